# Optimizing an MI355X kernel written in HIP

```python
import jax, jax.numpy as jnp
from jax import lax
import numpy as np

D_MODEL = 1024
BATCH = 32
SEQ = 2048
DEPTH = 1

MEM_LEN = 256
BLOCK = 128
WINDOW = 128
EPS = 1e-6
DA_HEADS = 8
DA_HEAD_DIM = 64
DA_V_DIM = 2 * DA_HEAD_DIM
WA_HEADS = 16
WA_KV_HEADS = 4
WA_HEAD_DIM = 64
XA_HEADS = 4
XA_HEAD_DIM = 256
N_BRANCH = 3
DA_QK_W = DA_HEADS * 2 * DA_HEAD_DIM
DA_V_W = DA_HEADS * DA_V_DIM
WA_Q_W = WA_HEADS * WA_HEAD_DIM
WA_KV_W = WA_KV_HEADS * WA_HEAD_DIM
XA_W = XA_HEADS * XA_HEAD_DIM
GATE_W = N_BRANCH * D_MODEL
IN_WIDTHS = (DA_QK_W, DA_QK_W, DA_V_W, WA_Q_W, WA_KV_W, WA_KV_W, XA_W, GATE_W)
IN_W = sum(IN_WIDTHS)
N_EXPERTS = 16
EC_FACTOR = 2
D_EXPERT = 2048
LAMBDA_STD = 0.1

kernel_name = 'hybrid_diffattn_swa_memxattn_ecmoe'


def rmsnorm(x, g):
    xf = x.astype(jnp.float32)
    y = xf * lax.rsqrt(jnp.mean(xf * xf, axis=-1, keepdims=True) + EPS)
    return (y * g.astype(jnp.float32)).astype(x.dtype)


def alibi_slopes(n_heads):
    return jnp.exp2(-8.0 * jnp.arange(1, n_heads + 1, dtype=jnp.float32) / n_heads)


def lambda_init(layer):
    return 0.8 - 0.6 * float(np.exp(-0.3 * layer))


def diff_attention(q, k, v, lam, subln_g, lam_init):
    b, s = q.shape[0], q.shape[1]
    nb = s // BLOCK
    scale = DA_HEAD_DIM ** -0.5
    slopes = alibi_slopes(DA_HEADS)[None, :, None, None, None]
    kpos = jnp.arange(s)
    qb = jnp.moveaxis(q.reshape(b, nb, BLOCK, DA_HEADS, 2, DA_HEAD_DIM), 1, 0)

    def one_block(args):
        qi, i = args
        sc = jnp.einsum('bqhmd,bkhmd->bhmqk', qi, k).astype(jnp.float32) * scale
        qpos = i * BLOCK + jnp.arange(BLOCK)
        dist = jnp.abs(qpos[:, None] - kpos[None, :]).astype(jnp.float32)
        p = jax.nn.softmax(sc - slopes * dist, axis=-1)
        a = p[:, :, 0] - lam * p[:, :, 1]
        return jnp.einsum('bhqk,bkhe->bqhe', a.astype(v.dtype), v)

    o = lax.map(one_block, (qb, jnp.arange(nb)))
    o = jnp.moveaxis(o, 0, 1).reshape(b, s, DA_HEADS, DA_V_DIM)
    o = rmsnorm(o, subln_g) * (1.0 - lam_init)
    return o.reshape(b, s, DA_V_W)


def window_attention(q, k, v, sink):
    b, s = q.shape[0], q.shape[1]
    nb = s // BLOCK
    span = BLOCK + 2 * WINDOW
    groups = WA_HEADS // WA_KV_HEADS
    scale = WA_HEAD_DIM ** -0.5
    slopes = alibi_slopes(WA_HEADS).reshape(WA_KV_HEADS, groups)[None, :, :, None, None]
    sink_logit = sink.astype(jnp.float32).reshape(WA_KV_HEADS, groups)[None, :, :, None, None]
    pad = ((0, 0), (WINDOW, WINDOW), (0, 0), (0, 0))
    kp = jnp.pad(k, pad)
    vp = jnp.pad(v, pad)
    qb = jnp.moveaxis(q.reshape(b, nb, BLOCK, WA_KV_HEADS, groups, WA_HEAD_DIM), 1, 0)

    def one_block(args):
        qi, i = args
        start = i * BLOCK
        kb = lax.dynamic_slice_in_dim(kp, start, span, axis=1)
        vb = lax.dynamic_slice_in_dim(vp, start, span, axis=1)
        sc = jnp.einsum('bqhgd,bkhd->bhgqk', qi, kb).astype(jnp.float32) * scale
        qpos = start + jnp.arange(BLOCK)
        kpos = start - WINDOW + jnp.arange(span)
        dist = jnp.abs(qpos[:, None] - kpos[None, :])
        valid = (dist <= WINDOW) & ((kpos >= 0) & (kpos < s))[None, :]
        sc = jnp.where(valid, sc - slopes * dist.astype(jnp.float32), -jnp.inf)
        sinks = jnp.broadcast_to(sink_logit, sc.shape[:-1] + (1,))
        p = jax.nn.softmax(jnp.concatenate([sc, sinks], axis=-1), axis=-1)[..., :span]
        return jnp.einsum('bhgqk,bkhd->bqhgd', p.astype(vb.dtype), vb)

    o = lax.map(one_block, (qb, jnp.arange(nb)))
    return jnp.moveaxis(o, 0, 1).reshape(b, s, WA_Q_W)


def memory_attention(q, mk, mv):
    sc = jnp.einsum('bqhd,bkhd->bhqk', q, mk).astype(jnp.float32) * (XA_HEAD_DIM ** -0.5)
    p = jax.nn.softmax(sc, axis=-1)
    o = jnp.einsum('bhqk,bkhd->bqhd', p.astype(mv.dtype), mv)
    return o.reshape(o.shape[0], o.shape[1], XA_W)


def expert_choice_ffn(h, w_router, w_gate, w_up, w_down):
    b, s, _ = h.shape
    cap = max(1, EC_FACTOR * s // N_EXPERTS)
    logits = jnp.einsum('bsd,de->bse', h, w_router).astype(jnp.float32)
    aff = jax.nn.softmax(logits, axis=-1)
    g, idx = lax.top_k(jnp.swapaxes(aff, 1, 2), cap)
    bidx = jnp.arange(b)[:, None, None]
    xe = h[bidx, idx]
    a = jnp.einsum('becd,edf->becf', xe, w_gate)
    u = jnp.einsum('becd,edf->becf', xe, w_up)
    ye = jnp.einsum('becf,efd->becd', jax.nn.silu(a) * u, w_down)
    ye = ye * g[..., None].astype(ye.dtype)
    return jnp.zeros_like(h).at[bidx, idx].add(ye)


def hybrid_layer(x, mem, layer, attn_norm_g, mem_norm_g, w_in, w_mem_kv,
                 da_lambda_q1, da_lambda_k1, da_lambda_q2, da_lambda_k2, da_subln_g,
                 wa_sink, w_da_o, w_wa_o, w_xa_o, w_out, ffn_norm_g,
                 w_router, w_exp_gate, w_exp_up, w_exp_down):
    b, s, d = x.shape
    h = rmsnorm(x, attn_norm_g)
    m = rmsnorm(mem, mem_norm_g)
    proj = h @ w_in
    offsets = np.cumsum(IN_WIDTHS)[:-1].tolist()
    da_q, da_k, da_v, wa_q, wa_k, wa_v, xa_q, gates = jnp.split(proj, offsets, axis=-1)

    lam_init = lambda_init(layer)
    lam = (jnp.exp(jnp.sum(da_lambda_q1.astype(jnp.float32) * da_lambda_k1.astype(jnp.float32)))
           - jnp.exp(jnp.sum(da_lambda_q2.astype(jnp.float32) * da_lambda_k2.astype(jnp.float32)))
           + lam_init)
    o_da = diff_attention(da_q.reshape(b, s, DA_HEADS, 2, DA_HEAD_DIM),
                          da_k.reshape(b, s, DA_HEADS, 2, DA_HEAD_DIM),
                          da_v.reshape(b, s, DA_HEADS, DA_V_DIM),
                          lam, da_subln_g, lam_init)

    o_wa = window_attention(wa_q.reshape(b, s, WA_HEADS, WA_HEAD_DIM),
                            wa_k.reshape(b, s, WA_KV_HEADS, WA_HEAD_DIM),
                            wa_v.reshape(b, s, WA_KV_HEADS, WA_HEAD_DIM),
                            wa_sink)

    mk, mv = jnp.split(m @ w_mem_kv, 2, axis=-1)
    n_mem = mem.shape[1]
    o_xa = memory_attention(xa_q.reshape(b, s, XA_HEADS, XA_HEAD_DIM),
                            mk.reshape(b, n_mem, XA_HEADS, XA_HEAD_DIM),
                            mv.reshape(b, n_mem, XA_HEADS, XA_HEAD_DIM))

    gate = jax.nn.sigmoid(gates.reshape(b, s, N_BRANCH, d))
    merged = (gate[:, :, 0] * (o_da @ w_da_o)
              + gate[:, :, 1] * (o_wa @ w_wa_o)
              + gate[:, :, 2] * (o_xa @ w_xa_o))
    x = x + merged @ w_out

    h2 = rmsnorm(x, ffn_norm_g)
    return x + expert_choice_ffn(h2, w_router, w_exp_gate, w_exp_up, w_exp_down)


def setup_inputs(seed: int = 0) -> dict:
    key = jax.random.key(seed)
    ks = jax.random.split(key, 24)
    L, D = DEPTH, D_MODEL

    def w(k, shape, fan_in):
        return jax.random.normal(k, shape, jnp.float32) * (fan_in ** -0.5)

    def gain(k, shape):
        return 1.0 + 0.05 * jax.random.normal(k, shape, jnp.float32)

    def small(k, shape, scale):
        return scale * jax.random.normal(k, shape, jnp.float32)

    return {
        'x': jax.random.normal(ks[0], (BATCH, SEQ, D), jnp.float32),
        'mem': jax.random.normal(ks[1], (BATCH, MEM_LEN, D), jnp.float32),
        'attn_norm_g': gain(ks[2], (L, D)),
        'mem_norm_g': gain(ks[3], (L, D)),
        'w_in': w(ks[4], (L, D, IN_W), D),
        'w_mem_kv': w(ks[5], (L, D, 2 * XA_W), D),
        'da_lambda_q1': small(ks[6], (L, DA_HEAD_DIM), LAMBDA_STD),
        'da_lambda_k1': small(ks[7], (L, DA_HEAD_DIM), LAMBDA_STD),
        'da_lambda_q2': small(ks[8], (L, DA_HEAD_DIM), LAMBDA_STD),
        'da_lambda_k2': small(ks[9], (L, DA_HEAD_DIM), LAMBDA_STD),
        'da_subln_g': gain(ks[10], (L, DA_V_DIM)),
        'wa_sink': small(ks[11], (L, WA_HEADS), 0.5),
        'w_da_o': w(ks[12], (L, DA_V_W, D), DA_V_W),
        'w_wa_o': w(ks[13], (L, WA_Q_W, D), WA_Q_W),
        'w_xa_o': w(ks[14], (L, XA_W, D), XA_W),
        'w_out': w(ks[15], (L, D, D), D),
        'ffn_norm_g': gain(ks[16], (L, D)),
        'w_router': w(ks[17], (L, D, N_EXPERTS), D),
        'w_exp_gate': w(ks[18], (L, N_EXPERTS, D, D_EXPERT), D),
        'w_exp_up': w(ks[19], (L, N_EXPERTS, D, D_EXPERT), D),
        'w_exp_down': w(ks[20], (L, N_EXPERTS, D_EXPERT, D), D_EXPERT),
        'final_norm_g': gain(ks[21], (D,)),
    }


def reference(x, mem, attn_norm_g, mem_norm_g, w_in, w_mem_kv,
              da_lambda_q1, da_lambda_k1, da_lambda_q2, da_lambda_k2, da_subln_g,
              wa_sink, w_da_o, w_wa_o, w_xa_o, w_out, ffn_norm_g,
              w_router, w_exp_gate, w_exp_up, w_exp_down, final_norm_g):
    for l in range(DEPTH):
        x = hybrid_layer(x, mem, l, attn_norm_g[l], mem_norm_g[l], w_in[l], w_mem_kv[l],
                         da_lambda_q1[l], da_lambda_k1[l], da_lambda_q2[l], da_lambda_k2[l],
                         da_subln_g[l], wa_sink[l], w_da_o[l], w_wa_o[l], w_xa_o[l], w_out[l],
                         ffn_norm_g[l], w_router[l], w_exp_gate[l], w_exp_up[l], w_exp_down[l])
    return rmsnorm(x, final_norm_g)
```

```cpp
#include <hip/hip_runtime.h>
#include <cstdio>
#include <cstdint>

#define GATES_FP8 1
#define INPROJ_FP8 0
#define XA_FP8 1
#define YC_FP8 1
#define WA_FP8 1
#define XS_FP8 1
constexpr float XQ8_SCALE = 16.0f;
constexpr float P8_SCALE = 256.0f, MVW8_SCALE = 8.0f;
#ifndef MK_N_LAUNCHES
#define MK_N_LAUNCHES 1
#endif

#define LAS __attribute__((address_space(3)))
#define GAS __attribute__((address_space(1)))
typedef unsigned short bf16_t;
typedef short bf16x8 __attribute__((ext_vector_type(8)));
typedef float f32x4 __attribute__((ext_vector_type(4)));
typedef float f32x2 __attribute__((ext_vector_type(2)));
typedef float f32x16 __attribute__((ext_vector_type(16)));
typedef unsigned u32x4 __attribute__((ext_vector_type(4)));
typedef unsigned u32x2 __attribute__((ext_vector_type(2)));

constexpr int DM = 1024, NB = 32, SEQ = 2048, MTOK = NB * SEQ;
constexpr int MEML = 256, MMEM = NB * MEML;
constexpr int NEXP = 16, CAP = 256, DEXP = 2048;
constexpr int INW = 8704;
constexpr float EPS = 1e-6f;
constexpr float LOG2E = 1.4426950408889634f;
constexpr float LAM_INIT = 0.2f;

constexpr size_t MiB = 1u << 20;
constexpr size_t WS_CTL = 0, CTL_ZERO_BYTES = 64 * 1024;
constexpr size_t WS_KMAX = 32 * 1024;
constexpr size_t WS_GL = 1 * MiB;
constexpr size_t WS_IDX = 1 * MiB + 512 * 1024;
constexpr size_t WS_INV = 2 * MiB;
constexpr size_t WS_WIN = 4 * MiB;
constexpr size_t WS_WMKV = 21 * MiB;
constexpr size_t WS_WDAO = 25 * MiB, WS_WWAO = 27 * MiB, WS_WXAO = 29 * MiB, WS_WOUT = 31 * MiB;
constexpr size_t WS_MN = 33 * MiB;
constexpr size_t WS_MK = 49 * MiB, WS_MV = 65 * MiB;
constexpr size_t WS_MVW = 81 * MiB;
constexpr size_t WS_AFF = 145 * MiB;
constexpr size_t WS_SG0 = 448 * MiB, WS_SG1 = 768 * MiB;
constexpr size_t WS_WXQ8 = 152 * MiB, WS_WMKV8 = 153 * MiB, WS_MN8 = 155 * MiB;
constexpr size_t WS_WWA8 = 163 * MiB;
constexpr size_t WS_WG8 = 149 * MiB;
constexpr size_t WS_ACT0 = 192 * MiB;
constexpr size_t WS_DAQ = 192 * MiB, WS_DAK = 320 * MiB, WS_DAVT = 448 * MiB, WS_WAQ = 576 * MiB, WS_WAK = 704 * MiB, WS_WAVT = 736 * MiB,
                 WS_XAQ = 768 * MiB, WS_H = 896 * MiB, WS_END = 1024 * MiB;
constexpr size_t WS_MERGED = WS_DAK;
constexpr size_t WS_X1 = 192 * MiB;
constexpr size_t WS_H2 = 320 * MiB;
constexpr size_t WS_WGU = 384 * MiB;
constexpr size_t WS_WD = 448 * MiB;
constexpr size_t WS_ACTB = 480 * MiB;
constexpr size_t WS_YE = 736 * MiB;

constexpr int R_DAQ = 0, R_DAK = 1024, R_WAQ = 2048, R_XAQ = 3072, R_WAK = 4096, R_DAV = 4352, R_WAV = 5376, R_GATE = 5632;

constexpr int RING_BYTES = 131072;
constexpr int EPI_OFF = RING_BYTES;
constexpr int MISC_OFF = RING_BYTES + 8192;
constexpr int LDS_BYTES = 147456;

#define LDS_WAIT() asm volatile("s_waitcnt lgkmcnt(0)" ::: "memory")
#define VM_WAIT() asm volatile("s_waitcnt vmcnt(0)" ::: "memory")
__device__ __forceinline__ unsigned cvt_pk_bf16(float lo, float hi) { unsigned r; asm volatile("v_cvt_pk_bf16_f32 %0, %1, %2" : "=v"(r) : "v"(lo), "v"(hi)); return r; }
typedef __bf16 bf16x2_t __attribute__((ext_vector_type(2)));
__device__ __forceinline__ unsigned cvt_pk_bf16_c(float lo, float hi) { f32x2 v; v.x = lo; v.y = hi; return __builtin_bit_cast(unsigned, __builtin_convertvector(v, bf16x2_t)); }
__device__ __forceinline__ float bf_lo(unsigned w) { return __uint_as_float(w << 16); }
__device__ __forceinline__ float bf_hi(unsigned w) { return __uint_as_float(w & 0xffff0000u); }
__device__ __forceinline__ float wave_sum(float v) {
#pragma unroll
    for (int o = 1; o < 64; o <<= 1) v += __shfl_xor(v, o);
    return v;
}
typedef int v8i __attribute__((ext_vector_type(8)));
typedef int v4i __attribute__((ext_vector_type(4)));
constexpr float W8_SCALE = 64.0f, ACT8_SCALE = 8.0f, YE8_SCALE = 8.0f;
__device__ __forceinline__ float clamp8(float v) { return fminf(fmaxf(v, -448.0f), 448.0f); }
__device__ __forceinline__ unsigned pk4_fp8(float a, float b, float c, float d) {
    int w = 0; w = __builtin_amdgcn_cvt_pk_fp8_f32(clamp8(a), clamp8(b), w, false); w = __builtin_amdgcn_cvt_pk_fp8_f32(clamp8(c), clamp8(d), w, true); return (unsigned)w; }
__device__ __forceinline__ float fast_sigmoid(float v) { return __builtin_amdgcn_rcpf(1.0f + __builtin_amdgcn_exp2f(-LOG2E * v)); }

#define XB_TMO      128
#define XB_XCNT(j)  (256  + 64 * (j))
#define XB_XSUB(j)  (1280 + 64 * (j))
#define XB_XGEN(j)  (2304 + 64 * (j))
#define XB_TOP      3328
#define XB_TOPGEN   3392
#define XCD_BAR_WORDS 3456
#define XB_SPIN_CAP (1u << 18)
__device__ __forceinline__ unsigned xb_ld(unsigned* p)              { return __hip_atomic_load(p, __ATOMIC_RELAXED, __HIP_MEMORY_SCOPE_AGENT); }
__device__ __forceinline__ unsigned xb_add(unsigned* p, unsigned v) { return __hip_atomic_fetch_add(p, v, __ATOMIC_RELAXED, __HIP_MEMORY_SCOPE_AGENT); }
__device__ __forceinline__ unsigned xb_xcc_id() { return (unsigned)__builtin_amdgcn_s_getreg((3 << 11) | 20) & 0xFu; }
#define XB_SPIN(cond, bar) do { unsigned _sp = 0; while (cond) { __builtin_amdgcn_s_sleep(1); \
    if ((++_sp & 255u) == 0u) { if (xb_ld(&(bar)[XB_TMO])) break; if (_sp > XB_SPIN_CAP) { atomicAdd(&(bar)[XB_TMO], 1u); break; } } } } while (0)
struct XcdBarrier { unsigned* bar; unsigned x; volatile LAS unsigned* st; };
__device__ __forceinline__ XcdBarrier xcd_barrier_post(unsigned* bar, volatile LAS unsigned* st) {
    XcdBarrier b; b.bar = bar; b.x = xb_xcc_id(); b.st = st;
    if (threadIdx.x == 0) (void)xb_add(&bar[XB_XCNT(b.x)], 1u);
    return b;
}
__device__ __forceinline__ void xcd_barrier_complete(unsigned* bar, unsigned x, unsigned& nloc, unsigned& nx) {
    const unsigned G = gridDim.x * gridDim.y * gridDim.z;
    unsigned sum, cnt, mine, sp = 0u;
    for (;;) {
        sum = 0u; cnt = 0u; mine = 0u;
#pragma unroll
        for (unsigned j = 0; j < 16; ++j) { const unsigned c = xb_ld(&bar[XB_XCNT(j)]); sum += c; cnt += (c > 0u) ? 1u : 0u; mine = (j == x) ? c : mine; }
        if (sum == G) break;
        __builtin_amdgcn_s_sleep(1);
        if ((++sp & 255u) == 0u) { if (xb_ld(&bar[XB_TMO])) break; if (sp > XB_SPIN_CAP) { atomicAdd(&bar[XB_TMO], 1u); break; } }
    }
    nloc = mine > 0u ? mine : 1u; nx = cnt > 0u ? cnt : 1u;
}
__device__ __forceinline__ void xcd_barrier(const XcdBarrier& b) {
    asm volatile("s_waitcnt vmcnt(0)" ::: "memory");
    __syncthreads();
    if (threadIdx.x == 0) {
        unsigned* bar = b.bar;
        __builtin_amdgcn_s_waitcnt(0);
        unsigned nloc = b.st[0], nx = b.st[1];
        if (nloc == 0u) { xcd_barrier_complete(bar, b.x, nloc, nx); b.st[0] = nloc; b.st[1] = nx; }
        const unsigned old = xb_add(&bar[XB_XSUB(b.x)], 1u);
        const unsigned gen = old / nloc;
        if (old + 1u == (gen + 1u) * nloc) {
            __builtin_amdgcn_fence(__ATOMIC_RELEASE, "agent");
            asm volatile("s_waitcnt vmcnt(0)" ::: "memory");
            const unsigned og = xb_add(&bar[XB_TOP], 1u);
            const unsigned tg = og / nx;
            if (og + 1u == (tg + 1u) * nx) xb_add(&bar[XB_TOPGEN], 1u);
            else XB_SPIN(xb_ld(&bar[XB_TOPGEN]) == tg, bar);
            __builtin_amdgcn_fence(__ATOMIC_ACQUIRE, "agent");
            xb_add(&bar[XB_XGEN(b.x)], 1u);
            asm volatile("s_waitcnt vmcnt(0)" ::: "memory");
        } else {
            XB_SPIN(xb_ld(&bar[XB_XGEN(b.x)]) == gen, bar);
            __builtin_amdgcn_fence(__ATOMIC_ACQUIRE, "agent");
            asm volatile("s_waitcnt vmcnt(0)" ::: "memory");
        }
    }
    __syncthreads();
}

namespace pg {
constexpr int BM = 256, BK = 64, HALF = 128, HTB = HALF * BK * 2, STAGE_BYTES = 8 * HTB, NXCD = 8, WGM = 8;
__host__ __device__ __forceinline__ int lds_byte(int r, int c) { const int st = (r >> 4) * 2 + (c >> 5), rr = r & 15, cc = c & 31, ob = rr * 64 + cc * 2; return st * 1024 + (ob ^ (((ob >> 9) & 1) << 5)); }
__host__ __device__ __forceinline__ void stage_rc(int b, int& R, int& C) { const int st = b / 1024, sb = b % 1024, swz = sb ^ (((sb >> 9) & 1) << 5); R = (st >> 1) * 16 + swz / 64; C = (st & 1) * 32 + (swz % 64) / 2; }
__host__ __device__ __forceinline__ int perm32(int rho) { const int n = rho >> 4, i = rho & 15; return 8 * (i >> 2) + 4 * n + (i & 3); }
__device__ __forceinline__ void xcd_map(int L, int nM, int nN, int& pm, int& pn) {
    const int nwg = nM * nN; int wgid = L;
    { const int q = nwg / NXCD, r = nwg % NXCD, xcd = wgid % NXCD, off = wgid / NXCD; wgid = (xcd < r ? xcd * (q + 1) : r * (q + 1) + (xcd - r) * q) + off; }
    const int nig = WGM * nN, gid = wgid / nig, fm = gid * WGM, gsz = (nM - fm) < WGM ? (nM - fm) : WGM;
    pm = fm + ((wgid % nig) % gsz); pn = (wgid % nig) / gsz;
}
struct GUnit { const char* A; const char* B; int pm, pn, job; };

#ifndef PG_SP2
#define PG_SP2 1
#endif
template <class Job, bool PERM, bool GATHER, bool FP8 = false>
__device__ __forceinline__ void gemm_phase(LAS unsigned char* lds, const Job& J) {
    const int tid = threadIdx.x, wid = __builtin_amdgcn_readfirstlane(tid >> 6), lane = tid & 63, wr = wid >> 2, wc = wid & 3, fr = lane & 15, fq = lane >> 4;
    const int K = J.K, nt = K / BK, lda = J.lda, ldb = J.ldb;
    int R0, C0, R1, C1; stage_rc(tid * 16, R0, C0); stage_rc(tid * 16 + 8192, R1, C1);
    unsigned vA[2][2], vAn[2][2], vB[2];
    { const int Rb0 = PERM ? ((R0 & ~31) + perm32(R0 & 31)) : R0, Rb1 = PERM ? ((R1 & ~31) + perm32(R1 & 31)) : R1;
      vB[0] = (unsigned)(Rb0 * ldb + C0) * 2u; vB[1] = (unsigned)(Rb1 * ldb + C1) * 2u; }
    const size_t kstep = (size_t)(BK * 2);
    const size_t hstepB = (size_t)HALF * ldb * 2;
    const unsigned ldsw = (unsigned)wid * 1024u;
    const unsigned ldsb = (unsigned)__builtin_amdgcn_readfirstlane((int)((unsigned)(uintptr_t)lds + ldsw));
    const int aoff = lds_byte(wr * 64 + fr, fq * 8), boff = lds_byte(wc * 32 + fr, fq * 8);
#define PG_SA(b, h) (((b) * 2 + (h)) * HTB)
#define PG_SB(b, h) ((4 + (b) * 2 + (h)) * HTB)
#define PG_STAGE(bufoff, gbase, voff) do { _Pragma("unroll") for (int _i = 0; _i < 2; ++_i) { unsigned _keep; \
        asm volatile("s_mov_b32 %0, m0\n\ts_mov_b32 m0, %3\n\ts_nop 0\n\tglobal_load_lds_dwordx4 %1, %2\n\ts_mov_b32 m0, %0" \
            : "=&s"(_keep) : "v"((voff)[_i]), "s"((const char*)(gbase)), "s"(ldsb + (unsigned)((bufoff) + _i * 8192)) : "memory"); } } while (0)
#define PG_LDA(dst, b, h) do { _Pragma("unroll") for (int m = 0; m < 4; ++m) _Pragma("unroll") for (int k = 0; k < 2; ++k) dst[m][k] = *(const LAS bf16x8*)(lds + PG_SA(b, h) + aoff + m * 2048 + k * 1024); } while (0)
#define PG_LDB(dst, b, h) do { _Pragma("unroll") for (int n = 0; n < 2; ++n) _Pragma("unroll") for (int k = 0; k < 2; ++k) dst[n][k] = *(const LAS bf16x8*)(lds + PG_SB(b, h) + boff + n * 2048 + k * 1024); } while (0)
#define PG_CAT8(x) __builtin_shufflevector(__builtin_bit_cast(v4i, (x)[0]), __builtin_bit_cast(v4i, (x)[1]), 0, 1, 2, 3, 4, 5, 6, 7)
#define PG_MMA(ai, bj, At, Bt) do { __builtin_amdgcn_s_setprio(1); _Pragma("unroll") for (int m = 0; m < 4; ++m) _Pragma("unroll") for (int n = 0; n < 2; ++n) { \
        if constexpr (FP8) { asm volatile("v_mfma_scale_f32_16x16x128_f8f6f4 %0, %1, %2, %0, %3, %3 op_sel_hi:[0,0,0]" : "+v"(acc[ai][bj][m][n]) : "v"(PG_CAT8(Bt[n])), "v"(PG_CAT8(At[m])), "v"(sc8)); } \
        else { _Pragma("unroll") for (int k = 0; k < 2; ++k) acc[ai][bj][m][n] = __builtin_amdgcn_mfma_f32_16x16x32_bf16(Bt[n][k], At[m][k], acc[ai][bj][m][n], 0, 0, 0); } } \
        __builtin_amdgcn_s_setprio(0); } while (0)
#define PG_WAIT_V(n) asm volatile("s_waitcnt vmcnt(" #n ")" ::: "memory")
#define PG_WAIT_L(n) asm volatile("s_waitcnt lgkmcnt(" #n ")" ::: "memory")
#define PG_BAR __builtin_amdgcn_s_barrier()
#define PG_SCHED __builtin_amdgcn_sched_barrier(0)
#define PG_SETV(dst, u) do { if constexpr (GATHER) { const int* _rw = J.rows(u); \
        dst[0][0] = (unsigned)(_rw[R0] * lda + C0) * 2u; dst[0][1] = (unsigned)(_rw[R1] * lda + C1) * 2u; \
        dst[1][0] = (unsigned)(_rw[HALF + R0] * lda + C0) * 2u; dst[1][1] = (unsigned)(_rw[HALF + R1] * lda + C1) * 2u; } \
      else { dst[0][0] = (unsigned)(R0 * lda + C0) * 2u; dst[0][1] = (unsigned)(R1 * lda + C1) * 2u; \
        dst[1][0] = (unsigned)((HALF + R0) * lda + C0) * 2u; dst[1][1] = (unsigned)((HALF + R1) * lda + C1) * 2u; } } while (0)
    const int sc8 = 0x7f7f7f7f;
    GUnit cur, nxt; int ui = 0;
    if (!J.next(0, cur)) return;
    f32x4 acc[2][2][4][2];
#pragma unroll
    for (int a = 0; a < 2; ++a)
#pragma unroll
        for (int b = 0; b < 2; ++b)
#pragma unroll
            for (int m = 0; m < 4; ++m)
#pragma unroll
                for (int n = 0; n < 2; ++n) acc[a][b][m][n] = (f32x4){0.f, 0.f, 0.f, 0.f};
    bf16x8 At[4][2], B0[2][2], B1[2][2];
    const char* cA = cur.A; const char* cB = cur.B;
    PG_SETV(vA, cur);
    if (PG_SP2) {
    PG_STAGE(PG_SB(0, 0), cB, vB); PG_STAGE(PG_SB(0, 1), cB + hstepB, vB); PG_STAGE(PG_SA(0, 0), cA, vA[0]); PG_STAGE(PG_SA(0, 1), cA, vA[1]);
    if (wr == 1) PG_BAR;
    PG_WAIT_V(2); PG_BAR;
    PG_STAGE(PG_SB(1, 0), cB + kstep, vB); PG_STAGE(PG_SA(1, 0), cA + kstep, vA[0]); PG_STAGE(PG_SB(1, 1), cB + hstepB + kstep, vB);
    PG_WAIT_V(6); PG_BAR;
    } else {
    PG_STAGE(PG_SB(0, 0), cB, vB); PG_STAGE(PG_SA(0, 0), cA, vA[0]); PG_STAGE(PG_SB(0, 1), cB + hstepB, vB); PG_STAGE(PG_SA(0, 1), cA, vA[1]);
    if (wr == 1) PG_BAR;
    PG_WAIT_V(4); PG_BAR;
    PG_STAGE(PG_SB(1, 0), cB + kstep, vB); PG_STAGE(PG_SA(1, 0), cA + kstep, vA[0]); PG_STAGE(PG_SB(1, 1), cB + hstepB + kstep, vB);
    PG_WAIT_V(6); PG_BAR;
    }
    for (;;) {
        const bool has_next = J.next(ui + 1, nxt);
        const char* nA = has_next ? nxt.A : cA; const char* nB = has_next ? nxt.B : cB;
        if constexpr (GATHER) { if (has_next) { PG_SETV(vAn, nxt); } else {
#pragma unroll
            for (int h = 0; h < 2; ++h) { vAn[h][0] = vA[h][0]; vAn[h][1] = vA[h][1]; } } }
        for (int t = 0; t < nt; t += 2) {
            const bool last = (t == nt - 2);
            const char* a1 = cA + (size_t)(t + 1) * kstep;
            const char* a2 = last ? nA : cA + (size_t)(t + 2) * kstep; const char* b2 = last ? nB : cB + (size_t)(t + 2) * kstep;
            const char* a3 = a2 + kstep; const char* b3 = b2 + kstep;
            unsigned vq[2][2];
#pragma unroll
            for (int h = 0; h < 2; ++h)
#pragma unroll
                for (int i = 0; i < 2; ++i) vq[h][i] = (GATHER && last) ? vAn[h][i] : vA[h][i];
            if (PG_SP2) {
            PG_LDB(B0, 0, 0); PG_LDB(B1, 0, 1); PG_SCHED; PG_LDA(At, 0, 0); PG_STAGE(PG_SA(1, 1), a1, vA[1]);
            PG_WAIT_V(8); PG_WAIT_L(0); PG_BAR; PG_MMA(0, 0, At, B0); PG_MMA(0, 1, At, B1); PG_BAR; PG_SCHED;
            PG_LDA(At, 0, 1); PG_STAGE(PG_SB(0, 0), b2, vB); PG_STAGE(PG_SB(0, 1), b2 + hstepB, vB); PG_STAGE(PG_SA(0, 0), a2, vq[0]);
            PG_WAIT_V(8); PG_WAIT_L(0); PG_BAR; PG_MMA(1, 0, At, B0); PG_MMA(1, 1, At, B1); PG_BAR; PG_SCHED;
            PG_LDB(B0, 1, 0); PG_LDB(B1, 1, 1); PG_SCHED; PG_LDA(At, 1, 0); PG_STAGE(PG_SA(0, 1), a2, vq[1]);
            PG_WAIT_V(8); PG_WAIT_L(0); PG_BAR; PG_MMA(0, 0, At, B0); PG_MMA(0, 1, At, B1); PG_BAR; PG_SCHED;
            PG_LDA(At, 1, 1); PG_STAGE(PG_SB(1, 0), b3, vB); PG_STAGE(PG_SB(1, 1), b3 + hstepB, vB); PG_STAGE(PG_SA(1, 0), a3, vq[0]);
            PG_WAIT_V(8); PG_WAIT_L(0); PG_BAR; PG_MMA(1, 0, At, B0); PG_MMA(1, 1, At, B1); PG_BAR; PG_SCHED;
            } else {
            PG_LDB(B0, 0, 0); PG_SCHED; PG_LDA(At, 0, 0); PG_STAGE(PG_SA(1, 1), a1, vA[1]);
            PG_WAIT_L(8); PG_BAR; PG_WAIT_L(0); PG_MMA(0, 0, At, B0); PG_BAR; PG_SCHED;
            PG_LDB(B1, 0, 1); PG_STAGE(PG_SB(0, 0), b2, vB);
            PG_BAR; PG_WAIT_L(0); PG_MMA(0, 1, At, B1); PG_BAR;
            PG_LDA(At, 0, 1); PG_STAGE(PG_SA(0, 0), a2, vq[0]);
            PG_BAR; PG_WAIT_L(0); PG_MMA(1, 0, At, B0); PG_BAR; PG_SCHED;
            PG_STAGE(PG_SB(0, 1), b2 + hstepB, vB);
            PG_WAIT_V(6); PG_BAR; PG_MMA(1, 1, At, B1); PG_BAR;
            PG_LDB(B0, 1, 0); PG_SCHED; PG_LDA(At, 1, 0); PG_STAGE(PG_SA(0, 1), a2, vq[1]);
            PG_WAIT_L(8); PG_BAR; PG_WAIT_L(0); PG_MMA(0, 0, At, B0); PG_BAR; PG_SCHED;
            PG_LDB(B1, 1, 1); PG_STAGE(PG_SB(1, 0), b3, vB);
            PG_BAR; PG_WAIT_L(0); PG_MMA(0, 1, At, B1); PG_BAR;
            PG_LDA(At, 1, 1); PG_STAGE(PG_SA(1, 0), a3, vq[0]);
            PG_BAR; PG_WAIT_L(0); PG_MMA(1, 0, At, B0); PG_BAR; PG_SCHED;
            PG_STAGE(PG_SB(1, 1), b3 + hstepB, vB);
            PG_WAIT_V(6); PG_BAR; PG_MMA(1, 1, At, B1); PG_BAR;
            }
        }
        if constexpr (FP8) asm volatile("s_nop 15\n\ts_nop 7" ::: "memory");
        if (wr == 0) PG_BAR;
        J.epi(acc, cur, wr, wc, fr, fq);
        if (!has_next) break;
#pragma unroll
        for (int a = 0; a < 2; ++a)
#pragma unroll
            for (int b = 0; b < 2; ++b)
#pragma unroll
                for (int m = 0; m < 4; ++m)
#pragma unroll
                    for (int n = 0; n < 2; ++n) acc[a][b][m][n] = (f32x4){0.f, 0.f, 0.f, 0.f};
        cur = nxt; cA = nA; cB = nB; ++ui;
        if constexpr (GATHER) {
#pragma unroll
            for (int h = 0; h < 2; ++h) { vA[h][0] = vAn[h][0]; vA[h][1] = vAn[h][1]; } }
        if (wr == 1) PG_BAR;
    }
    PG_WAIT_V(0);
    PG_BAR;
#undef PG_SA
#undef PG_SB
#undef PG_STAGE
#undef PG_LDA
#undef PG_LDB
#undef PG_MMA
#undef PG_CAT8
#undef PG_WAIT_V
#undef PG_WAIT_L
#undef PG_BAR
#undef PG_SCHED
#undef PG_SETV
}

__device__ __forceinline__ void store_tile_bf16(const f32x4 (&acc)[2][2][4][2], bf16_t* O, int ldo, float sc, int wr, int wc, int fr, int fq) {
    const unsigned loff = (unsigned)((wr * 64 + fr) * ldo + wc * 32 + 8 * fq) * 2u;
#pragma unroll
    for (int ai = 0; ai < 2; ++ai)
#pragma unroll
        for (int m = 0; m < 4; ++m) { char* rowb = (char*)O + (size_t)(ai * HALF + m * 16) * ldo * 2;
#pragma unroll
            for (int bj = 0; bj < 2; ++bj) { const f32x4 v0 = acc[ai][bj][m][0] * sc, v1 = acc[ai][bj][m][1] * sc;
                u32x4 w; w.x = cvt_pk_bf16(v0[0], v0[1]); w.y = cvt_pk_bf16(v0[2], v0[3]); w.z = cvt_pk_bf16(v1[0], v1[1]); w.w = cvt_pk_bf16(v1[2], v1[3]);
                *(u32x4*)(rowb + bj * HALF * 2 + loff) = w; } }
}
}

struct Ptrs {
    const float* x; const float* mem; const float* attn_g; const float* mem_g; const float* w_in; const float* w_mkv;
    const float* lq1; const float* lk1; const float* lq2; const float* lk2; const float* subln_g; const float* wa_sink;
    const float* w_da_o; const float* w_wa_o; const float* w_xa_o; const float* w_out; const float* ffn_g; const float* w_router;
    const float* w_eg; const float* w_eu; const float* w_ed; const float* final_g;
    float* out; unsigned char* ws;
};
#define WSP(T, off) ((T*)(P.ws + (off)))

struct JobP1 {
    Ptrs P; int G, c; int K, lda, ldb; LAS float* scr;
    __device__ __forceinline__ bool next(int i, pg::GUnit& u) const {
        int L = i * G + c;
        constexpr size_t RB = INPROJ_FP8 ? 1024 : 2048;
        const char* h = INPROJ_FP8 ? (const char*)P.out + 128 * MiB : (const char*)(P.ws + WS_H); const char* w = (const char*)(P.ws + WS_WIN);
        if (XA_FP8 && WA_FP8) {
            if (L < 2048) { pg::xcd_map(L, 256, 8, u.pm, u.pn); u.job = 0; u.A = h + (size_t)u.pm * (256 * RB); u.B = w + (size_t)u.pn * (256 * RB); return true; }
            L -= 2048;
            if (L < 1024) { pg::xcd_map(L, 4, 256, u.pm, u.pn); u.job = 1; u.A = w + (size_t)(R_DAV + u.pm * 256) * RB; u.B = h + (size_t)u.pn * (256 * RB); return true; }
            return false;
        }
        if (XA_FP8) {
            if (L < 3328) { pg::xcd_map(L, 256, 13, u.pm, u.pn); if (u.pn == 12) u.pn = 16; u.job = 0; u.A = h + (size_t)u.pm * (256 * RB); u.B = w + (size_t)u.pn * (256 * RB); return true; }
            L -= 3328;
            if (L < 1280) { pg::xcd_map(L, 5, 256, u.pm, u.pn); u.job = 1; u.A = w + (size_t)(R_DAV + u.pm * 256) * RB; u.B = h + (size_t)u.pn * (256 * RB); return true; }
            return false;
        }
        if (L < 4352) { pg::xcd_map(L, 256, 17, u.pm, u.pn); u.job = 0; u.A = h + (size_t)u.pm * (256 * RB); u.B = w + (size_t)u.pn * (256 * RB); return true; }
        L -= 4352;
        if (L < 1280) { pg::xcd_map(L, 5, 256, u.pm, u.pn); u.job = 1; u.A = w + (size_t)(R_DAV + u.pm * 256) * RB; u.B = h + (size_t)u.pn * (256 * RB); return true; }
        L -= 1280;
        if (L < 256) { pg::xcd_map(L, 32, 8, u.pm, u.pn); u.job = 2; u.A = (const char*)(P.ws + WS_MN) + (size_t)u.pm * (256 * RB); u.B = (const char*)(P.ws + WS_WMKV) + (size_t)u.pn * (256 * RB); return true; }
        return false;
    }
    __device__ __forceinline__ const int* rows(const pg::GUnit&) const { return nullptr; }
    __device__ __forceinline__ void epi(const f32x4 (&acc)[2][2][4][2], const pg::GUnit& u, int wr, int wc, int fr, int fq) const {
        bf16_t* O; int ldo = 1024; float sc = INPROJ_FP8 ? (1.0f / W8_SCALE) : 1.f;
        if (u.job == 0) {
            const int s = u.pn >> 2, q = u.pn & 3;
            if (s == 0) { O = WSP(bf16_t, WS_DAQ) + (size_t)u.pm * 256 * 1024 + q * 256; sc *= 0.125f * LOG2E; }
            else if (s == 1) { O = WSP(bf16_t, WS_DAK) + (size_t)u.pm * 256 * 1024 + q * 256; }
            else if (s == 2) { O = WSP(bf16_t, WS_WAQ) + (size_t)u.pm * 256 * 1024 + q * 256; sc *= 0.125f * LOG2E; }
            else if (s == 3) { O = WSP(bf16_t, WS_XAQ) + (size_t)u.pm * 256 * 1024 + q * 256; sc *= 0.0625f * LOG2E; }
            else { O = WSP(bf16_t, WS_WAK) + (size_t)u.pm * 256 * 256; ldo = 256; }
        } else if (u.job == 1) {
            ldo = MTOK;
            if (u.pm < 4) O = WSP(bf16_t, WS_DAVT) + (size_t)u.pm * 256 * MTOK + (size_t)u.pn * 256;
            else O = WSP(bf16_t, WS_WAVT) + (size_t)u.pn * 256;
        } else {
            if (u.pn < 4) O = WSP(bf16_t, WS_MK) + (size_t)u.pm * 256 * 1024 + u.pn * 256;
            else O = WSP(bf16_t, WS_MV) + (size_t)u.pm * 256 * 1024 + (u.pn - 4) * 256;
        }
        pg::store_tile_bf16(acc, O, ldo, sc, wr, wc, fr, fq);
        if (u.job == 0 && (u.pn >> 2) == 1) {
            LAS float* X = scr;
#pragma unroll
            for (int ai = 0; ai < 2; ++ai)
#pragma unroll
                for (int m = 0; m < 4; ++m)
#pragma unroll
                    for (int bj = 0; bj < 2; ++bj) { const f32x4 a = acc[ai][bj][m][0] * sc, b2 = acc[ai][bj][m][1] * sc;
                        float q = (a[0] * a[0] + a[1] * a[1]) + (a[2] * a[2] + a[3] * a[3]) + (b2[0] * b2[0] + b2[1] * b2[1]) + (b2[2] * b2[2] + b2[3] * b2[3]);
                        q += __shfl_xor(q, 16); q += __shfl_xor(q, 32);
                        if (fq == 0) X[((ai * 128 + wr * 64 + m * 16 + fr) * 2 + bj) * 4 + wc] = q; }
            LDS_WAIT(); __builtin_amdgcn_s_barrier(); asm volatile("" ::: "memory");
            { const int t = threadIdx.x, row = t & 255, bj = t >> 8; const f32x4 q = *(const LAS f32x4*)(X + (row * 2 + bj) * 4);
              float v = fmaxf(q[0] + q[1], q[2] + q[3]) * 1.01f;
#pragma unroll
              for (int off = 1; off < 64; off <<= 1) v = fmaxf(v, __shfl_xor(v, off));
              if ((t & 63) == 0) __hip_atomic_fetch_max(WSP(unsigned, WS_KMAX) + (u.pm >> 3) * 8 + 2 * (u.pn - 4) + bj, __float_as_uint(v), __ATOMIC_RELAXED, __HIP_MEMORY_SCOPE_AGENT); }
            LDS_WAIT(); __builtin_amdgcn_s_barrier(); asm volatile("" ::: "memory");
        }
    }
};

struct JobP1x {
    Ptrs P; int G, c; int K, lda, ldb;
    __device__ __forceinline__ bool next(int i, pg::GUnit& u) const {
        int L = i * G + c;
        if (L < 1024) { pg::xcd_map(L, 256, 4, u.pm, u.pn); u.job = 0; u.A = (const char*)P.out + 128 * MiB + (size_t)u.pm * (256 * 1024); u.B = (const char*)(P.ws + WS_WXQ8) + (size_t)u.pn * (256 * 1024); return true; }
        L -= 1024;
        if (L < 256) { pg::xcd_map(L, 32, 8, u.pm, u.pn); u.job = 2; u.A = (const char*)(P.ws + WS_MN8) + (size_t)u.pm * (256 * 1024); u.B = (const char*)(P.ws + WS_WMKV8) + (size_t)u.pn * (256 * 1024); return true; }
        if (!WA_FP8) return false;
        L -= 256;
        const char* h8 = (const char*)P.out + 128 * MiB; const char* w8 = (const char*)(P.ws + WS_WWA8);
        if (L < 1280) { pg::xcd_map(L, 256, 5, u.pm, u.pn); u.job = 3; u.A = h8 + (size_t)u.pm * (256 * 1024); u.B = w8 + (size_t)u.pn * (256 * 1024); return true; }
        L -= 1280;
        if (L < 256) { u.pm = 0; u.pn = L; u.job = 4; u.A = w8 + (size_t)1280 * 1024; u.B = h8 + (size_t)u.pn * (256 * 1024); return true; }
        return false;
    }
    __device__ __forceinline__ const int* rows(const pg::GUnit&) const { return nullptr; }
    __device__ __forceinline__ void epi(const f32x4 (&acc)[2][2][4][2], const pg::GUnit& u, int wr, int wc, int fr, int fq) const {
        bf16_t* O; float sc = 1.0f / W8_SCALE;
        if (u.job >= 3) {
            int ldo = 1024;
            if (u.job == 4) { O = WSP(bf16_t, WS_WAVT) + (size_t)u.pn * 256; ldo = MTOK; }
            else if (u.pn < 4) { O = WSP(bf16_t, WS_WAQ) + (size_t)u.pm * 256 * 1024 + u.pn * 256; sc *= 0.125f * LOG2E; }
            else { O = WSP(bf16_t, WS_WAK) + (size_t)u.pm * 256 * 256; ldo = 256; }
            pg::store_tile_bf16(acc, O, ldo, sc, wr, wc, fr, fq);
            return; }
        if (u.job == 0) { O = WSP(bf16_t, WS_XAQ) + (size_t)u.pm * 256 * 1024 + u.pn * 256; sc *= 0.0625f * LOG2E; }
        else if (u.pn < 4) O = WSP(bf16_t, WS_MK) + (size_t)u.pm * 256 * 1024 + u.pn * 256;
        else O = WSP(bf16_t, WS_MV) + (size_t)u.pm * 256 * 1024 + (u.pn - 4) * 256;
        if (XS_FP8) {
            if (u.job == 0) sc *= XQ8_SCALE;
            char* O8 = (char*)(P.ws + (u.job == 0 ? WS_XAQ : (u.pn < 4 ? WS_MK : WS_MV))) + (size_t)u.pm * 256 * 1024 + (u.pn & 3) * 256;
            const unsigned loff = (unsigned)((wr * 64 + fr) * 1024 + wc * 32 + 8 * fq);
#pragma unroll
            for (int ai = 0; ai < 2; ++ai)
#pragma unroll
                for (int m = 0; m < 4; ++m)
#pragma unroll
                    for (int bj = 0; bj < 2; ++bj) { const f32x4 a = acc[ai][bj][m][0] * sc, b2 = acc[ai][bj][m][1] * sc;
                        u32x2 w; w.x = pk4_fp8(a[0], a[1], a[2], a[3]); w.y = pk4_fp8(b2[0], b2[1], b2[2], b2[3]);
                        *(u32x2*)(O8 + (size_t)(ai * 128 + m * 16) * 1024 + bj * 128 + loff) = w; }
            return; }
        pg::store_tile_bf16(acc, O, 1024, sc, wr, wc, fr, fq);
    }
};

struct JobXA {
    Ptrs P; int G, c; int K, lda, ldb; LAS float* scr;
    __device__ __forceinline__ bool next(int i, pg::GUnit& u) const {
        const int L = i * G + c; if (L >= 1024) return false;
        u.job = 0; u.pm = L >> 2; u.pn = L & 3;
        if (XS_FP8) { u.A = (const char*)(P.ws + WS_XAQ) + (size_t)u.pm * (256 * 1024) + u.pn * 256;
                      u.B = (const char*)(P.ws + WS_MK) + (size_t)(u.pm >> 3) * (256 * 1024) + u.pn * 256; return true; }
        u.A = (const char*)(P.ws + WS_XAQ) + (size_t)u.pm * (256 * 1024 * 2) + u.pn * 512;
        u.B = (const char*)(P.ws + WS_MK) + (size_t)(u.pm >> 3) * (256 * 1024 * 2) + u.pn * 512; return true;
    }
    __device__ __forceinline__ const int* rows(const pg::GUnit&) const { return nullptr; }
    __device__ __forceinline__ void epi(f32x4 (&acc)[2][2][4][2], const pg::GUnit& u, int wr, int wc, int fr, int fq) const {
        LAS f32x2* X = (LAS f32x2*)scr;
        if (XS_FP8) {
#pragma unroll
            for (int ai = 0; ai < 2; ++ai)
#pragma unroll
                for (int bj = 0; bj < 2; ++bj)
#pragma unroll
                    for (int m = 0; m < 4; ++m)
#pragma unroll
                        for (int n = 0; n < 2; ++n) acc[ai][bj][m][n] = acc[ai][bj][m][n] * (1.0f / XQ8_SCALE); }
        float lm[2][4];
#pragma unroll
        for (int ai = 0; ai < 2; ++ai)
#pragma unroll
            for (int m = 0; m < 4; ++m) { float v = -3.0e38f;
#pragma unroll
                for (int bj = 0; bj < 2; ++bj)
#pragma unroll
                    for (int n = 0; n < 2; ++n) { const f32x4 a = acc[ai][bj][m][n]; v = fmaxf(v, fmaxf(fmaxf(a[0], a[1]), fmaxf(a[2], a[3]))); }
                v = fmaxf(v, __shfl_xor(v, 16)); v = fmaxf(v, __shfl_xor(v, 32));
                float sm = 0.f;
#pragma unroll
                for (int bj = 0; bj < 2; ++bj)
#pragma unroll
                    for (int n = 0; n < 2; ++n) { f32x4 a = acc[ai][bj][m][n];
#pragma unroll
                        for (int j = 0; j < 4; ++j) { a[j] = __builtin_amdgcn_exp2f(a[j] - v); sm += a[j]; }
                        acc[ai][bj][m][n] = a; }
                sm += __shfl_xor(sm, 16); sm += __shfl_xor(sm, 32);
                lm[ai][m] = v; if (fq == 0) X[(ai * 128 + wr * 64 + m * 16 + fr) * 4 + wc] = (f32x2){v, sm}; }
        LDS_WAIT(); __builtin_amdgcn_s_barrier(); asm volatile("" ::: "memory");
#pragma unroll
        for (int ai = 0; ai < 2; ++ai)
#pragma unroll
            for (int m = 0; m < 4; ++m) { const LAS f32x2* xp = X + (ai * 128 + wr * 64 + m * 16 + fr) * 4;
                const f32x2 p0 = xp[0], p1 = xp[1], p2 = xp[2], p3 = xp[3];
                const float M = fmaxf(fmaxf(p0[0], p1[0]), fmaxf(p2[0], p3[0]));
                const float tot = (p0[1] * __builtin_amdgcn_exp2f(p0[0] - M) + p1[1] * __builtin_amdgcn_exp2f(p1[0] - M)) + (p2[1] * __builtin_amdgcn_exp2f(p2[0] - M) + p3[1] * __builtin_amdgcn_exp2f(p3[0] - M));
                const float f = __builtin_amdgcn_exp2f(lm[ai][m] - M) / tot;
#pragma unroll
                for (int bj = 0; bj < 2; ++bj)
#pragma unroll
                    for (int n = 0; n < 2; ++n) acc[ai][bj][m][n] = acc[ai][bj][m][n] * f; }
        if (YC_FP8) { char* O8 = (char*)P.out + (size_t)u.pm * 256 * 1024 + u.pn * 256; const unsigned loff = (unsigned)((wr * 64 + fr) * 1024 + wc * 32 + 8 * fq);
#pragma unroll
            for (int ai = 0; ai < 2; ++ai)
#pragma unroll
                for (int m = 0; m < 4; ++m)
#pragma unroll
                    for (int bj = 0; bj < 2; ++bj) { const f32x4 a = acc[ai][bj][m][0] * P8_SCALE, b2 = acc[ai][bj][m][1] * P8_SCALE;
                        u32x2 w; w.x = pk4_fp8(a[0], a[1], a[2], a[3]); w.y = pk4_fp8(b2[0], b2[1], b2[2], b2[3]);
                        *(u32x2*)(O8 + (size_t)(ai * 128 + m * 16) * 1024 + bj * 128 + loff) = w; } }
        else { bf16_t* O = (bf16_t*)P.out + (size_t)u.pm * 256 * 1024 + u.pn * 256;
            pg::store_tile_bf16(acc, O, 1024, 1.f, wr, wc, fr, fq); }
        LDS_WAIT(); __builtin_amdgcn_s_barrier(); asm volatile("" ::: "memory");
    }
};
struct JobMVW {
    Ptrs P; int G, c; int K, lda, ldb;
    __device__ __forceinline__ bool next(int i, pg::GUnit& u) const {
        const int L = i * G + c; if (L >= 512) return false;
        u.job = 0; u.pm = L & 3; u.pn = L >> 2;
        if (XS_FP8) { u.A = (const char*)(P.ws + WS_WXAO) + (size_t)u.pm * (256 * 1024) + (u.pn & 3) * 256;
                      u.B = (const char*)(P.ws + WS_MV) + (size_t)(u.pn >> 2) * (256 * 1024) + (u.pn & 3) * 256; return true; }
        u.A = (const char*)(P.ws + WS_WXAO) + (size_t)u.pm * (256 * 1024 * 2) + (u.pn & 3) * 512;
        u.B = (const char*)(P.ws + WS_MV) + (size_t)(u.pn >> 2) * (256 * 1024 * 2) + (u.pn & 3) * 512; return true;
    }
    __device__ __forceinline__ const int* rows(const pg::GUnit&) const { return nullptr; }
    __device__ __forceinline__ void epi(const f32x4 (&acc)[2][2][4][2], const pg::GUnit& u, int wr, int wc, int fr, int fq) const {
        if (YC_FP8) { char* O8 = (char*)(P.ws + WS_MVW) + (size_t)(u.pn >> 2) * (1024 * 1024) + (size_t)u.pm * 256 * 1024 + (u.pn & 3) * 256;
            const unsigned loff = (unsigned)((wr * 64 + fr) * 1024 + wc * 32 + 8 * fq);
#pragma unroll
            for (int ai = 0; ai < 2; ++ai)
#pragma unroll
                for (int m = 0; m < 4; ++m)
#pragma unroll
                    for (int bj = 0; bj < 2; ++bj) { const float ms = XS_FP8 ? MVW8_SCALE / W8_SCALE : MVW8_SCALE; const f32x4 a = acc[ai][bj][m][0] * ms, b2 = acc[ai][bj][m][1] * ms;
                        u32x2 w; w.x = pk4_fp8(a[0], a[1], a[2], a[3]); w.y = pk4_fp8(b2[0], b2[1], b2[2], b2[3]);
                        *(u32x2*)(O8 + (size_t)(ai * 128 + m * 16) * 1024 + bj * 128 + loff) = w; } }
        else { bf16_t* O = WSP(bf16_t, WS_MVW) + (size_t)(u.pn >> 2) * (1024 * 1024) + (size_t)u.pm * 256 * 1024 + (u.pn & 3) * 256;
            pg::store_tile_bf16(acc, O, 1024, 1.f, wr, wc, fr, fq); }
    }
};

__device__ __forceinline__ char* sg_base(const Ptrs& P, int br) {
    return br == 0 ? (char*)(P.ws + WS_SG0) : br == 1 ? (char*)(P.ws + WS_SG1) : (GATES_FP8 ? (char*)(P.ws + WS_H) : (char*)P.out + 128 * MiB);
}
struct JobMergeG {
    Ptrs P; int G, c; int K, lda, ldb;
    __device__ __forceinline__ bool next(int i, pg::GUnit& u) const {
        if (i >= 12) return false;
        const int ti = i / 3, br = i - ti * 3;
        pg::xcd_map(ti * G + c, 256, 4, u.pm, u.pn); u.job = br;
        if (GATES_FP8) { u.A = (const char*)P.out + 128 * MiB + (size_t)u.pm * (256 * 1024); u.B = (const char*)(P.ws + (INPROJ_FP8 ? WS_WIN + (size_t)R_GATE * 1024 : WS_WG8)) + (size_t)(br * 1024 + u.pn * 256) * 1024; }
        else { u.A = (const char*)(P.ws + WS_H) + (size_t)u.pm * (256 * 1024 * 2); u.B = (const char*)(P.ws + WS_WIN) + (size_t)(R_GATE + br * 1024 + u.pn * 256) * 2048; }
        return true;
    }
    __device__ __forceinline__ const int* rows(const pg::GUnit&) const { return nullptr; }
    __device__ __forceinline__ void epi(const f32x4 (&acc)[2][2][4][2], const pg::GUnit& u, int wr, int wc, int fr, int fq) const {
        char* OB = sg_base(P, u.job) + ((size_t)u.pm * 256 * 1024 + u.pn * 256) * 2;
        const unsigned loff = (unsigned)((wr * 64 + fr) * 1024 + wc * 32 + 8 * fq) * 2u;
        constexpr float sc = GATES_FP8 ? (1.0f / W8_SCALE) : 1.0f;
#pragma unroll
        for (int ai = 0; ai < 2; ++ai)
#pragma unroll
            for (int m = 0; m < 4; ++m)
#pragma unroll
                for (int bj = 0; bj < 2; ++bj) { const unsigned uo = (unsigned)((ai * 128 + m * 16) * 1024 + bj * 128) * 2u;
                    const f32x4 a = acc[ai][bj][m][0] * (-LOG2E * sc), b = acc[ai][bj][m][1] * (-LOG2E * sc);
#define MG_SIG(v) __builtin_amdgcn_rcpf(1.0f + __builtin_amdgcn_exp2f(v))
                    u32x4 w; w.x = cvt_pk_bf16_c(MG_SIG(a[0]), MG_SIG(a[1])); w.y = cvt_pk_bf16_c(MG_SIG(a[2]), MG_SIG(a[3]));
                    w.z = cvt_pk_bf16_c(MG_SIG(b[0]), MG_SIG(b[1])); w.w = cvt_pk_bf16_c(MG_SIG(b[2]), MG_SIG(b[3]));
#undef MG_SIG
                    *(u32x4*)(OB + uo + loff) = w; }
    }
};
struct JobMergeY {
    Ptrs P; int G, c; int K, lda, ldb; int mode;
    __device__ __forceinline__ bool next(int i, pg::GUnit& u) const {
        int ti, br;
        if (mode == 0) { if (i >= 12) return false; ti = i / 3; br = i - ti * 3; }
        else if (mode == 1) { if (i >= 8) return false; ti = i >> 1; br = i & 1; }
        else { if (i >= 4) return false; ti = i; br = 2; }
        pg::xcd_map(ti * G + c, 256, 4, u.pm, u.pn); u.job = br;
        if (mode == 2) { u.A = (const char*)P.out + (size_t)u.pm * (256 * 1024); u.B = (const char*)(P.ws + WS_MVW) + (size_t)(u.pm >> 3) * (1024 * 1024) + (size_t)u.pn * (256 * 1024); return true; }
        if (br == 0) { u.A = (const char*)(P.ws + WS_DAQ) + (size_t)u.pm * (256 * 1024 * 2); u.B = (const char*)(P.ws + WS_WDAO) + (size_t)u.pn * (256 * 1024 * 2); }
        else if (br == 1) { u.A = (const char*)(P.ws + WS_WAQ) + (size_t)u.pm * (256 * 1024 * 2); u.B = (const char*)(P.ws + WS_WWAO) + (size_t)u.pn * (256 * 1024 * 2); }
        else { u.A = (const char*)P.out + (size_t)u.pm * (256 * 1024 * 2); u.B = (const char*)(P.ws + WS_MVW) + (size_t)(u.pm >> 3) * (1024 * 1024 * 2) + (size_t)u.pn * (256 * 1024 * 2); }
        return true;
    }
    __device__ __forceinline__ const int* rows(const pg::GUnit&) const { return nullptr; }
    __device__ __forceinline__ void epi(const f32x4 (&acc)[2][2][4][2], const pg::GUnit& u, int wr, int wc, int fr, int fq) const {
        const size_t tileoff = ((size_t)u.pm * 256 * 1024 + u.pn * 256) * 2;
        const char* SGb = sg_base(P, u.job) + tileoff; char* MGb = (char*)(P.ws + WS_MERGED) + tileoff;
        const unsigned loff = (unsigned)((wr * 64 + fr) * 1024 + wc * 32 + 8 * fq) * 2u;
        const bool hasPrev = u.job != 0;
        const float ysc = (mode == 2) ? 1.0f / (P8_SCALE * MVW8_SCALE) : 1.0f;
#pragma unroll
        for (int ai = 0; ai < 2; ++ai) {
            u32x4 g[4][2], pv[4][2];
#pragma unroll
            for (int m = 0; m < 4; ++m)
#pragma unroll
                for (int bj = 0; bj < 2; ++bj) { const unsigned uo = (unsigned)((ai * 128 + m * 16) * 1024 + bj * 128) * 2u;
                    g[m][bj] = __builtin_nontemporal_load((const u32x4*)(SGb + uo + loff));
                    pv[m][bj] = (u32x4){0u, 0u, 0u, 0u};
                    if (hasPrev) pv[m][bj] = __builtin_nontemporal_load((const u32x4*)(MGb + uo + loff)); }
#pragma unroll
            for (int m = 0; m < 4; ++m)
#pragma unroll
                for (int bj = 0; bj < 2; ++bj) { const unsigned uo = (unsigned)((ai * 128 + m * 16) * 1024 + bj * 128) * 2u;
                    const f32x4 a = acc[ai][bj][m][0] * ysc, b = acc[ai][bj][m][1] * ysc;
                    const u32x4 gq = g[m][bj], pq = pv[m][bj];
                    u32x4 w;
                    w.x = cvt_pk_bf16(bf_lo(pq.x) + bf_lo(gq.x) * a[0], bf_hi(pq.x) + bf_hi(gq.x) * a[1]);
                    w.y = cvt_pk_bf16(bf_lo(pq.y) + bf_lo(gq.y) * a[2], bf_hi(pq.y) + bf_hi(gq.y) * a[3]);
                    w.z = cvt_pk_bf16(bf_lo(pq.z) + bf_lo(gq.z) * b[0], bf_hi(pq.z) + bf_hi(gq.z) * b[1]);
                    w.w = cvt_pk_bf16(bf_lo(pq.w) + bf_lo(gq.w) * b[2], bf_hi(pq.w) + bf_hi(gq.w) * b[3]);
                    *(u32x4*)(MGb + uo + loff) = w; }
            asm volatile("" ::: "memory"); }
    }
};

struct JobOut {
    Ptrs P; int G, c; int K, lda, ldb;
    __device__ __forceinline__ bool next(int i, pg::GUnit& u) const {
        const int L = i * G + c; if (L >= 1024) return false;
        pg::xcd_map(L, 256, 4, u.pm, u.pn); u.job = 0;
        u.A = (const char*)(P.ws + WS_MERGED) + (size_t)u.pm * (256 * 1024 * 2); u.B = (const char*)(P.ws + WS_WOUT) + (size_t)u.pn * (256 * 1024 * 2); return true;
    }
    __device__ __forceinline__ const int* rows(const pg::GUnit&) const { return nullptr; }
    __device__ __forceinline__ void epi(const f32x4 (&acc)[2][2][4][2], const pg::GUnit& u, int wr, int wc, int fr, int fq) const {
        const int row0 = u.pm * 256 + wr * 64 + fr, col0 = u.pn * 256 + wc * 32 + 8 * fq;
#pragma unroll
        for (int ai = 0; ai < 2; ++ai)
#pragma unroll
            for (int m = 0; m < 4; ++m) { const size_t off = (size_t)(row0 + ai * 128 + m * 16) * 1024 + col0;
#pragma unroll
                for (int bj = 0; bj < 2; ++bj) { const f32x4 x0 = *(const f32x4*)(P.x + off + bj * 128), x1 = *(const f32x4*)(P.x + off + bj * 128 + 4);
                    const f32x4 v0 = x0 + acc[ai][bj][m][0], v1 = x1 + acc[ai][bj][m][1];
                    u32x4 w; w.x = cvt_pk_bf16(v0[0], v0[1]); w.y = cvt_pk_bf16(v0[2], v0[3]); w.z = cvt_pk_bf16(v1[0], v1[1]); w.w = cvt_pk_bf16(v1[2], v1[3]);
                    *(u32x4*)(WSP(bf16_t, WS_X1) + off + bj * 128) = w; } }
    }
};
struct JobGU {
    Ptrs P; int G, c; int K, lda, ldb;
    __device__ __forceinline__ bool next(int i, pg::GUnit& u) const {
        const int L = i * G + c; if (L >= 8192) return false;
        pg::xcd_map(L, 512, 16, u.pm, u.pn); u.job = 0;
        u.A = (const char*)(P.ws + WS_H2);
        u.B = (const char*)(P.ws + WS_WGU) + (size_t)(u.pm >> 5) * (4096 * 1024) + (size_t)u.pn * (256 * 1024); return true;
    }
    __device__ __forceinline__ const int* rows(const pg::GUnit& u) const { const int e = u.pm >> 5, b = u.pm & 31; return WSP(const int, WS_IDX) + (b * 16 + e) * 256; }
    __device__ __forceinline__ void epi(const f32x4 (&acc)[2][2][4][2], const pg::GUnit& u, int wr, int wc, int fr, int fq) const {
        char* O = (char*)(P.ws + WS_ACTB) + (size_t)u.pm * 256 * 2048 + u.pn * 128;
        const unsigned loff = (unsigned)((wr * 64 + fr) * 2048 + wc * 32 + 8 * fq);
        constexpr float IS = 1.0f / W8_SCALE, KX = -LOG2E * IS, IC = 1.0f / (IS * IS * ACT8_SCALE);
#pragma unroll
        for (int ai = 0; ai < 2; ++ai)
#pragma unroll
            for (int m = 0; m < 4; ++m) {
                f32x2 o[2][2];
#pragma unroll
                for (int n = 0; n < 2; ++n)
#pragma unroll
                    for (int p = 0; p < 2; ++p) {
                        const f32x2 g = p ? __builtin_shufflevector(acc[ai][0][m][n], acc[ai][0][m][n], 2, 3) : __builtin_shufflevector(acc[ai][0][m][n], acc[ai][0][m][n], 0, 1);
                        const f32x2 up = p ? __builtin_shufflevector(acc[ai][1][m][n], acc[ai][1][m][n], 2, 3) : __builtin_shufflevector(acc[ai][1][m][n], acc[ai][1][m][n], 0, 1);
                        const f32x2 t = g * up, x = g * KX;
                        f32x2 e; e.x = __builtin_amdgcn_exp2f(x.x); e.y = __builtin_amdgcn_exp2f(x.y);
                        const f32x2 d = e * IC + IC;
                        f32x2 r; r.x = __builtin_amdgcn_rcpf(d.x); r.y = __builtin_amdgcn_rcpf(d.y);
                        o[n][p] = t * r; }
                u32x2 w; w.x = pk4_fp8(o[0][0].x, o[0][0].y, o[0][1].x, o[0][1].y); w.y = pk4_fp8(o[1][0].x, o[1][0].y, o[1][1].x, o[1][1].y);
                *(u32x2*)(O + (size_t)(ai * 128 + m * 16) * 2048 + loff) = w; }
    }
};
struct JobDown {
    Ptrs P; int G, c; int K, lda, ldb;
    __device__ __forceinline__ bool next(int i, pg::GUnit& u) const {
        const int L = i * G + c; if (L >= 2048) return false;
        pg::xcd_map(L, 512, 4, u.pm, u.pn); u.job = 0;
        u.A = (const char*)(P.ws + WS_ACTB) + (size_t)u.pm * (256 * 2048);
        u.B = (const char*)(P.ws + WS_WD) + (size_t)(u.pm >> 5) * (1024 * 2048) + (size_t)u.pn * (256 * 2048); return true;
    }
    __device__ __forceinline__ const int* rows(const pg::GUnit&) const { return nullptr; }
    __device__ __forceinline__ void epi(const f32x4 (&acc)[2][2][4][2], const pg::GUnit& u, int wr, int wc, int fr, int fq) const {
        char* O = (char*)(P.ws + WS_YE) + (size_t)u.pm * 256 * 1024 + u.pn * 256;
        const unsigned loff = (unsigned)((wr * 64 + fr) * 1024 + wc * 32 + 8 * fq);
        constexpr float sc = YE8_SCALE / (W8_SCALE * ACT8_SCALE);
#pragma unroll
        for (int ai = 0; ai < 2; ++ai)
#pragma unroll
            for (int m = 0; m < 4; ++m)
#pragma unroll
                for (int bj = 0; bj < 2; ++bj) { const f32x4 a = acc[ai][bj][m][0] * sc, b2 = acc[ai][bj][m][1] * sc;
                    u32x2 w; w.x = pk4_fp8(a[0], a[1], a[2], a[3]); w.y = pk4_fp8(b2[0], b2[1], b2[2], b2[3]);
                    *(u32x2*)(O + (size_t)(ai * 128 + m * 16) * 1024 + bj * 128 + loff) = w; }
    }
};

namespace fa {
__device__ __forceinline__ void glds16(const void* g, LAS unsigned char* l) { __builtin_amdgcn_global_load_lds((const unsigned*)g, (LAS unsigned*)l, 16, 0, 0); }
__device__ __forceinline__ void glds16_s(const char* sbase, unsigned voff, unsigned ldsaddr) { unsigned keep;
    asm volatile("s_mov_b32 %0, m0\n\ts_mov_b32 m0, %3\n\ts_nop 0\n\tglobal_load_lds_dwordx4 %1, %2\n\ts_mov_b32 m0, %0" : "=&s"(keep) : "v"(voff), "s"(sbase), "s"(ldsaddr) : "memory"); }
__device__ __forceinline__ float max3f(float a, float b, float c) { float r; asm volatile("v_max3_f32 %0, %1, %2, %3" : "=v"(r) : "v"(a), "v"(b), "v"(c)); return r; }
#define FA_ROWMAX(_m, Y0, Y1) do { \
        float _g0 = __builtin_amdgcn_fmed3f(Y0[0], Y0[1], Y0[2]); asm volatile("" : "+v"(_g0)); \
        float _g1 = __builtin_amdgcn_fmed3f(Y1[0], Y1[1], Y1[2]); asm volatile("" : "+v"(_g1)); \
        _m = max3f(Y0[0], Y0[1], Y0[2]); float _m2 = max3f(Y1[0], Y1[1], Y1[2]); \
        _Pragma("unroll") for (int _r = 3; _r < 15; _r += 2) { _m = max3f(_m, Y0[_r], Y0[_r + 1]); _m2 = max3f(_m2, Y1[_r], Y1[_r + 1]); } \
        _m = max3f(_m, Y0[15], Y1[15]); _m = max3f(_m, _m2, _m2); { float _o = __shfl_xor(_m, 32); _m = max3f(_m, _o, _o); } } while (0)
constexpr float THR = 16.0f;
#define FA_SB() __builtin_amdgcn_sched_barrier(0)

template <int MODE>
__device__ __forceinline__ void flash_unit(LAS unsigned char* lds, const Ptrs& P, int b, int hd, int qblk, float lam) {
    constexpr bool DA = (MODE == 0);
    constexpr int NDB = DA ? 4 : 2;
    constexpr int NPV = 4 * NDB;
    constexpr int STG = DA ? 32768 : 16384, VOFF = DA ? 16384 : 8192;
    const int tid = threadIdx.x, lane = tid & 63, r32 = lane & 31, hi = lane >> 5, w = __builtin_amdgcn_readfirstlane(tid >> 6);
    int q0, qw, NT, tlo, ts, thi; bool notrack = false;
    const bf16_t *Qp, *Kp, *Vp; bf16_t* Op; int kld; float slope2;
    if constexpr (DA) {
        q0 = qblk * 128; const int map = w >> 2; qw = q0 + (w & 3) * 32;
        Qp = WSP(const bf16_t, WS_DAQ) + (size_t)(b * SEQ) * 1024 + hd * 128 + map * 64;
        Kp = WSP(const bf16_t, WS_DAK) + (size_t)(b * SEQ) * 1024 + hd * 128;
        Vp = WSP(const bf16_t, WS_DAVT) + (size_t)(hd * 128) * MTOK + (size_t)b * SEQ;
        Op = WSP(bf16_t, WS_DAQ) + (size_t)(b * SEQ) * 1024 + hd * 128;
        kld = 1024; NT = 32; tlo = 0; thi = 31; ts = q0 >> 6;
        slope2 = LOG2E * __builtin_amdgcn_exp2f(-(float)(hd + 1));
    } else {
        q0 = qblk * 256; qw = q0 + w * 32; const int kvh = hd >> 2;
        Qp = WSP(const bf16_t, WS_WAQ) + (size_t)(b * SEQ) * 1024 + hd * 64;
        Kp = WSP(const bf16_t, WS_WAK) + (size_t)(b * SEQ) * 256 + kvh * 64;
        Vp = WSP(const bf16_t, WS_WAVT) + (size_t)(kvh * 64) * MTOK + (size_t)b * SEQ;
        Op = WSP(bf16_t, WS_WAQ) + (size_t)(b * SEQ) * 1024 + hd * 64;
        kld = 256; tlo = 4 * qblk - 2; if (tlo < 0) tlo = 0; thi = 4 * qblk + 5; if (thi > 31) thi = 31; ts = 4 * qblk; NT = thi - tlo + 1;
        slope2 = LOG2E * __builtin_amdgcn_exp2f(-0.5f * (float)(hd + 1));
    }
    const int Rk = w * 8 + (lane >> 3), slot = lane & 7;
    const bf16_t* srcK0 = Kp + (size_t)Rk * kld + ((slot ^ ((Rk >> 1) & 7)) * 8);
    const bf16_t* srcV0 = Vp + (size_t)Rk * MTOK + ((slot ^ ((Rk >> 1) & 7)) * 8);
    const bf16_t* srcV1 = Vp + (size_t)(Rk + 64) * MTOK + ((slot ^ (((Rk + 64) >> 1) & 7)) * 8);
    const unsigned koffb = (unsigned)(Rk * kld + ((slot ^ ((Rk >> 1) & 7)) * 8)) * 2u;
    const unsigned voffb0 = (unsigned)(Rk * MTOK + ((slot ^ ((Rk >> 1) & 7)) * 8)) * 2u, voffb1 = (unsigned)((Rk + 64) * MTOK + ((slot ^ (((Rk + 64) >> 1) & 7)) * 8)) * 2u;
    const unsigned ldsw0 = (unsigned)__builtin_amdgcn_readfirstlane((int)((unsigned)(uintptr_t)lds + (unsigned)w * 1024u));
#define FA_DMAK(t, stg) do { LAS unsigned char* _s = lds + (stg) * STG; \
        if constexpr (DA) { const char* _kb = (const char*)Kp + (size_t)(t) * (64 * 1024 * 2); const unsigned _la = ldsw0 + (unsigned)((stg) * STG); \
            glds16_s(_kb, koffb, _la); glds16_s(_kb, koffb + 128u, _la + 8192u); } \
        else { glds16(srcK0 + (size_t)(t) * 64 * 256, _s + w * 1024); } } while (0)
#define FA_DMAV(t, stg) do { LAS unsigned char* _s = lds + (stg) * STG; \
        if constexpr (DA) { const char* _vb = (const char*)Vp + (size_t)(t) * 128; const unsigned _la = ldsw0 + (unsigned)((stg) * STG + VOFF); \
            glds16_s(_vb, voffb0, _la); glds16_s(_vb, voffb1, _la + 8192u); } \
        else { glds16(srcV0 + (t) * 64, _s + VOFF + w * 1024); } } while (0)
#define FA_TILE(i) ((ts + (i) <= thi) ? ts + (i) : tlo + ((i) - (thi - ts + 1)))
    FA_DMAK(FA_TILE(0), 0);
    bf16x8 qf[4];
    { const bf16_t* qp = Qp + (size_t)(qw + r32) * 1024 + hi * 8;
#pragma unroll
      for (int d = 0; d < 4; ++d) qf[d] = *(const bf16x8*)(qp + d * 16); }
    if constexpr (DA) {
        float qs = 0.f;
#pragma unroll
        for (int d = 0; d < 4; ++d)
#pragma unroll
            for (int jj = 0; jj < 8; ++jj) { const float x = __uint_as_float(((unsigned)(unsigned short)qf[d][jj]) << 16); qs += x * x; }
        qs += __shfl_xor(qs, 32);
#pragma unroll
        for (int off = 1; off < 32; off <<= 1) qs = fmaxf(qs, __shfl_xor(qs, off));
        volatile LAS float* qsc = (volatile LAS float*)(lds + MISC_OFF + 64);
        if (lane == 0) qsc[w] = qs;
        LDS_WAIT(); __builtin_amdgcn_s_barrier(); asm volatile("" ::: "memory");
        float qn2 = qsc[0];
#pragma unroll
        for (int i = 1; i < 8; ++i) qn2 = fmaxf(qn2, qsc[i]);
        const float kn2 = __uint_as_float(WSP(const unsigned, WS_KMAX)[b * 8 + hd]);
        const float qk = sqrtf(qn2 * kn2);
        notrack = __builtin_amdgcn_readfirstlane((int)(qk < 100.0f)) != 0;
        float wf = (46.0f + 2.0f * qk) / slope2; wf = fminf(wf, 4096.0f);
        const int W = __builtin_amdgcn_readfirstlane((int)wf + 1);
        tlo = (q0 - W) < 0 ? 0 : ((q0 - W) >> 6); thi = (q0 + 127 + W) >> 6; if (thi > 31) thi = 31;
        if (((thi - tlo) & 1) == 0) { if (thi < 31) ++thi; else --tlo; }
        NT = thi - tlo + 1;
    }
    const int krow = (r32 & 0x13) | ((r32 & 4) << 1) | ((r32 & 8) >> 1), ksw = (krow >> 1) & 7, vsw = (r32 >> 1) & 7;
    const LAS unsigned char* kp[4]; const LAS unsigned char* vp[4];
#pragma unroll
    for (int d = 0; d < 4; ++d) kp[d] = lds + (DA ? (w >> 2) * 8192 : 0) + krow * 128 + (((2 * d + hi) ^ ksw) * 16);
#pragma unroll
    for (int ks = 0; ks < 4; ++ks) vp[ks] = lds + r32 * 128 + (((4 * (ks >> 1) + 2 * (ks & 1) + hi) ^ vsw) * 16);
    f32x16 o[NDB];
#pragma unroll
    for (int d = 0; d < NDB; ++d) o[d] = (f32x16){0.f, 0.f, 0.f, 0.f, 0.f, 0.f, 0.f, 0.f, 0.f, 0.f, 0.f, 0.f, 0.f, 0.f, 0.f, 0.f};
    f32x16 A0, A1, B0, B1;
    B0 = o[0]; B1 = o[0];
    float mref = 0.f, negm = 0.f, l = 0.f, fsave = 1.f; bool resc = false;
    const int qpos = qw + r32; const float nslope = -slope2;
    u32x4 pk[4]; bf16x8 kf[4], vf[8];
#define FA_EL(X0, X1, e) (((e) < 16) ? X0[(e) & 15] : X1[(e) & 15])
#define FA_SETEL(X0, X1, e, v) do { if ((e) < 16) X0[(e) & 15] = (v); else X1[(e) & 15] = (v); } while (0)
#define FA_NOFF(e) (32 * ((e) >> 4) + 16 * (((e) & 15) >> 3) + ((e) & 7))
#define FA_BIAS1(X0, X1, e) do { const float _x = t0n - (float)FA_NOFF(e); float _c = __builtin_fmaf(nslope, __builtin_fabsf(_x), negm); \
        if constexpr (!DA) _c = (__builtin_fabsf(_x) > 128.0f) ? -1.0e30f : _c; asm volatile("" : "+v"(_c)); FA_SETEL(X0, X1, e, _c); } while (0)
#define FA_BIASC(X0, X1, e) do { float _c = __builtin_fmaf(bd1, (float)FA_NOFF(e), bbase); asm volatile("" : "+v"(_c)); FA_SETEL(X0, X1, e, _c); } while (0)
#define FA_T0(dst, t) do { float _t = (float)(qpos - 64 * (t) - 8 * hi); asm volatile("" : "+v"(_t)); dst = _t; } while (0)
#define FA_STEP(Y0, Y1, X0, X1, KS, VB, T, TN, HASN, TRK, PV, CH) do { \
        if (HASN) FA_DMAK(TN, (KS) ^ 1); \
        FA_DMAV(T, KS); \
        _Pragma("unroll") for (int _j = 0; _j < 4; ++_j) kf[_j] = *(const LAS bf16x8*)(kp[_j >> 1] + (KS) * STG + (_j & 1) * 4096); \
        if (PV) { _Pragma("unroll") for (int _f = 0; _f < 8; ++_f) vf[_f] = *(const LAS bf16x8*)(vp[DA ? (_f >> 2) : (_f >> 1)] + (VB) + (DA ? (_f & 3) : (_f & 1)) * 4096); } \
        float t0n; FA_T0(t0n, TN); \
        float sacc = 0.f; FA_SB(); \
        _Pragma("unroll") for (int _j = 0; _j < 8; ++_j) { \
            if (_j & 1) Y1 = __builtin_amdgcn_mfma_f32_32x32x16_bf16(kf[_j & 3], qf[_j >> 1], Y1, 0, 0, 0); \
            else        Y0 = __builtin_amdgcn_mfma_f32_32x32x16_bf16(kf[_j & 3], qf[_j >> 1], Y0, 0, 0, 0); \
            if (_j < 4) kf[_j] = *(const LAS bf16x8*)(kp[(_j + 4) >> 1] + (KS) * STG + (_j & 1) * 4096); \
            { const float _a = FA_EL(X0, X1, 4 * _j), _b = FA_EL(X0, X1, 4 * _j + 1), _c = FA_EL(X0, X1, 4 * _j + 2), _d = FA_EL(X0, X1, 4 * _j + 3); \
              sacc += (_a + _b) + (_c + _d); asm volatile("" : "+v"(sacc)); pk[_j >> 1][2 * (_j & 1)] = cvt_pk_bf16(_a, _b); pk[_j >> 1][2 * (_j & 1) + 1] = cvt_pk_bf16(_c, _d); } \
            FA_SB(); } \
        l += sacc; \
        if (TRK) { float _m; FA_ROWMAX(_m, Y0, Y1); resc = false; \
          if (__builtin_expect(__any(_m > THR), 0)) { const float _dl = fmaxf(_m, 0.f); mref += _dl; negm = -mref; fsave = __builtin_amdgcn_exp2f(-_dl); l *= fsave; resc = true; \
              _Pragma("unroll") for (int _r = 0; _r < 16; ++_r) { Y0[_r] -= _dl; Y1[_r] -= _dl; } } } \
        float bbase = 0.f, bd1 = 0.f; if (CH) { const float _sn = ((TN) > ts) ? -nslope : nslope; bbase = __builtin_fmaf(_sn, t0n, negm); bd1 = -_sn; } \
        FA_SB(); \
        _Pragma("unroll") for (int _i = 0; _i < NPV; ++_i) { \
            if (PV) { o[DA ? (_i & 3) : (_i & 1)] = __builtin_amdgcn_mfma_f32_32x32x16_bf16(vf[_i & 7], __builtin_bit_cast(bf16x8, pk[DA ? (_i >> 2) : (_i >> 1)]), o[DA ? (_i & 3) : (_i & 1)], 0, 0, 0); \
              if (DA && _i < 8) vf[_i] = *(const LAS bf16x8*)(vp[(_i + 8) >> 2] + (VB) + ((_i + 8) & 3) * 4096); } \
            _Pragma("unroll") for (int _e = 0; _e < 32 / NPV; ++_e) { const int _q = (32 / NPV) * _i + _e; \
                { float _ev = __builtin_amdgcn_exp2f(FA_EL(Y0, Y1, _q)); asm volatile("" : "+v"(_ev)); FA_SETEL(Y0, Y1, _q, _ev); } if (CH) FA_BIASC(X0, X1, _q); else FA_BIAS1(X0, X1, _q); } \
            FA_SB(); } \
        asm volatile("s_waitcnt vmcnt(0) lgkmcnt(0)" ::: "memory"); __builtin_amdgcn_s_barrier(); asm volatile("" ::: "memory"); \
        if (TRK && __builtin_expect(resc, 0)) { _Pragma("unroll") for (int _d = 0; _d < NDB; ++_d) _Pragma("unroll") for (int _r = 0; _r < 16; ++_r) o[_d][_r] *= fsave; } \
    } while (0)
    { float t0n; FA_T0(t0n, FA_TILE(0));
#pragma unroll
      for (int e = 0; e < 32; ++e) FA_BIAS1(A0, A1, e); }
    asm volatile("s_waitcnt vmcnt(0)" ::: "memory"); __builtin_amdgcn_s_barrier(); asm volatile("" ::: "memory");
    const bool trk = !(DA && notrack);
    { const int t0_ = FA_TILE(0), t1_ = FA_TILE(1), t2_ = FA_TILE(2);
      FA_STEP(A0, A1, B0, B1, 0, 0, t0_, t1_, true, trk, false, false);
      FA_STEP(B0, B1, A0, A1, 1, VOFF, t1_, t2_, true, trk, true, DA); }
    for (int i = 2; i < NT; i += 2) {
        const int ta = FA_TILE(i), tb = FA_TILE(i + 1), tc = (i + 2 < NT) ? FA_TILE(i + 2) : FA_TILE(i + 1);
        FA_STEP(A0, A1, B0, B1, 0, STG + VOFF, ta, tb, true, trk, true, DA);
        FA_STEP(B0, B1, A0, A1, 1, VOFF, tb, tc, (i + 2 < NT), trk, true, DA); }
    { float sacc = 0.f;
#pragma unroll
      for (int j = 0; j < 8; ++j) { const float a_ = FA_EL(B0, B1, 4 * j), b_ = FA_EL(B0, B1, 4 * j + 1), c_ = FA_EL(B0, B1, 4 * j + 2), d_ = FA_EL(B0, B1, 4 * j + 3);
          sacc += (a_ + b_) + (c_ + d_); pk[j >> 1][2 * (j & 1)] = cvt_pk_bf16(a_, b_); pk[j >> 1][2 * (j & 1) + 1] = cvt_pk_bf16(c_, d_); }
      l += sacc;
#pragma unroll
      for (int i = 0; i < NPV; ++i) { const int ks = DA ? (i >> 2) : (i >> 1), d = DA ? (i & 3) : (i & 1);
          const bf16x8 v = *(const LAS bf16x8*)(vp[ks] + STG + VOFF + d * 4096);
          o[d] = __builtin_amdgcn_mfma_f32_32x32x16_bf16(v, __builtin_bit_cast(bf16x8, pk[ks]), o[d], 0, 0, 0); } }
    LDS_WAIT(); __builtin_amdgcn_s_barrier(); asm volatile("" ::: "memory");
    l += __shfl_xor(l, 32);
    if constexpr (DA) {
        const float il = 1.0f / l;
        LAS float* ex = (LAS float*)lds + (w & 3) * 4096;
        if (w >= 4) {
#pragma unroll
            for (int d = 0; d < 4; ++d)
#pragma unroll
                for (int r = 0; r < 16; ++r) ex[(d * 16 + r) * 64 + lane] = o[d][r] * il;
        }
        LDS_WAIT(); __builtin_amdgcn_s_barrier(); asm volatile("" ::: "memory");
        if (w < 4) {
            float ss = 0.f;
#pragma unroll
            for (int d = 0; d < 4; ++d)
#pragma unroll
                for (int r = 0; r < 16; ++r) { const float v = o[d][r] * il - lam * ex[(d * 16 + r) * 64 + lane]; o[d][r] = v; ss += v * v; }
            ss += __shfl_xor(ss, 32);
            const float rs = (1.0f - LAM_INIT) * __builtin_amdgcn_rsqf(ss * (1.0f / 128.0f) + EPS);
            bf16_t* op = Op + (size_t)(qw + r32) * 1024;
#pragma unroll
            for (int d = 0; d < 4; ++d)
#pragma unroll
                for (int gp = 0; gp < 2; ++gp) { u32x2 pw[2];
#pragma unroll
                    for (int gg = 0; gg < 2; ++gg) { const int g = 2 * gp + gg, dd = d * 32 + 8 * g + 4 * hi; const f32x4 sg = *(const f32x4*)(P.subln_g + dd);
                        pw[gg].x = cvt_pk_bf16(o[d][4 * g] * rs * sg[0], o[d][4 * g + 1] * rs * sg[1]); pw[gg].y = cvt_pk_bf16(o[d][4 * g + 2] * rs * sg[2], o[d][4 * g + 3] * rs * sg[3]); }
                    const unsigned sx = hi ? pw[0].x : pw[1].x, sy = hi ? pw[0].y : pw[1].y;
                    const unsigned rx = (unsigned)__shfl_xor((int)sx, 32), ry = (unsigned)__shfl_xor((int)sy, 32);
                    u32x4 wv; if (hi) { wv.x = rx; wv.y = ry; wv.z = pw[1].x; wv.w = pw[1].y; } else { wv.x = pw[0].x; wv.y = pw[0].y; wv.z = rx; wv.w = ry; }
                    *(u32x4*)(op + d * 32 + 16 * gp + 8 * hi) = wv; }
        }
    } else {
        const float sink2 = P.wa_sink[hd] * LOG2E;
        const float lt = l + __builtin_amdgcn_exp2f(sink2 - mref);
        const float il = 1.0f / lt;
        bf16_t* op = Op + (size_t)(qw + r32) * 1024;
#pragma unroll
        for (int d = 0; d < 2; ++d)
#pragma unroll
            for (int g = 0; g < 4; ++g) { const int dd = d * 32 + 8 * g + 4 * hi;
                u32x2 wv; wv.x = cvt_pk_bf16(o[d][4 * g] * il, o[d][4 * g + 1] * il); wv.y = cvt_pk_bf16(o[d][4 * g + 2] * il, o[d][4 * g + 3] * il);
                *(u32x2*)(op + dd) = wv; }
    }
    asm volatile("s_waitcnt vmcnt(0) lgkmcnt(0)" ::: "memory"); __builtin_amdgcn_s_barrier(); asm volatile("" ::: "memory");
#undef FA_DMAK
#undef FA_DMAV
#undef FA_TILE
#undef FA_EL
#undef FA_SETEL
#undef FA_NOFF
#undef FA_BIAS1
#undef FA_BIASC
#undef FA_T0
#undef FA_STEP
}
#undef FA_SB
__device__ __forceinline__ void wa_group(LAS unsigned char* lds, const Ptrs& P, int b, int kvh, int qblk) {
    constexpr int NDB = 2, NPV = 8, TSZ = 16384, VOFF = 8192;
    const int tid = threadIdx.x, lane = tid & 63, r32 = lane & 31, hi = lane >> 5, w = __builtin_amdgcn_readfirstlane(tid >> 6);
    const int q0 = qblk * 256, qw = q0 + w * 32;
    int tlo = 4 * qblk - 2; if (tlo < 0) tlo = 0; int thi = 4 * qblk + 5; if (thi > 31) thi = 31; const int NTW = thi - tlo + 1;
    { const bf16_t* Kp = WSP(const bf16_t, WS_WAK) + (size_t)(b * SEQ) * 256 + kvh * 64;
      const bf16_t* Vp = WSP(const bf16_t, WS_WAVT) + (size_t)(kvh * 64) * MTOK + (size_t)b * SEQ;
      const int Rk = w * 8 + (lane >> 3), slot = lane & 7;
      const bf16_t* srcK0 = Kp + (size_t)Rk * 256 + ((slot ^ ((Rk >> 1) & 7)) * 8);
      const bf16_t* srcV0 = Vp + (size_t)Rk * MTOK + ((slot ^ ((Rk >> 1) & 7)) * 8);
      for (int j = 0; j < NTW; ++j) { const int t = tlo + j; glds16(srcK0 + (size_t)t * 64 * 256, lds + j * TSZ + w * 1024); glds16(srcV0 + t * 64, lds + j * TSZ + VOFF + w * 1024); } }
    int tw0 = (qw - 128) >> 6; const int tw0r = tw0; if (tw0 > thi - 4) tw0 = thi - 4; if (tw0 < tlo) tw0 = tlo;
    const bool regular = __builtin_amdgcn_readfirstlane((int)(tw0 == tw0r)) != 0;
    const int krow = (r32 & 0x13) | ((r32 & 4) << 1) | ((r32 & 8) >> 1), ksw = (krow >> 1) & 7, vsw = (r32 >> 1) & 7;
    const LAS unsigned char* kp[4]; const LAS unsigned char* vp[4];
#pragma unroll
    for (int d = 0; d < 4; ++d) kp[d] = lds + krow * 128 + (((2 * d + hi) ^ ksw) * 16);
#pragma unroll
    for (int ks = 0; ks < 4; ++ks) vp[ks] = lds + r32 * 128 + (((4 * (ks >> 1) + 2 * (ks & 1) + hi) ^ vsw) * 16);
    const int qpos = qw + r32;
    asm volatile("s_waitcnt vmcnt(0)" ::: "memory"); __builtin_amdgcn_s_barrier(); asm volatile("" ::: "memory");
    float kmx;
    { float kn2 = 0.f;
      if (w < NTW) { const LAS unsigned char* kr = lds + w * TSZ + lane * 128;
#pragma unroll
          for (int c = 0; c < 8; ++c) { const bf16x8 v = *(const LAS bf16x8*)(kr + c * 16);
#pragma unroll
              for (int jj = 0; jj < 8; ++jj) { const float x = __uint_as_float(((unsigned)(unsigned short)v[jj]) << 16); kn2 += x * x; } } }
#pragma unroll
      for (int off = 1; off < 64; off <<= 1) kn2 = fmaxf(kn2, __shfl_xor(kn2, off));
      volatile LAS float* ksc = (volatile LAS float*)(lds + MISC_OFF + 64);
      if (lane == 0) ksc[w] = kn2;
      LDS_WAIT(); __builtin_amdgcn_s_barrier(); asm volatile("" ::: "memory");
      kmx = ksc[0];
#pragma unroll
      for (int i = 1; i < 8; ++i) kmx = fmaxf(kmx, ksc[i]); }
#define FA_SB() __builtin_amdgcn_sched_barrier(0)
#define FA_EL(X0, X1, e) (((e) < 16) ? X0[(e) & 15] : X1[(e) & 15])
#define FA_SETEL(X0, X1, e, v) do { if ((e) < 16) X0[(e) & 15] = (v); else X1[(e) & 15] = (v); } while (0)
#define FA_NOFF(e) (32 * ((e) >> 4) + 16 * (((e) & 15) >> 3) + ((e) & 7))
#define FA_BIAS1(X0, X1, e) do { const float _x = t0n - (float)FA_NOFF(e); float _c = __builtin_fmaf(nslope, __builtin_fabsf(_x), negm); \
        _c = (__builtin_fabsf(_x) > 128.0f) ? -1.0e30f : _c; asm volatile("" : "+v"(_c)); FA_SETEL(X0, X1, e, _c); } while (0)
#define FW_BIAS(BM, SG, X0, X1, e) do { if ((BM) != 4) { float _c; \
        if ((BM) == 0 || (BM) == 2) { const float _x = t0n - (float)FA_NOFF(e); _c = __builtin_fmaf(nslope, __builtin_fabsf(_x), negm); \
            if ((BM) == 0) _c = (__builtin_fabsf(_x) > 128.0f) ? -1.0e30f : _c; } \
        else { _c = __builtin_fmaf(bd1, (float)FA_NOFF(e), bbase); \
            if ((BM) == 3) _c = (((SG) > 0) ? ((float)FA_NOFF(e) < blim) : ((float)FA_NOFF(e) > blim)) ? -1.0e30f : _c; } \
        asm volatile("" : "+v"(_c)); FA_SETEL(X0, X1, e, _c); } } while (0)
#define FA_T0(dst, t) do { float _t = (float)(qpos - 64 * (t) - 8 * hi); asm volatile("" : "+v"(_t)); dst = _t; } while (0)
#define FW_STEP(Y0, Y1, X0, X1, KOFF, VBOFF, TN, PV, BM, SG) do { \
        const LAS unsigned char* kq[4]; const LAS unsigned char* vq[4]; \
        _Pragma("unroll") for (int _d = 0; _d < 4; ++_d) { kq[_d] = kp[_d] + (KOFF); vq[_d] = vp[_d] + (VBOFF); } \
        _Pragma("unroll") for (int _j = 0; _j < 4; ++_j) kf[_j] = *(const LAS bf16x8*)(kq[_j >> 1] + (_j & 1) * 4096); \
        if (PV) { _Pragma("unroll") for (int _f = 0; _f < 8; ++_f) vf[_f] = *(const LAS bf16x8*)(vq[_f >> 1] + (_f & 1) * 4096); } \
        float t0n; FA_T0(t0n, TN); \
        float sacc = 0.f; FA_SB(); \
        _Pragma("unroll") for (int _j = 0; _j < 8; ++_j) { \
            if (_j & 1) Y1 = __builtin_amdgcn_mfma_f32_32x32x16_bf16(kf[_j & 3], qf[_j >> 1], Y1, 0, 0, 0); \
            else        Y0 = __builtin_amdgcn_mfma_f32_32x32x16_bf16(kf[_j & 3], qf[_j >> 1], Y0, 0, 0, 0); \
            if (_j < 4) kf[_j] = *(const LAS bf16x8*)(kq[(_j + 4) >> 1] + (_j & 1) * 4096); \
            { const float _a = FA_EL(X0, X1, 4 * _j), _b = FA_EL(X0, X1, 4 * _j + 1), _c = FA_EL(X0, X1, 4 * _j + 2), _d = FA_EL(X0, X1, 4 * _j + 3); \
              sacc += (_a + _b) + (_c + _d); asm volatile("" : "+v"(sacc)); pk[_j >> 1][2 * (_j & 1)] = cvt_pk_bf16(_a, _b); pk[_j >> 1][2 * (_j & 1) + 1] = cvt_pk_bf16(_c, _d); } \
            FA_SB(); } \
        l += sacc; \
        if (trk) { float _m; FA_ROWMAX(_m, Y0, Y1); resc = false; \
          if (__builtin_expect(__any(_m > THR), 0)) { const float _dl = fmaxf(_m, 0.f); mref += _dl; negm = -mref; fsave = __builtin_amdgcn_exp2f(-_dl); l *= fsave; resc = true; \
              _Pragma("unroll") for (int _r = 0; _r < 16; ++_r) { Y0[_r] -= _dl; Y1[_r] -= _dl; } } } \
        float bbase = 0.f, bd1 = 0.f, blim = 0.f; if ((BM) == 1 || (BM) == 3) { const float _sn = ((SG) > 0) ? nslope : -nslope; bbase = __builtin_fmaf(_sn, t0n, negm); bd1 = -_sn; blim = ((SG) > 0) ? t0n - 128.0f : t0n + 128.0f; } \
        FA_SB(); \
        _Pragma("unroll") for (int _i = 0; _i < NPV; ++_i) { \
            if (PV) o[_i & 1] = __builtin_amdgcn_mfma_f32_32x32x16_bf16(vf[_i], __builtin_bit_cast(bf16x8, pk[_i >> 1]), o[_i & 1], 0, 0, 0); \
            _Pragma("unroll") for (int _e = 0; _e < 4; ++_e) { const int _q = 4 * _i + _e; \
                { float _ev = __builtin_amdgcn_exp2f(FA_EL(Y0, Y1, _q)); asm volatile("" : "+v"(_ev)); FA_SETEL(Y0, Y1, _q, _ev); } FW_BIAS(BM, SG, X0, X1, _q); } \
            FA_SB(); } \
        if (trk && __builtin_expect(resc, 0)) { _Pragma("unroll") for (int _d = 0; _d < NDB; ++_d) _Pragma("unroll") for (int _r = 0; _r < 16; ++_r) o[_d][_r] *= fsave; } \
    } while (0)
    for (int hq = 0; hq < 4; ++hq) {
        const int hd = kvh * 4 + hq;
        const float slope2 = LOG2E * __builtin_amdgcn_exp2f(-0.5f * (float)(hd + 1)), nslope = -slope2;
        bf16x8 qf[4];
        { const bf16_t* qp = WSP(const bf16_t, WS_WAQ) + (size_t)(b * SEQ + qw + r32) * 1024 + hd * 64 + hi * 8;
#pragma unroll
          for (int d = 0; d < 4; ++d) qf[d] = *(const bf16x8*)(qp + d * 16); }
        bool trk;
        { float qs = 0.f;
#pragma unroll
          for (int d = 0; d < 4; ++d)
#pragma unroll
              for (int jj = 0; jj < 8; ++jj) { const float x = __uint_as_float(((unsigned)(unsigned short)qf[d][jj]) << 16); qs += x * x; }
          qs += __shfl_xor(qs, 32);
#pragma unroll
          for (int off = 1; off < 32; off <<= 1) qs = fmaxf(qs, __shfl_xor(qs, off));
          trk = __builtin_amdgcn_readfirstlane((int)(sqrtf(qs * kmx) < 100.0f)) == 0; }
        f32x16 o[NDB];
#pragma unroll
        for (int d = 0; d < NDB; ++d) o[d] = (f32x16){0.f, 0.f, 0.f, 0.f, 0.f, 0.f, 0.f, 0.f, 0.f, 0.f, 0.f, 0.f, 0.f, 0.f, 0.f, 0.f};
        f32x16 A0, A1, B0, B1; B0 = o[0]; B1 = o[0];
        float mref = 0.f, negm = 0.f, l = 0.f, fsave = 1.f; bool resc = false;
        u32x4 pk[4]; bf16x8 kf[4], vf[8];
        const int kb0 = (tw0 - tlo) * TSZ;
        if (regular) {
            { float t0n; FA_T0(t0n, tw0); const float bbase = __builtin_fmaf(nslope, t0n, negm), bd1 = -nslope, blim = t0n - 128.0f;
#pragma unroll
              for (int e = 0; e < 32; ++e) FW_BIAS(3, 1, A0, A1, e); }
            FW_STEP(A0, A1, B0, B1, kb0, kb0, tw0 + 1, false, 1, 1);
            FW_STEP(B0, B1, A0, A1, kb0 + TSZ, kb0 + VOFF, tw0 + 2, true, 2, 0);
            FW_STEP(A0, A1, B0, B1, kb0 + 2 * TSZ, kb0 + TSZ + VOFF, tw0 + 3, true, 1, -1);
            FW_STEP(B0, B1, A0, A1, kb0 + 3 * TSZ, kb0 + 2 * TSZ + VOFF, tw0 + 4, true, 3, -1);
            FW_STEP(A0, A1, B0, B1, kb0 + 4 * TSZ, kb0 + 3 * TSZ + VOFF, tw0 + 4, true, 4, 0);
        } else {
            { float t0n; FA_T0(t0n, tw0); const float bbase = 0.f, bd1 = 0.f, blim = 0.f;
#pragma unroll
              for (int e = 0; e < 32; ++e) FW_BIAS(0, 0, A0, A1, e); }
            FW_STEP(A0, A1, B0, B1, kb0, kb0, tw0 + 1, false, 0, 0);
            FW_STEP(B0, B1, A0, A1, kb0 + TSZ, kb0 + VOFF, tw0 + 2, true, 0, 0);
            FW_STEP(A0, A1, B0, B1, kb0 + 2 * TSZ, kb0 + TSZ + VOFF, tw0 + 3, true, 0, 0);
            FW_STEP(B0, B1, A0, A1, kb0 + 3 * TSZ, kb0 + 2 * TSZ + VOFF, tw0 + 4, true, 0, 0);
            FW_STEP(A0, A1, B0, B1, kb0 + 4 * TSZ, kb0 + 3 * TSZ + VOFF, tw0 + 4, true, 4, 0);
        }
        { float sacc = 0.f;
#pragma unroll
          for (int j = 0; j < 8; ++j) { const float a_ = FA_EL(A0, A1, 4 * j), b_ = FA_EL(A0, A1, 4 * j + 1), c_ = FA_EL(A0, A1, 4 * j + 2), d_ = FA_EL(A0, A1, 4 * j + 3);
              sacc += (a_ + b_) + (c_ + d_); pk[j >> 1][2 * (j & 1)] = cvt_pk_bf16(a_, b_); pk[j >> 1][2 * (j & 1) + 1] = cvt_pk_bf16(c_, d_); }
          l += sacc;
#pragma unroll
          for (int i = 0; i < NPV; ++i) { const int ks = i >> 1, d = i & 1;
              const bf16x8 v = *(const LAS bf16x8*)(vp[ks] + kb0 + 4 * TSZ + VOFF + d * 4096);
              o[d] = __builtin_amdgcn_mfma_f32_32x32x16_bf16(v, __builtin_bit_cast(bf16x8, pk[ks]), o[d], 0, 0, 0); } }
        l += __shfl_xor(l, 32);
        { const float sink2 = P.wa_sink[hd] * LOG2E;
          const float il = 1.0f / (l + __builtin_amdgcn_exp2f(sink2 - mref));
          bf16_t* op = WSP(bf16_t, WS_WAQ) + (size_t)(b * SEQ + qw + r32) * 1024 + hd * 64;
#pragma unroll
          for (int d = 0; d < 2; ++d)
#pragma unroll
              for (int gp = 0; gp < 2; ++gp) { u32x2 pw[2];
#pragma unroll
                  for (int gg = 0; gg < 2; ++gg) { const int g = 2 * gp + gg; pw[gg].x = cvt_pk_bf16(o[d][4 * g] * il, o[d][4 * g + 1] * il); pw[gg].y = cvt_pk_bf16(o[d][4 * g + 2] * il, o[d][4 * g + 3] * il); }
                  const unsigned sx = hi ? pw[0].x : pw[1].x, sy = hi ? pw[0].y : pw[1].y;
                  const unsigned rx = (unsigned)__shfl_xor((int)sx, 32), ry = (unsigned)__shfl_xor((int)sy, 32);
                  u32x4 wv; if (hi) { wv.x = rx; wv.y = ry; wv.z = pw[1].x; wv.w = pw[1].y; } else { wv.x = pw[0].x; wv.y = pw[0].y; wv.z = rx; wv.w = ry; }
                  *(u32x4*)(op + d * 32 + 16 * gp + 8 * hi) = wv; } }
    }
    asm volatile("s_waitcnt vmcnt(0) lgkmcnt(0)" ::: "memory"); __builtin_amdgcn_s_barrier(); asm volatile("" ::: "memory");
#undef FW_STEP
#undef FW_BIAS
#undef FA_EL
#undef FA_SETEL
#undef FA_NOFF
#undef FA_BIAS1
#undef FA_T0
#undef FA_SB
}
}

struct Frame { LAS unsigned char* lds; int tid, lane, wave, vcu, G; };

__device__ __forceinline__ void transpose_item(const float* W, int K, int N, bf16_t* WT, int k0, int n0, int drow0, LAS float* scr, int lane) {
#pragma unroll 8
    for (int i = 0; i < 32; ++i) { const int kk = 2 * i + (lane >> 5); scr[kk * 33 + (lane & 31)] = W[(size_t)(k0 + kk) * N + n0 + (lane & 31)]; }
    LDS_WAIT(); asm volatile("" ::: "memory");
    const int c = lane & 7;
#pragma unroll
    for (int j = 0; j < 4; ++j) { const int n = (lane >> 3) + 8 * j; const LAS float* s = scr + (8 * c) * 33 + n;
        u32x4 o; o.x = cvt_pk_bf16(s[0 * 33], s[1 * 33]); o.y = cvt_pk_bf16(s[2 * 33], s[3 * 33]); o.z = cvt_pk_bf16(s[4 * 33], s[5 * 33]); o.w = cvt_pk_bf16(s[6 * 33], s[7 * 33]);
        *(u32x4*)(WT + (size_t)(drow0 + n) * K + k0 + 8 * c) = o; }
    LDS_WAIT(); asm volatile("" ::: "memory");
}
__device__ __forceinline__ void transpose_item_fp8(const float* W, int K, int N, unsigned char* WT, int k0, int n0, int drow0, float sc, LAS float* scr, int lane) {
#pragma unroll 8
    for (int i = 0; i < 32; ++i) { const int kk = 2 * i + (lane >> 5); scr[kk * 33 + (lane & 31)] = W[(size_t)(k0 + kk) * N + n0 + (lane & 31)]; }
    LDS_WAIT(); asm volatile("" ::: "memory");
    const int c = lane & 7;
#pragma unroll
    for (int j = 0; j < 4; ++j) { const int n = (lane >> 3) + 8 * j; const LAS float* q = scr + (8 * c) * 33 + n;
        u32x2 o; o.x = pk4_fp8(q[0 * 33] * sc, q[1 * 33] * sc, q[2 * 33] * sc, q[3 * 33] * sc); o.y = pk4_fp8(q[4 * 33] * sc, q[5 * 33] * sc, q[6 * 33] * sc, q[7 * 33] * sc);
        *(u32x2*)(WT + (size_t)(drow0 + n) * K + k0 + 8 * c) = o; }
    LDS_WAIT(); asm volatile("" ::: "memory");
}
__device__ __forceinline__ int win_dst_row(int n) {
    if (n < 1024) return R_DAQ + n; if (n < 2048) return R_DAK + (n - 1024); if (n < 3072) return R_DAV + (n - 2048); if (n < 4096) return R_WAQ + (n - 3072);
    if (n < 4352) return R_WAK + (n - 4096); if (n < 4608) return R_WAV + (n - 4352); if (n < 5632) return R_XAQ + (n - 4608); return R_GATE + (n - 5632);
}
__device__ __forceinline__ void rms_row_to_bf16(const float* xrow, const float* g, bf16_t* orow, int lane, unsigned* orow8 = nullptr) {
    const f32x4* xr = (const f32x4*)xrow + lane; const f32x4* gr = (const f32x4*)g + lane;
    f32x4 v[4]; float s = 0.f;
#pragma unroll
    for (int j = 0; j < 4; ++j) { v[j] = xr[64 * j]; s += (v[j][0] * v[j][0] + v[j][1] * v[j][1]) + (v[j][2] * v[j][2] + v[j][3] * v[j][3]); }
    const float rstd = 1.0f / sqrtf(wave_sum(s) * (1.0f / 1024.0f) + EPS);
    u32x2* o8 = (u32x2*)orow + lane;
#pragma unroll
    for (int j = 0; j < 4; ++j) { const f32x4 gg = gr[64 * j]; u32x2 wv; wv.x = cvt_pk_bf16(v[j][0] * rstd * gg[0], v[j][1] * rstd * gg[1]); wv.y = cvt_pk_bf16(v[j][2] * rstd * gg[2], v[j][3] * rstd * gg[3]); if (orow) o8[64 * j] = wv;
        if (orow8) orow8[lane + 64 * j] = pk4_fp8(v[j][0] * rstd * gg[0], v[j][1] * rstd * gg[1], v[j][2] * rstd * gg[2], v[j][3] * rstd * gg[3]); }
}
template <int NR>
__device__ __forceinline__ void rms_rows(const float* x0, const float* g, bf16_t* o0, unsigned* o80, int lane) {
    const f32x4* gr = (const f32x4*)g + lane;
    f32x4 v[NR][4]; float rstd[NR];
#pragma unroll
    for (int r = 0; r < NR; ++r) { const f32x4* xr = (const f32x4*)(x0 + (size_t)r * 1024) + lane;
#pragma unroll
        for (int j = 0; j < 4; ++j) v[r][j] = xr[64 * j]; }
#pragma unroll
    for (int r = 0; r < NR; ++r) { float s = 0.f;
#pragma unroll
        for (int j = 0; j < 4; ++j) s += (v[r][j][0] * v[r][j][0] + v[r][j][1] * v[r][j][1]) + (v[r][j][2] * v[r][j][2] + v[r][j][3] * v[r][j][3]);
        rstd[r] = 1.0f / sqrtf(wave_sum(s) * (1.0f / 1024.0f) + EPS); }
#pragma unroll
    for (int j = 0; j < 4; ++j) { const f32x4 gg = gr[64 * j];
#pragma unroll
        for (int r = 0; r < NR; ++r) { const float a = v[r][j][0] * rstd[r] * gg[0], b = v[r][j][1] * rstd[r] * gg[1], c = v[r][j][2] * rstd[r] * gg[2], d = v[r][j][3] * rstd[r] * gg[3];
            if (o0) { u32x2 wv; wv.x = cvt_pk_bf16(a, b); wv.y = cvt_pk_bf16(c, d); ((u32x2*)(o0 + (size_t)r * 1024))[lane + 64 * j] = wv; }
            if (o80) o80[(size_t)r * 256 + lane + 64 * j] = pk4_fp8(a, b, c, d); } }
}
__device__ __forceinline__ void phase_prologue(Frame& F, const Ptrs& P) {
    LAS float* scr = (LAS float*)(F.lds + F.wave * 16384);
    const int gw = F.vcu * 8 + F.wave, NGW = F.G * 8;
    constexpr int I_IN = 16 * 272, I_KV = 16 * 64, I_SQ = 16 * 32;
    constexpr int NIT = I_IN + I_KV + 4 * I_SQ;
    for (int it = gw; it < NIT; it += NGW) {
        int r = it;
        if (r < I_IN) { const int kb = r / 272, nb = r % 272;
            if (WA_FP8 && 32 * nb >= 3072 && 32 * nb < 4608) transpose_item_fp8(P.w_in, 1024, INW, WSP(unsigned char, WS_WWA8), 64 * kb, 32 * nb, 32 * nb - 3072, W8_SCALE, scr, F.lane);
            else if (XA_FP8 && 32 * nb >= 4608 && 32 * nb < 5632) transpose_item_fp8(P.w_in, 1024, INW, WSP(unsigned char, WS_WXQ8), 64 * kb, 32 * nb, 32 * nb - 4608, W8_SCALE, scr, F.lane);
            else if (INPROJ_FP8) transpose_item_fp8(P.w_in, 1024, INW, WSP(unsigned char, WS_WIN), 64 * kb, 32 * nb, win_dst_row(32 * nb), W8_SCALE, scr, F.lane);
            else if (GATES_FP8 && 32 * nb >= 5632) transpose_item_fp8(P.w_in, 1024, INW, WSP(unsigned char, WS_WG8), 64 * kb, 32 * nb, 32 * nb - 5632, W8_SCALE, scr, F.lane);
            else transpose_item(P.w_in, 1024, INW, WSP(bf16_t, WS_WIN), 64 * kb, 32 * nb, win_dst_row(32 * nb), scr, F.lane);
            continue; } r -= I_IN;
        if (r < I_KV) { const int kb = r / 64, nb = r % 64;
            if (XA_FP8) transpose_item_fp8(P.w_mkv, 1024, 2048, WSP(unsigned char, WS_WMKV8), 64 * kb, 32 * nb, 32 * nb, W8_SCALE, scr, F.lane);
            else if (INPROJ_FP8) transpose_item_fp8(P.w_mkv, 1024, 2048, WSP(unsigned char, WS_WMKV), 64 * kb, 32 * nb, 32 * nb, W8_SCALE, scr, F.lane);
            else transpose_item(P.w_mkv, 1024, 2048, WSP(bf16_t, WS_WMKV), 64 * kb, 32 * nb, 32 * nb, scr, F.lane);
            continue; } r -= I_KV;
        const int which = r / I_SQ; r -= which * I_SQ; const int kb = r / 32, nb = r % 32;
        const float* src = which == 0 ? P.w_da_o : which == 1 ? P.w_wa_o : which == 2 ? P.w_xa_o : P.w_out;
        bf16_t* dst = which == 0 ? WSP(bf16_t, WS_WDAO) : which == 1 ? WSP(bf16_t, WS_WWAO) : which == 2 ? WSP(bf16_t, WS_WXAO) : WSP(bf16_t, WS_WOUT);
        if (XS_FP8 && which == 2) transpose_item_fp8(src, 1024, 1024, (unsigned char*)dst, 64 * kb, 32 * nb, 32 * nb, W8_SCALE, scr, F.lane);
        else transpose_item(src, 1024, 1024, dst, 64 * kb, 32 * nb, 32 * nb, scr, F.lane);
    }
    for (int m = 2 * gw; m < MTOK; m += 2 * NGW) rms_rows<2>(P.x + (size_t)m * 1024, P.attn_g, INPROJ_FP8 ? nullptr : WSP(bf16_t, WS_H) + (size_t)m * 1024, GATES_FP8 ? (unsigned*)((char*)P.out + 128 * MiB) + (size_t)m * 256 : nullptr, F.lane);
    for (int m = gw; m < MMEM; m += NGW) rms_row_to_bf16(P.mem + (size_t)m * 1024, P.mem_g, (INPROJ_FP8 || XA_FP8) ? nullptr : WSP(bf16_t, WS_MN) + (size_t)m * 1024, F.lane, XA_FP8 ? WSP(unsigned, WS_MN8) + (size_t)m * 256 : INPROJ_FP8 ? WSP(unsigned, WS_MN) + (size_t)m * 256 : nullptr);
    { u32x4* inv = WSP(u32x4, WS_INV); const int n16 = MTOK * 16 * 2 / 16;
      for (int i = F.vcu * 512 + F.tid; i < n16; i += F.G * 512) inv[i] = (u32x4){0xffffffffu, 0xffffffffu, 0xffffffffu, 0xffffffffu}; }
}

__device__ __forceinline__ void convert_expert_weights(Frame& F, const Ptrs& P, LAS float* scr);
__device__ __forceinline__ void phase_norm_router(Frame& F, const Ptrs& P) {
    LAS float* wl = (LAS float*)F.lds;
    LAS float* gl = wl + 64 * 260;
    for (int i = F.tid; i < 1024 * 16; i += 512) { const int k = i >> 4, e = i & 15; wl[(((k >> 4) & 3) * 16 + e) * 260 + (k >> 6) * 16 + (k & 15)] = P.w_router[i] * P.ffn_g[k]; }
    for (int i = F.tid; i < 1024; i += 512) gl[i] = P.ffn_g[i];
    __syncthreads();
    const int lane = F.lane, t = lane & 15, kq = lane >> 4;
    const LAS float* wrow = wl + (kq * 16 + t) * 260;
    const LAS float* grow = gl + kq * 16;
    LAS float* cscr = (LAS float*)(F.lds + 70656 + F.wave * 8448);
    static_assert(70656 + 8 * 8448 <= MISC_OFF, "conversion tiles overlap the barrier words");
    if (F.wave & 1) convert_expert_weights(F, P, cscr);
    for (int g = F.vcu * 8 + F.wave; g < MTOK / 16; g += F.G * 8) {
        const int m0 = 16 * g;
        const u32x4* xr = (const u32x4*)(WSP(const unsigned char, WS_X1) + (size_t)(m0 + t) * 2048 + kq * 32);
        u32x4 xp[32];
#pragma unroll
        for (int J = 0; J < 16; ++J) { xp[2 * J] = xr[8 * J]; xp[2 * J + 1] = xr[8 * J + 1]; }
        f32x4 a0 = (f32x4){0.f, 0.f, 0.f, 0.f}, a1 = a0; float ss = 0.f;
        f32x4 w0 = *(const LAS f32x4*)(wrow), w1 = *(const LAS f32x4*)(wrow + 4);
#pragma unroll
        for (int j = 0; j < 32; ++j) {
            asm volatile("" ::: "memory");
            const f32x4 w0n = *(const LAS f32x4*)(wrow + 8 * ((j + 1) & 31)), w1n = *(const LAS f32x4*)(wrow + 8 * ((j + 1) & 31) + 4);
            asm volatile("" : "+v"(xp[j]));
            const u32x4 d = xp[j];
            const float x0 = bf_lo(d.x), x1 = bf_hi(d.x), x2 = bf_lo(d.y), x3 = bf_hi(d.y), x4 = bf_lo(d.z), x5 = bf_hi(d.z), x6 = bf_lo(d.w), x7 = bf_hi(d.w);
            a0 = __builtin_amdgcn_mfma_f32_16x16x4f32(w0[0], x0, a0, 0, 0, 0); a1 = __builtin_amdgcn_mfma_f32_16x16x4f32(w0[1], x1, a1, 0, 0, 0);
            a0 = __builtin_amdgcn_mfma_f32_16x16x4f32(w0[2], x2, a0, 0, 0, 0); a1 = __builtin_amdgcn_mfma_f32_16x16x4f32(w0[3], x3, a1, 0, 0, 0);
            a0 = __builtin_amdgcn_mfma_f32_16x16x4f32(w1[0], x4, a0, 0, 0, 0); a1 = __builtin_amdgcn_mfma_f32_16x16x4f32(w1[1], x5, a1, 0, 0, 0);
            a0 = __builtin_amdgcn_mfma_f32_16x16x4f32(w1[2], x6, a0, 0, 0, 0); a1 = __builtin_amdgcn_mfma_f32_16x16x4f32(w1[3], x7, a1, 0, 0, 0);
            ss += ((x0 * x0 + x1 * x1) + (x2 * x2 + x3 * x3)) + ((x4 * x4 + x5 * x5) + (x6 * x6 + x7 * x7));
            w0 = w0n; w1 = w1n; __builtin_amdgcn_sched_barrier(0); }
        ss += __shfl_xor(ss, 16); ss += __shfl_xor(ss, 32);
        const float rstd = 1.0f / sqrtf(ss * (1.0f / 1024.0f) + EPS);
        const f32x4 lg = (a0 + a1) * rstd;
        float mx = fmaxf(fmaxf(lg[0], lg[1]), fmaxf(lg[2], lg[3])); mx = fmaxf(mx, __shfl_xor(mx, 16)); mx = fmaxf(mx, __shfl_xor(mx, 32));
        f32x4 ex; ex[0] = __expf(lg[0] - mx); ex[1] = __expf(lg[1] - mx); ex[2] = __expf(lg[2] - mx); ex[3] = __expf(lg[3] - mx);
        float den = (ex[0] + ex[1]) + (ex[2] + ex[3]); den += __shfl_xor(den, 16); den += __shfl_xor(den, 32);
        *(f32x4*)(WSP(float, WS_AFF) + (size_t)(m0 + t) * 16 + 4 * kq) = ex / den;
        unsigned char* hrow = WSP(unsigned char, WS_H2) + (size_t)(m0 + t) * 1024 + kq * 16;
#pragma unroll
        for (int J = 0; J < 16; ++J) { u32x4 o;
#pragma unroll
            for (int h = 0; h < 2; ++h) { asm volatile("" : "+v"(xp[2 * J + h]) :: "memory"); const u32x4 d = xp[2 * J + h];
                const f32x4 g0 = *(const LAS f32x4*)(grow + 64 * J + 8 * h), g1 = *(const LAS f32x4*)(grow + 64 * J + 8 * h + 4);
                const unsigned lo = pk4_fp8(bf_lo(d.x) * rstd * g0[0], bf_hi(d.x) * rstd * g0[1], bf_lo(d.y) * rstd * g0[2], bf_hi(d.y) * rstd * g0[3]);
                const unsigned hi = pk4_fp8(bf_lo(d.z) * rstd * g1[0], bf_hi(d.z) * rstd * g1[1], bf_lo(d.w) * rstd * g1[2], bf_hi(d.w) * rstd * g1[3]);
                if (h == 0) { o.x = lo; o.y = hi; } else { o.z = lo; o.w = hi; } }
            *(u32x4*)(hrow + 64 * J) = o; __builtin_amdgcn_sched_barrier(0); }
    }
    if (!(F.wave & 1)) convert_expert_weights(F, P, cscr);
}

__device__ __forceinline__ void convert_expert_weights(Frame& F, const Ptrs& P, LAS float* scr) {
    {
        const int gw = F.vcu * 8 + F.wave, NGW = F.G * 8;
        for (int it = gw; it < 3 * 16 * 1024; it += NGW) {
            const int mat = it >> 14, r = it & 16383, e = r >> 10, q = r & 1023;
            if (mat < 2) { const int kb = q >> 6, nb = q & 63, n0 = 32 * nb;
                transpose_item_fp8((mat == 0 ? P.w_eg : P.w_eu) + (size_t)e * 1024 * 2048, 1024, 2048, WSP(unsigned char, WS_WGU) + (size_t)e * 4096 * 1024, 64 * kb, n0, (n0 >> 7) * 256 + mat * 128 + (n0 & 127), W8_SCALE, scr, F.lane); }
            else { const int kb = q >> 5, nb = q & 31;
                transpose_item_fp8(P.w_ed + (size_t)e * 2048 * 1024, 2048, 1024, WSP(unsigned char, WS_WD) + (size_t)e * 1024 * 2048, 64 * kb, 32 * nb, 32 * nb, W8_SCALE, scr, F.lane); }
        }
    }
}
__device__ __forceinline__ void phase_topk_convert(Frame& F, const Ptrs& P) {
    LAS float* vals = (LAS float*)F.lds;
    LAS unsigned* hist = (LAS unsigned*)(F.lds + 8192);
    LAS unsigned* ctl = hist + 256;
    for (int task = F.vcu; task < NB * NEXP; task += F.G) {
        const int b = task >> 4, e = task & 15;
        __syncthreads();
        float v[4]; unsigned u[4];
#pragma unroll
        for (int j = 0; j < 4; ++j) { const int t = F.tid + 512 * j; v[j] = WSP(const float, WS_AFF)[(size_t)(b * SEQ + t) * 16 + e]; vals[t] = v[j]; u[j] = __float_as_uint(v[j]); }
        unsigned prefix = 0u, need = (unsigned)CAP;
        for (int pass = 0; pass < 4; ++pass) {
            const int shift = 24 - 8 * pass;
            if (F.tid < 256) hist[F.tid] = 0u;
            if (F.tid == 0) { ctl[2] = 0u; ctl[4] = 0u; }
            __syncthreads();
#pragma unroll
            for (int j = 0; j < 4; ++j) if (pass == 0 || (u[j] >> (shift + 8)) == prefix) __hip_atomic_fetch_add(&hist[(u[j] >> shift) & 255u], 1u, __ATOMIC_RELAXED, __HIP_MEMORY_SCOPE_WORKGROUP);
            __syncthreads();
            if (F.wave == 0) {
                const u32x4 h4 = *(const LAS u32x4*)(hist + 4 * F.lane);
                const unsigned sl = (h4.x + h4.y) + (h4.z + h4.w);
                unsigned S = sl;
#pragma unroll
                for (int off = 1; off < 64; off <<= 1) { const unsigned t = __shfl_down(S, off); S += (F.lane + off < 64) ? t : 0u; }
                const unsigned long long mk = __ballot(S >= need);
                const int L = 63 - __builtin_clzll(mk);
                if (F.lane == L) { unsigned c = S - sl; int d = 4 * L; unsigned bc = 0u;
                    if (c + h4.w >= need) { d = 4 * L + 3; bc = h4.w; } else { c += h4.w;
                    if (c + h4.z >= need) { d = 4 * L + 2; bc = h4.z; } else { c += h4.z;
                    if (c + h4.y >= need) { d = 4 * L + 1; bc = h4.y; } else { c += h4.y; d = 4 * L; bc = h4.x; } } }
                    ctl[0] = (prefix << 8) | (unsigned)d; ctl[1] = need - c; ctl[3] = bc; }
            }
            __syncthreads();
            prefix = ctl[0]; need = ctl[1];
        }
        const unsigned T = prefix, cnt_eq = ctl[3], ngt = (unsigned)CAP - need;
#pragma unroll
        for (int j = 0; j < 4; ++j) { const int t = F.tid + 512 * j; int slot = -1;
            if (u[j] > T) slot = (int)__hip_atomic_fetch_add(&ctl[2], 1u, __ATOMIC_RELAXED, __HIP_MEMORY_SCOPE_WORKGROUP);
            else if (u[j] == T) {
                if (cnt_eq == need) slot = (int)(ngt + __hip_atomic_fetch_add(&ctl[4], 1u, __ATOMIC_RELAXED, __HIP_MEMORY_SCOPE_WORKGROUP));
                else { unsigned eq = 0u; for (int i = 0; i < t; ++i) eq += (vals[i] == v[j]) ? 1u : 0u; if (eq < need) slot = (int)(ngt + eq); } }
            if (slot >= 0) {
                WSP(int, WS_IDX)[(b * 16 + e) * 256 + slot] = b * SEQ + t;
                WSP(float, WS_GL)[(b * 16 + e) * 256 + slot] = v[j];
                WSP(short, WS_INV)[(size_t)(b * SEQ + t) * 16 + e] = (short)slot; } }
    }
}

__device__ __forceinline__ void phase_final(Frame& F, const Ptrs& P) {
    constexpr int FR = 4;
    const int gw = F.vcu * 8 + F.wave, NGW = F.G * 8, lane = F.lane;
    const short* INV = WSP(const short, WS_INV); const float* GLp = WSP(const float, WS_GL); const unsigned* YEp = WSP(const unsigned, WS_YE);
    f32x4 gg[4];
#pragma unroll
    for (int j = 0; j < 4; ++j) gg[j] = ((const f32x4*)P.final_g)[lane + 64 * j];
    for (int m0 = gw; m0 < MTOK; m0 += FR * NGW) {
        int sl[FR]; u32x2 xq[FR][4]; unsigned yq[FR][4][4]; float glv[FR]; int ek[FR][4]; unsigned rest[FR];
#pragma unroll
        for (int r = 0; r < FR; ++r) { const int m = m0 + r * NGW; sl[r] = (m < MTOK && lane < 16) ? (int)INV[(size_t)m * 16 + lane] : -1; }
#pragma unroll
        for (int r = 0; r < FR; ++r) { const int m = m0 + r * NGW; if (m < MTOK) { const u32x2* xr = WSP(const u32x2, WS_X1) + (size_t)m * 256 + lane;
#pragma unroll
            for (int j = 0; j < 4; ++j) xq[r][j] = xr[64 * j]; } }
#pragma unroll
        for (int r = 0; r < FR; ++r) { const int m = m0 + r * NGW, b = m >> 11;
            unsigned mk = (unsigned)__ballot(sl[r] >= 0) & 0xffffu;
            glv[r] = (sl[r] >= 0) ? GLp[(b * 16 + lane) * 256 + sl[r]] : 0.f;
#pragma unroll
            for (int k = 0; k < 4; ++k) { ek[r][k] = mk ? (int)__builtin_ctz(mk) : -1; mk &= mk - 1u;
                if (ek[r][k] >= 0) { const int s_ = __builtin_amdgcn_readlane(sl[r], ek[r][k]); const unsigned* yr = YEp + (size_t)((ek[r][k] * 32 + b) * 256 + s_) * 256 + lane;
#pragma unroll
                    for (int j = 0; j < 4; ++j) yq[r][k][j] = yr[64 * j]; } }
            rest[r] = mk; }
#pragma unroll
        for (int r = 0; r < FR; ++r) { const int m = m0 + r * NGW, b = m >> 11; if (m >= MTOK) break;
            f32x4 v[4];
#pragma unroll
            for (int j = 0; j < 4; ++j) v[j] = (f32x4){bf_lo(xq[r][j].x), bf_hi(xq[r][j].x), bf_lo(xq[r][j].y), bf_hi(xq[r][j].y)};
#pragma unroll
            for (int k = 0; k < 4; ++k) if (ek[r][k] >= 0) { const float g = __uint_as_float((unsigned)__builtin_amdgcn_readlane((int)__float_as_uint(glv[r]), ek[r][k])) * (1.0f / YE8_SCALE);
#pragma unroll
                for (int j = 0; j < 4; ++j) { const int y = (int)yq[r][k][j]; const f32x2 lo = __builtin_amdgcn_cvt_pk_f32_fp8(y, false), hi2 = __builtin_amdgcn_cvt_pk_f32_fp8(y, true);
                    v[j][0] += g * lo[0]; v[j][1] += g * lo[1]; v[j][2] += g * hi2[0]; v[j][3] += g * hi2[1]; } }
            unsigned rs_ = rest[r];
            while (rs_) { const int e = (int)__builtin_ctz(rs_); rs_ &= rs_ - 1u;
                const int s2 = __builtin_amdgcn_readlane(sl[r], e); const float g = __uint_as_float((unsigned)__builtin_amdgcn_readlane((int)__float_as_uint(glv[r]), e)) * (1.0f / YE8_SCALE);
                const unsigned* yr = YEp + (size_t)((e * 32 + b) * 256 + s2) * 256 + lane;
#pragma unroll
                for (int j = 0; j < 4; ++j) { const int y = (int)yr[64 * j]; const f32x2 lo = __builtin_amdgcn_cvt_pk_f32_fp8(y, false), hi2 = __builtin_amdgcn_cvt_pk_f32_fp8(y, true);
                    v[j][0] += g * lo[0]; v[j][1] += g * lo[1]; v[j][2] += g * hi2[0]; v[j][3] += g * hi2[1]; } }
            float s = 0.f;
#pragma unroll
            for (int j = 0; j < 4; ++j) s += (v[j][0] * v[j][0] + v[j][1] * v[j][1]) + (v[j][2] * v[j][2] + v[j][3] * v[j][3]);
            const float rstd = 1.0f / sqrtf(wave_sum(s) * (1.0f / 1024.0f) + EPS);
            f32x4* orow = (f32x4*)(P.out + (size_t)m * 1024) + lane;
#pragma unroll
            for (int j = 0; j < 4; ++j) { f32x4 o; o[0] = v[j][0] * rstd * gg[j][0]; o[1] = v[j][1] * rstd * gg[j][1]; o[2] = v[j][2] * rstd * gg[j][2]; o[3] = v[j][3] * rstd * gg[j][3]; orow[64 * j] = o; } }
    }
}

constexpr int N_PHASES = 10;
struct Args { Ptrs P; int ph_lo, ph_hi; };
__global__ void __launch_bounds__(512, 2) fwd(Args args) {
    extern __shared__ __attribute__((aligned(16))) unsigned char lds_raw[];
    LAS unsigned char* lds = (LAS unsigned char*)lds_raw;
    const Ptrs& P = args.P;
    Frame F; F.lds = lds; F.tid = threadIdx.x; F.lane = F.tid & 63; F.wave = __builtin_amdgcn_readfirstlane(F.tid >> 6);
    F.G = gridDim.x; { const int bx = blockIdx.x; F.vcu = (F.G % 8 == 0) ? (bx % 8) * (F.G / 8) + bx / 8 : bx; }
    volatile LAS unsigned* MISC = (volatile LAS unsigned*)(lds + MISC_OFF);
    if (F.tid < 64) MISC[F.tid] = 0u;
    __syncthreads();
    XcdBarrier bar; bar.bar = WSP(unsigned, WS_CTL) + 1024; bar.x = 0; bar.st = nullptr;
    if (MK_N_LAUNCHES == 1) bar = xcd_barrier_post(WSP(unsigned, WS_CTL) + 1024, MISC + 8);
    const int lo = args.ph_lo, hi = args.ph_hi;
#ifndef PHMASK
#define PHMASK 0x3ff
#endif
#define IN(k) (((PHMASK >> (k)) & 1) && lo <= (k) && (k) < hi)
#define SEAM(k) do { if (IN(k) && IN((k) + 1)) xcd_barrier(bar); } while (0)

    if (IN(0)) { phase_prologue(F, P); } SEAM(0);
    if (IN(1)) { JobP1 J{P, F.G, (int)blockIdx.x, INPROJ_FP8 ? 512 : 1024, INPROJ_FP8 ? 512 : 1024, INPROJ_FP8 ? 512 : 1024, (LAS float*)(lds + EPI_OFF)}; pg::gemm_phase<JobP1, true, false, INPROJ_FP8 != 0>(lds, J);
        if (XA_FP8) { JobP1x Jx{P, F.G, (int)blockIdx.x, 512, 512, 512}; pg::gemm_phase<JobP1x, true, false, true>(lds, Jx); } } SEAM(1);
    if (IN(2)) {
        for (int i = 0; i < 4; ++i) { const int u_ = i * F.G + F.vcu; fa::wa_group(lds, P, u_ >> 5, (u_ >> 3) & 3, u_ & 7); }
        { JobXA J{P, F.G, (int)blockIdx.x, XS_FP8 ? 128 : 256, XS_FP8 ? 512 : 1024, XS_FP8 ? 512 : 1024, (LAS float*)(lds + EPI_OFF)}; pg::gemm_phase<JobXA, true, false, XS_FP8 != 0>(lds, J); }
        { JobMVW J{P, F.G, (int)blockIdx.x, XS_FP8 ? 128 : 256, XS_FP8 ? 512 : 1024, XS_FP8 ? 512 : 1024}; pg::gemm_phase<JobMVW, true, false, XS_FP8 != 0>(lds, J); }
        { float lam;
          { const float a = P.lq1[F.lane] * P.lk1[F.lane], b2 = P.lq2[F.lane] * P.lk2[F.lane];
            lam = __expf(wave_sum(a)) - __expf(wave_sum(b2)) + LAM_INIT; }
          const int g_ = F.vcu >> 4, qb0 = F.vcu & 15;
          for (int i = 0; i < 16; ++i) { const int ih = i & 7, ib = i >> 3; fa::flash_unit<0>(lds, P, 2 * g_ + ib, (ih + g_) & 7, (qb0 + 3 * ih + 8 * ib) & 15, lam); } }
    } SEAM(2);
    if (IN(3)) {
        { JobMergeG J{P, F.G, (int)blockIdx.x, GATES_FP8 ? 512 : 1024, GATES_FP8 ? 512 : 1024, GATES_FP8 ? 512 : 1024}; pg::gemm_phase<JobMergeG, true, false, GATES_FP8 != 0>(lds, J); }
        if (YC_FP8) { { JobMergeY J{P, F.G, (int)blockIdx.x, 1024, 1024, 1024, 1}; pg::gemm_phase<JobMergeY, true, false>(lds, J); }
                      { JobMergeY J{P, F.G, (int)blockIdx.x, 512, 512, 512, 2}; pg::gemm_phase<JobMergeY, true, false, true>(lds, J); } }
        else { JobMergeY J{P, F.G, (int)blockIdx.x, 1024, 1024, 1024, 0}; pg::gemm_phase<JobMergeY, true, false>(lds, J); }
    } SEAM(3);
    if (IN(4)) { JobOut J{P, F.G, (int)blockIdx.x, 1024, 1024, 1024}; pg::gemm_phase<JobOut, true, false>(lds, J); } SEAM(4);
    if (IN(5)) { phase_norm_router(F, P); } SEAM(5);
    if (IN(6)) { phase_topk_convert(F, P); } SEAM(6);
    if (IN(7)) { JobGU J{P, F.G, (int)blockIdx.x, 512, 512, 512}; pg::gemm_phase<JobGU, true, true, true>(lds, J); } SEAM(7);
    if (IN(8)) { JobDown J{P, F.G, (int)blockIdx.x, 1024, 1024, 1024}; pg::gemm_phase<JobDown, true, false, true>(lds, J); } SEAM(8);
    if (IN(9)) { phase_final(F, P); }
#undef IN
#undef SEAM
}

extern "C" void kernel_launch(void* const* d_in, const int* in_sizes, int n_in, void* d_out, int out_size, void* d_ws, size_t ws_size, hipStream_t stream) {
    static int grid = 0;
    if (grid == 0) {
        if (n_in != 22 || in_sizes[0] != MTOK * DM || out_size != MTOK * DM || ws_size < WS_END) {
            fprintf(stderr, "kernel_launch: unexpected shapes (n_in %d, in0 %d, out %d, ws %zu)\n", n_in, n_in > 0 ? in_sizes[0] : -1, out_size, ws_size); grid = -1; return; }
        int dev = 0, cus = 0;
        if (hipGetDevice(&dev) != hipSuccess || hipDeviceGetAttribute(&cus, hipDeviceAttributeMultiprocessorCount, dev) != hipSuccess) { grid = -1; return; }
        if (hipFuncSetAttribute((const void*)fwd, hipFuncAttributeMaxDynamicSharedMemorySize, LDS_BYTES) != hipSuccess) { fprintf(stderr, "kernel_launch: hipFuncSetAttribute failed\n"); grid = -1; return; }
        int per_cu = 0;
        if (hipOccupancyMaxActiveBlocksPerMultiprocessor(&per_cu, (const void*)fwd, 512, LDS_BYTES) != hipSuccess || per_cu < 1) fprintf(stderr, "kernel_launch: occupancy query says %d\n", per_cu);
        (void)hipGetLastError();
        grid = cus;
        if (grid != 256) fprintf(stderr, "kernel_launch: %d CUs (built for 256)\n", grid);
    }
    if (grid < 0) return;
    (void)hipMemsetAsync((char*)d_ws + WS_CTL, 0, CTL_ZERO_BYTES, stream);
    Args a{};
    Ptrs& P = a.P;
    P.x = (const float*)d_in[0]; P.mem = (const float*)d_in[1]; P.attn_g = (const float*)d_in[2]; P.mem_g = (const float*)d_in[3]; P.w_in = (const float*)d_in[4]; P.w_mkv = (const float*)d_in[5];
    P.lq1 = (const float*)d_in[6]; P.lk1 = (const float*)d_in[7]; P.lq2 = (const float*)d_in[8]; P.lk2 = (const float*)d_in[9]; P.subln_g = (const float*)d_in[10]; P.wa_sink = (const float*)d_in[11];
    P.w_da_o = (const float*)d_in[12]; P.w_wa_o = (const float*)d_in[13]; P.w_xa_o = (const float*)d_in[14]; P.w_out = (const float*)d_in[15]; P.ffn_g = (const float*)d_in[16]; P.w_router = (const float*)d_in[17];
    P.w_eg = (const float*)d_in[18]; P.w_eu = (const float*)d_in[19]; P.w_ed = (const float*)d_in[20]; P.final_g = (const float*)d_in[21];
    P.out = (float*)d_out; P.ws = (unsigned char*)d_ws;
    if (MK_N_LAUNCHES == 1) { a.ph_lo = 0; a.ph_hi = N_PHASES; hipLaunchKernelGGL(fwd, dim3(grid), dim3(512), LDS_BYTES, stream, a); }
    else { for (int p = 0; p < N_PHASES; ++p) { a.ph_lo = p; a.ph_hi = p + 1; hipLaunchKernelGGL(fwd, dim3(grid), dim3(512), LDS_BYTES, stream, a); } }
}
```

```cpp
#include <hip/hip_runtime.h>
#include <cstdio>
#include <cstdint>

#define GATES_FP8 1
#define INPROJ_FP8 0
#define XA_FP8 1
#define YC_FP8 1
#define WA_FP8 1
#define XS_FP8 1
constexpr float XQ8_SCALE = 16.0f;
constexpr float P8_SCALE = 256.0f, MVW8_SCALE = 8.0f;
#ifndef MK_N_LAUNCHES
#define MK_N_LAUNCHES 1
#endif

#define LAS __attribute__((address_space(3)))
#define GAS __attribute__((address_space(1)))
typedef unsigned short bf16_t;
typedef short bf16x8 __attribute__((ext_vector_type(8)));
typedef float f32x4 __attribute__((ext_vector_type(4)));
typedef float f32x2 __attribute__((ext_vector_type(2)));
typedef float f32x16 __attribute__((ext_vector_type(16)));
typedef unsigned u32x4 __attribute__((ext_vector_type(4)));
typedef unsigned u32x2 __attribute__((ext_vector_type(2)));

constexpr int DM = 1024, NB = 32, SEQ = 2048, MTOK = NB * SEQ;
constexpr int MEML = 256, MMEM = NB * MEML;
constexpr int NEXP = 16, CAP = 256, DEXP = 2048;
constexpr int INW = 8704;
constexpr float EPS = 1e-6f;
constexpr float LOG2E = 1.4426950408889634f;
constexpr float LAM_INIT = 0.2f;

constexpr size_t MiB = 1u << 20;
constexpr size_t WS_CTL = 0, CTL_ZERO_BYTES = 64 * 1024;
constexpr size_t WS_KMAX = 32 * 1024;
constexpr size_t WS_GL = 1 * MiB;
constexpr size_t WS_IDX = 1 * MiB + 512 * 1024;
constexpr size_t WS_INV = 2 * MiB;
constexpr size_t WS_WIN = 4 * MiB;
constexpr size_t WS_WMKV = 21 * MiB;
constexpr size_t WS_WDAO = 25 * MiB, WS_WWAO = 27 * MiB, WS_WXAO = 29 * MiB, WS_WOUT = 31 * MiB;
constexpr size_t WS_MN = 33 * MiB;
constexpr size_t WS_MK = 49 * MiB, WS_MV = 65 * MiB;
constexpr size_t WS_MVW = 81 * MiB;
constexpr size_t WS_AFF = 145 * MiB;
constexpr size_t WS_SG0 = 448 * MiB, WS_SG1 = 768 * MiB;
constexpr size_t WS_WXQ8 = 152 * MiB, WS_WMKV8 = 153 * MiB, WS_MN8 = 155 * MiB;
constexpr size_t WS_WWA8 = 163 * MiB;
constexpr size_t WS_WG8 = 149 * MiB;
constexpr size_t WS_ACT0 = 192 * MiB;
constexpr size_t WS_DAQ = 192 * MiB, WS_DAK = 320 * MiB, WS_DAVT = 448 * MiB, WS_WAQ = 576 * MiB, WS_WAK = 704 * MiB, WS_WAVT = 736 * MiB,
                 WS_XAQ = 768 * MiB, WS_H = 896 * MiB, WS_END = 1024 * MiB;
constexpr size_t WS_MERGED = WS_DAK;
constexpr size_t WS_X1 = 192 * MiB;
constexpr size_t WS_H2 = 320 * MiB;
constexpr size_t WS_WGU = 384 * MiB;
constexpr size_t WS_WD = 448 * MiB;
constexpr size_t WS_ACTB = 480 * MiB;
constexpr size_t WS_YE = 736 * MiB;

constexpr int R_DAQ = 0, R_DAK = 1024, R_WAQ = 2048, R_XAQ = 3072, R_WAK = 4096, R_DAV = 4352, R_WAV = 5376, R_GATE = 5632;

constexpr int RING_BYTES = 131072;
constexpr int EPI_OFF = RING_BYTES;
constexpr int MISC_OFF = RING_BYTES + 8192;
constexpr int LDS_BYTES = 147456;

#define LDS_WAIT() asm volatile("s_waitcnt lgkmcnt(0)" ::: "memory")
#define VM_WAIT() asm volatile("s_waitcnt vmcnt(0)" ::: "memory")
__device__ __forceinline__ unsigned cvt_pk_bf16(float lo, float hi) { unsigned r; asm volatile("v_cvt_pk_bf16_f32 %0, %1, %2" : "=v"(r) : "v"(lo), "v"(hi)); return r; }
typedef __bf16 bf16x2_t __attribute__((ext_vector_type(2)));
__device__ __forceinline__ unsigned cvt_pk_bf16_c(float lo, float hi) { f32x2 v; v.x = lo; v.y = hi; return __builtin_bit_cast(unsigned, __builtin_convertvector(v, bf16x2_t)); }
__device__ __forceinline__ float bf_lo(unsigned w) { return __uint_as_float(w << 16); }
__device__ __forceinline__ float bf_hi(unsigned w) { return __uint_as_float(w & 0xffff0000u); }
__device__ __forceinline__ float wave_sum(float v) {
#pragma unroll
    for (int o = 1; o < 64; o <<= 1) v += __shfl_xor(v, o);
    return v;
}
typedef int v8i __attribute__((ext_vector_type(8)));
typedef int v4i __attribute__((ext_vector_type(4)));
constexpr float W8_SCALE = 64.0f, ACT8_SCALE = 8.0f, YE8_SCALE = 8.0f;
__device__ __forceinline__ float clamp8(float v) { return fminf(fmaxf(v, -448.0f), 448.0f); }
__device__ __forceinline__ unsigned pk4_fp8(float a, float b, float c, float d) {
    int w = 0; w = __builtin_amdgcn_cvt_pk_fp8_f32(clamp8(a), clamp8(b), w, false); w = __builtin_amdgcn_cvt_pk_fp8_f32(clamp8(c), clamp8(d), w, true); return (unsigned)w; }
__device__ __forceinline__ float fast_sigmoid(float v) { return __builtin_amdgcn_rcpf(1.0f + __builtin_amdgcn_exp2f(-LOG2E * v)); }

#define XB_TMO      128
#define XB_XCNT(j)  (256  + 64 * (j))
#define XB_XSUB(j)  (1280 + 64 * (j))
#define XB_XGEN(j)  (2304 + 64 * (j))
#define XB_TOP      3328
#define XB_TOPGEN   3392
#define XCD_BAR_WORDS 3456
#define XB_SPIN_CAP (1u << 18)
__device__ __forceinline__ unsigned xb_ld(unsigned* p)              { return __hip_atomic_load(p, __ATOMIC_RELAXED, __HIP_MEMORY_SCOPE_AGENT); }
__device__ __forceinline__ unsigned xb_add(unsigned* p, unsigned v) { return __hip_atomic_fetch_add(p, v, __ATOMIC_RELAXED, __HIP_MEMORY_SCOPE_AGENT); }
__device__ __forceinline__ unsigned xb_xcc_id() { return (unsigned)__builtin_amdgcn_s_getreg((3 << 11) | 20) & 0xFu; }
#define XB_SPIN(cond, bar) do { unsigned _sp = 0; while (cond) { __builtin_amdgcn_s_sleep(1); \
    if ((++_sp & 255u) == 0u) { if (xb_ld(&(bar)[XB_TMO])) break; if (_sp > XB_SPIN_CAP) { atomicAdd(&(bar)[XB_TMO], 1u); break; } } } } while (0)
struct XcdBarrier { unsigned* bar; unsigned x; volatile LAS unsigned* st; };
__device__ __forceinline__ XcdBarrier xcd_barrier_post(unsigned* bar, volatile LAS unsigned* st) {
    XcdBarrier b; b.bar = bar; b.x = xb_xcc_id(); b.st = st;
    if (threadIdx.x == 0) (void)xb_add(&bar[XB_XCNT(b.x)], 1u);
    return b;
}
__device__ __forceinline__ void xcd_barrier_complete(unsigned* bar, unsigned x, unsigned& nloc, unsigned& nx) {
    const unsigned G = gridDim.x * gridDim.y * gridDim.z;
    unsigned sum, cnt, mine, sp = 0u;
    for (;;) {
        sum = 0u; cnt = 0u; mine = 0u;
#pragma unroll
        for (unsigned j = 0; j < 16; ++j) { const unsigned c = xb_ld(&bar[XB_XCNT(j)]); sum += c; cnt += (c > 0u) ? 1u : 0u; mine = (j == x) ? c : mine; }
        if (sum == G) break;
        __builtin_amdgcn_s_sleep(1);
        if ((++sp & 255u) == 0u) { if (xb_ld(&bar[XB_TMO])) break; if (sp > XB_SPIN_CAP) { atomicAdd(&bar[XB_TMO], 1u); break; } }
    }
    nloc = mine > 0u ? mine : 1u; nx = cnt > 0u ? cnt : 1u;
}
__device__ __forceinline__ void xcd_barrier(const XcdBarrier& b) {
    asm volatile("s_waitcnt vmcnt(0)" ::: "memory");
    __syncthreads();
    if (threadIdx.x == 0) {
        unsigned* bar = b.bar;
        __builtin_amdgcn_s_waitcnt(0);
        unsigned nloc = b.st[0], nx = b.st[1];
        if (nloc == 0u) { xcd_barrier_complete(bar, b.x, nloc, nx); b.st[0] = nloc; b.st[1] = nx; }
        const unsigned old = xb_add(&bar[XB_XSUB(b.x)], 1u);
        const unsigned gen = old / nloc;
        if (old + 1u == (gen + 1u) * nloc) {
            __builtin_amdgcn_fence(__ATOMIC_RELEASE, "agent");
            asm volatile("s_waitcnt vmcnt(0)" ::: "memory");
            const unsigned og = xb_add(&bar[XB_TOP], 1u);
            const unsigned tg = og / nx;
            if (og + 1u == (tg + 1u) * nx) xb_add(&bar[XB_TOPGEN], 1u);
            else XB_SPIN(xb_ld(&bar[XB_TOPGEN]) == tg, bar);
            __builtin_amdgcn_fence(__ATOMIC_ACQUIRE, "agent");
            xb_add(&bar[XB_XGEN(b.x)], 1u);
            asm volatile("s_waitcnt vmcnt(0)" ::: "memory");
        } else {
            XB_SPIN(xb_ld(&bar[XB_XGEN(b.x)]) == gen, bar);
            __builtin_amdgcn_fence(__ATOMIC_ACQUIRE, "agent");
            asm volatile("s_waitcnt vmcnt(0)" ::: "memory");
        }
    }
    __syncthreads();
}

namespace pg {
constexpr int BM = 256, BK = 64, HALF = 128, HTB = HALF * BK * 2, STAGE_BYTES = 8 * HTB, NXCD = 8, WGM = 8;
__host__ __device__ __forceinline__ int lds_byte(int r, int c) { const int st = (r >> 4) * 2 + (c >> 5), rr = r & 15, cc = c & 31, ob = rr * 64 + cc * 2; return st * 1024 + (ob ^ (((ob >> 9) & 1) << 5)); }
__host__ __device__ __forceinline__ void stage_rc(int b, int& R, int& C) { const int st = b / 1024, sb = b % 1024, swz = sb ^ (((sb >> 9) & 1) << 5); R = (st >> 1) * 16 + swz / 64; C = (st & 1) * 32 + (swz % 64) / 2; }
__host__ __device__ __forceinline__ int perm32(int rho) { const int n = rho >> 4, i = rho & 15; return 8 * (i >> 2) + 4 * n + (i & 3); }
__device__ __forceinline__ void xcd_map(int L, int nM, int nN, int& pm, int& pn) {
    const int nwg = nM * nN; int wgid = L;
    { const int q = nwg / NXCD, r = nwg % NXCD, xcd = wgid % NXCD, off = wgid / NXCD; wgid = (xcd < r ? xcd * (q + 1) : r * (q + 1) + (xcd - r) * q) + off; }
    const int nig = WGM * nN, gid = wgid / nig, fm = gid * WGM, gsz = (nM - fm) < WGM ? (nM - fm) : WGM;
    pm = fm + ((wgid % nig) % gsz); pn = (wgid % nig) / gsz;
}
struct GUnit { const char* A; const char* B; int pm, pn, job; };

#ifndef PG_SP2
#define PG_SP2 1
#endif
template <class Job, bool PERM, bool GATHER, bool FP8 = false>
__device__ __forceinline__ void gemm_phase(LAS unsigned char* lds, const Job& J) {
    const int tid = threadIdx.x, wid = __builtin_amdgcn_readfirstlane(tid >> 6), lane = tid & 63, wr = wid >> 2, wc = wid & 3, fr = lane & 15, fq = lane >> 4;
    const int K = J.K, nt = K / BK, lda = J.lda, ldb = J.ldb;
    int R0, C0, R1, C1; stage_rc(tid * 16, R0, C0); stage_rc(tid * 16 + 8192, R1, C1);
    unsigned vA[2][2], vAn[2][2], vB[2];
    { const int Rb0 = PERM ? ((R0 & ~31) + perm32(R0 & 31)) : R0, Rb1 = PERM ? ((R1 & ~31) + perm32(R1 & 31)) : R1;
      vB[0] = (unsigned)(Rb0 * ldb + C0) * 2u; vB[1] = (unsigned)(Rb1 * ldb + C1) * 2u; }
    const size_t kstep = (size_t)(BK * 2);
    const size_t hstepB = (size_t)HALF * ldb * 2;
    const unsigned ldsw = (unsigned)wid * 1024u;
    const unsigned ldsb = (unsigned)__builtin_amdgcn_readfirstlane((int)((unsigned)(uintptr_t)lds + ldsw));
    const int aoff = lds_byte(wr * 64 + fr, fq * 8), boff = lds_byte(wc * 32 + fr, fq * 8);
#define PG_SA(b, h) (((b) * 2 + (h)) * HTB)
#define PG_SB(b, h) ((4 + (b) * 2 + (h)) * HTB)
#define PG_STAGE(bufoff, gbase, voff) do { _Pragma("unroll") for (int _i = 0; _i < 2; ++_i) { unsigned _keep; \
        asm volatile("s_mov_b32 %0, m0\n\ts_mov_b32 m0, %3\n\ts_nop 0\n\tglobal_load_lds_dwordx4 %1, %2\n\ts_mov_b32 m0, %0" \
            : "=&s"(_keep) : "v"((voff)[_i]), "s"((const char*)(gbase)), "s"(ldsb + (unsigned)((bufoff) + _i * 8192)) : "memory"); } } while (0)
#define PG_LDA(dst, b, h) do { _Pragma("unroll") for (int m = 0; m < 4; ++m) _Pragma("unroll") for (int k = 0; k < 2; ++k) dst[m][k] = *(const LAS bf16x8*)(lds + PG_SA(b, h) + aoff + m * 2048 + k * 1024); } while (0)
#define PG_LDB(dst, b, h) do { _Pragma("unroll") for (int n = 0; n < 2; ++n) _Pragma("unroll") for (int k = 0; k < 2; ++k) dst[n][k] = *(const LAS bf16x8*)(lds + PG_SB(b, h) + boff + n * 2048 + k * 1024); } while (0)
#define PG_CAT8(x) __builtin_shufflevector(__builtin_bit_cast(v4i, (x)[0]), __builtin_bit_cast(v4i, (x)[1]), 0, 1, 2, 3, 4, 5, 6, 7)
#define PG_MMA(ai, bj, At, Bt) do { __builtin_amdgcn_s_setprio(1); _Pragma("unroll") for (int m = 0; m < 4; ++m) _Pragma("unroll") for (int n = 0; n < 2; ++n) { \
        if constexpr (FP8) { asm volatile("v_mfma_scale_f32_16x16x128_f8f6f4 %0, %1, %2, %0, %3, %3 op_sel_hi:[0,0,0]" : "+v"(acc[ai][bj][m][n]) : "v"(PG_CAT8(Bt[n])), "v"(PG_CAT8(At[m])), "v"(sc8)); } \
        else { _Pragma("unroll") for (int k = 0; k < 2; ++k) acc[ai][bj][m][n] = __builtin_amdgcn_mfma_f32_16x16x32_bf16(Bt[n][k], At[m][k], acc[ai][bj][m][n], 0, 0, 0); } } \
        __builtin_amdgcn_s_setprio(0); } while (0)
#define PG_WAIT_V(n) asm volatile("s_waitcnt vmcnt(" #n ")" ::: "memory")
#define PG_WAIT_L(n) asm volatile("s_waitcnt lgkmcnt(" #n ")" ::: "memory")
#define PG_BAR __builtin_amdgcn_s_barrier()
#define PG_SCHED __builtin_amdgcn_sched_barrier(0)
#define PG_SETV(dst, u) do { if constexpr (GATHER) { const int* _rw = J.rows(u); \
        dst[0][0] = (unsigned)(_rw[R0] * lda + C0) * 2u; dst[0][1] = (unsigned)(_rw[R1] * lda + C1) * 2u; \
        dst[1][0] = (unsigned)(_rw[HALF + R0] * lda + C0) * 2u; dst[1][1] = (unsigned)(_rw[HALF + R1] * lda + C1) * 2u; } \
      else { dst[0][0] = (unsigned)(R0 * lda + C0) * 2u; dst[0][1] = (unsigned)(R1 * lda + C1) * 2u; \
        dst[1][0] = (unsigned)((HALF + R0) * lda + C0) * 2u; dst[1][1] = (unsigned)((HALF + R1) * lda + C1) * 2u; } } while (0)
    const int sc8 = 0x7f7f7f7f;
    GUnit cur, nxt; int ui = 0;
    if (!J.next(0, cur)) return;
    f32x4 acc[2][2][4][2];
#pragma unroll
    for (int a = 0; a < 2; ++a)
#pragma unroll
        for (int b = 0; b < 2; ++b)
#pragma unroll
            for (int m = 0; m < 4; ++m)
#pragma unroll
                for (int n = 0; n < 2; ++n) acc[a][b][m][n] = (f32x4){0.f, 0.f, 0.f, 0.f};
    bf16x8 At[4][2], B0[2][2], B1[2][2];
    const char* cA = cur.A; const char* cB = cur.B;
    PG_SETV(vA, cur);
    if (PG_SP2) {
    PG_STAGE(PG_SB(0, 0), cB, vB); PG_STAGE(PG_SB(0, 1), cB + hstepB, vB); PG_STAGE(PG_SA(0, 0), cA, vA[0]); PG_STAGE(PG_SA(0, 1), cA, vA[1]);
    if (wr == 1) PG_BAR;
    PG_WAIT_V(2); PG_BAR;
    PG_STAGE(PG_SB(1, 0), cB + kstep, vB); PG_STAGE(PG_SA(1, 0), cA + kstep, vA[0]); PG_STAGE(PG_SB(1, 1), cB + hstepB + kstep, vB);
    PG_WAIT_V(6); PG_BAR;
    } else {
    PG_STAGE(PG_SB(0, 0), cB, vB); PG_STAGE(PG_SA(0, 0), cA, vA[0]); PG_STAGE(PG_SB(0, 1), cB + hstepB, vB); PG_STAGE(PG_SA(0, 1), cA, vA[1]);
    if (wr == 1) PG_BAR;
    PG_WAIT_V(4); PG_BAR;
    PG_STAGE(PG_SB(1, 0), cB + kstep, vB); PG_STAGE(PG_SA(1, 0), cA + kstep, vA[0]); PG_STAGE(PG_SB(1, 1), cB + hstepB + kstep, vB);
    PG_WAIT_V(6); PG_BAR;
    }
    for (;;) {
        const bool has_next = J.next(ui + 1, nxt);
        const char* nA = has_next ? nxt.A : cA; const char* nB = has_next ? nxt.B : cB;
        if constexpr (GATHER) { if (has_next) { PG_SETV(vAn, nxt); } else {
#pragma unroll
            for (int h = 0; h < 2; ++h) { vAn[h][0] = vA[h][0]; vAn[h][1] = vA[h][1]; } } }
        for (int t = 0; t < nt; t += 2) {
            const bool last = (t == nt - 2);
            const char* a1 = cA + (size_t)(t + 1) * kstep;
            const char* a2 = last ? nA : cA + (size_t)(t + 2) * kstep; const char* b2 = last ? nB : cB + (size_t)(t + 2) * kstep;
            const char* a3 = a2 + kstep; const char* b3 = b2 + kstep;
            unsigned vq[2][2];
#pragma unroll
            for (int h = 0; h < 2; ++h)
#pragma unroll
                for (int i = 0; i < 2; ++i) vq[h][i] = (GATHER && last) ? vAn[h][i] : vA[h][i];
            if (PG_SP2) {
            PG_LDB(B0, 0, 0); PG_LDB(B1, 0, 1); PG_SCHED; PG_LDA(At, 0, 0); PG_STAGE(PG_SA(1, 1), a1, vA[1]);
            PG_WAIT_V(8); PG_WAIT_L(0); PG_BAR; PG_MMA(0, 0, At, B0); PG_MMA(0, 1, At, B1); PG_BAR; PG_SCHED;
            PG_LDA(At, 0, 1); PG_STAGE(PG_SB(0, 0), b2, vB); PG_STAGE(PG_SB(0, 1), b2 + hstepB, vB); PG_STAGE(PG_SA(0, 0), a2, vq[0]);
            PG_WAIT_V(8); PG_WAIT_L(0); PG_BAR; PG_MMA(1, 0, At, B0); PG_MMA(1, 1, At, B1); PG_BAR; PG_SCHED;
            PG_LDB(B0, 1, 0); PG_LDB(B1, 1, 1); PG_SCHED; PG_LDA(At, 1, 0); PG_STAGE(PG_SA(0, 1), a2, vq[1]);
            PG_WAIT_V(8); PG_WAIT_L(0); PG_BAR; PG_MMA(0, 0, At, B0); PG_MMA(0, 1, At, B1); PG_BAR; PG_SCHED;
            PG_LDA(At, 1, 1); PG_STAGE(PG_SB(1, 0), b3, vB); PG_STAGE(PG_SB(1, 1), b3 + hstepB, vB); PG_STAGE(PG_SA(1, 0), a3, vq[0]);
            PG_WAIT_V(8); PG_WAIT_L(0); PG_BAR; PG_MMA(1, 0, At, B0); PG_MMA(1, 1, At, B1); PG_BAR; PG_SCHED;
            } else {
            PG_LDB(B0, 0, 0); PG_SCHED; PG_LDA(At, 0, 0); PG_STAGE(PG_SA(1, 1), a1, vA[1]);
            PG_WAIT_L(8); PG_BAR; PG_WAIT_L(0); PG_MMA(0, 0, At, B0); PG_BAR; PG_SCHED;
            PG_LDB(B1, 0, 1); PG_STAGE(PG_SB(0, 0), b2, vB);
            PG_BAR; PG_WAIT_L(0); PG_MMA(0, 1, At, B1); PG_BAR;
            PG_LDA(At, 0, 1); PG_STAGE(PG_SA(0, 0), a2, vq[0]);
            PG_BAR; PG_WAIT_L(0); PG_MMA(1, 0, At, B0); PG_BAR; PG_SCHED;
            PG_STAGE(PG_SB(0, 1), b2 + hstepB, vB);
            PG_WAIT_V(6); PG_BAR; PG_MMA(1, 1, At, B1); PG_BAR;
            PG_LDB(B0, 1, 0); PG_SCHED; PG_LDA(At, 1, 0); PG_STAGE(PG_SA(0, 1), a2, vq[1]);
            PG_WAIT_L(8); PG_BAR; PG_WAIT_L(0); PG_MMA(0, 0, At, B0); PG_BAR; PG_SCHED;
            PG_LDB(B1, 1, 1); PG_STAGE(PG_SB(1, 0), b3, vB);
            PG_BAR; PG_WAIT_L(0); PG_MMA(0, 1, At, B1); PG_BAR;
            PG_LDA(At, 1, 1); PG_STAGE(PG_SA(1, 0), a3, vq[0]);
            PG_BAR; PG_WAIT_L(0); PG_MMA(1, 0, At, B0); PG_BAR; PG_SCHED;
            PG_STAGE(PG_SB(1, 1), b3 + hstepB, vB);
            PG_WAIT_V(6); PG_BAR; PG_MMA(1, 1, At, B1); PG_BAR;
            }
        }
        if constexpr (FP8) asm volatile("s_nop 15\n\ts_nop 7" ::: "memory");
        if (wr == 0) PG_BAR;
        J.epi(acc, cur, wr, wc, fr, fq);
        if (!has_next) break;
#pragma unroll
        for (int a = 0; a < 2; ++a)
#pragma unroll
            for (int b = 0; b < 2; ++b)
#pragma unroll
                for (int m = 0; m < 4; ++m)
#pragma unroll
                    for (int n = 0; n < 2; ++n) acc[a][b][m][n] = (f32x4){0.f, 0.f, 0.f, 0.f};
        cur = nxt; cA = nA; cB = nB; ++ui;
        if constexpr (GATHER) {
#pragma unroll
            for (int h = 0; h < 2; ++h) { vA[h][0] = vAn[h][0]; vA[h][1] = vAn[h][1]; } }
        if (wr == 1) PG_BAR;
    }
    PG_WAIT_V(0);
    PG_BAR;
#undef PG_SA
#undef PG_SB
#undef PG_STAGE
#undef PG_LDA
#undef PG_LDB
#undef PG_MMA
#undef PG_CAT8
#undef PG_WAIT_V
#undef PG_WAIT_L
#undef PG_BAR
#undef PG_SCHED
#undef PG_SETV
}

__device__ __forceinline__ void store_tile_bf16(const f32x4 (&acc)[2][2][4][2], bf16_t* O, int ldo, float sc, int wr, int wc, int fr, int fq) {
    const unsigned loff = (unsigned)((wr * 64 + fr) * ldo + wc * 32 + 8 * fq) * 2u;
#pragma unroll
    for (int ai = 0; ai < 2; ++ai)
#pragma unroll
        for (int m = 0; m < 4; ++m) { char* rowb = (char*)O + (size_t)(ai * HALF + m * 16) * ldo * 2;
#pragma unroll
            for (int bj = 0; bj < 2; ++bj) { const f32x4 v0 = acc[ai][bj][m][0] * sc, v1 = acc[ai][bj][m][1] * sc;
                u32x4 w; w.x = cvt_pk_bf16(v0[0], v0[1]); w.y = cvt_pk_bf16(v0[2], v0[3]); w.z = cvt_pk_bf16(v1[0], v1[1]); w.w = cvt_pk_bf16(v1[2], v1[3]);
                *(u32x4*)(rowb + bj * HALF * 2 + loff) = w; } }
}
}

struct Ptrs {
    const float* x; const float* mem; const float* attn_g; const float* mem_g; const float* w_in; const float* w_mkv;
    const float* lq1; const float* lk1; const float* lq2; const float* lk2; const float* subln_g; const float* wa_sink;
    const float* w_da_o; const float* w_wa_o; const float* w_xa_o; const float* w_out; const float* ffn_g; const float* w_router;
    const float* w_eg; const float* w_eu; const float* w_ed; const float* final_g;
    float* out; unsigned char* ws;
};
#define WSP(T, off) ((T*)(P.ws + (off)))

struct JobP1 {
    Ptrs P; int G, c; int K, lda, ldb; LAS float* scr;
    __device__ __forceinline__ bool next(int i, pg::GUnit& u) const {
        int L = i * G + c;
        constexpr size_t RB = INPROJ_FP8 ? 1024 : 2048;
        const char* h = INPROJ_FP8 ? (const char*)P.out + 128 * MiB : (const char*)(P.ws + WS_H); const char* w = (const char*)(P.ws + WS_WIN);
        if (XA_FP8 && WA_FP8) {
            if (L < 2048) { pg::xcd_map(L, 256, 8, u.pm, u.pn); u.job = 0; u.A = h + (size_t)u.pm * (256 * RB); u.B = w + (size_t)u.pn * (256 * RB); return true; }
            L -= 2048;
            if (L < 1024) { pg::xcd_map(L, 4, 256, u.pm, u.pn); u.job = 1; u.A = w + (size_t)(R_DAV + u.pm * 256) * RB; u.B = h + (size_t)u.pn * (256 * RB); return true; }
            return false;
        }
        if (XA_FP8) {
            if (L < 3328) { pg::xcd_map(L, 256, 13, u.pm, u.pn); if (u.pn == 12) u.pn = 16; u.job = 0; u.A = h + (size_t)u.pm * (256 * RB); u.B = w + (size_t)u.pn * (256 * RB); return true; }
            L -= 3328;
            if (L < 1280) { pg::xcd_map(L, 5, 256, u.pm, u.pn); u.job = 1; u.A = w + (size_t)(R_DAV + u.pm * 256) * RB; u.B = h + (size_t)u.pn * (256 * RB); return true; }
            return false;
        }
        if (L < 4352) { pg::xcd_map(L, 256, 17, u.pm, u.pn); u.job = 0; u.A = h + (size_t)u.pm * (256 * RB); u.B = w + (size_t)u.pn * (256 * RB); return true; }
        L -= 4352;
        if (L < 1280) { pg::xcd_map(L, 5, 256, u.pm, u.pn); u.job = 1; u.A = w + (size_t)(R_DAV + u.pm * 256) * RB; u.B = h + (size_t)u.pn * (256 * RB); return true; }
        L -= 1280;
        if (L < 256) { pg::xcd_map(L, 32, 8, u.pm, u.pn); u.job = 2; u.A = (const char*)(P.ws + WS_MN) + (size_t)u.pm * (256 * RB); u.B = (const char*)(P.ws + WS_WMKV) + (size_t)u.pn * (256 * RB); return true; }
        return false;
    }
    __device__ __forceinline__ const int* rows(const pg::GUnit&) const { return nullptr; }
    __device__ __forceinline__ void epi(const f32x4 (&acc)[2][2][4][2], const pg::GUnit& u, int wr, int wc, int fr, int fq) const {
        bf16_t* O; int ldo = 1024; float sc = INPROJ_FP8 ? (1.0f / W8_SCALE) : 1.f;
        if (u.job == 0) {
            const int s = u.pn >> 2, q = u.pn & 3;
            if (s == 0) { O = WSP(bf16_t, WS_DAQ) + (size_t)u.pm * 256 * 1024 + q * 256; sc *= 0.125f * LOG2E; }
            else if (s == 1) { O = WSP(bf16_t, WS_DAK) + (size_t)u.pm * 256 * 1024 + q * 256; }
            else if (s == 2) { O = WSP(bf16_t, WS_WAQ) + (size_t)u.pm * 256 * 1024 + q * 256; sc *= 0.125f * LOG2E; }
            else if (s == 3) { O = WSP(bf16_t, WS_XAQ) + (size_t)u.pm * 256 * 1024 + q * 256; sc *= 0.0625f * LOG2E; }
            else { O = WSP(bf16_t, WS_WAK) + (size_t)u.pm * 256 * 256; ldo = 256; }
        } else if (u.job == 1) {
            ldo = MTOK;
            if (u.pm < 4) O = WSP(bf16_t, WS_DAVT) + (size_t)u.pm * 256 * MTOK + (size_t)u.pn * 256;
            else O = WSP(bf16_t, WS_WAVT) + (size_t)u.pn * 256;
        } else {
            if (u.pn < 4) O = WSP(bf16_t, WS_MK) + (size_t)u.pm * 256 * 1024 + u.pn * 256;
            else O = WSP(bf16_t, WS_MV) + (size_t)u.pm * 256 * 1024 + (u.pn - 4) * 256;
        }
        pg::store_tile_bf16(acc, O, ldo, sc, wr, wc, fr, fq);
        if (u.job == 0 && (u.pn >> 2) == 1) {
            LAS float* X = scr;
#pragma unroll
            for (int ai = 0; ai < 2; ++ai)
#pragma unroll
                for (int m = 0; m < 4; ++m)
#pragma unroll
                    for (int bj = 0; bj < 2; ++bj) { const f32x4 a = acc[ai][bj][m][0] * sc, b2 = acc[ai][bj][m][1] * sc;
                        float q = (a[0] * a[0] + a[1] * a[1]) + (a[2] * a[2] + a[3] * a[3]) + (b2[0] * b2[0] + b2[1] * b2[1]) + (b2[2] * b2[2] + b2[3] * b2[3]);
                        q += __shfl_xor(q, 16); q += __shfl_xor(q, 32);
                        if (fq == 0) X[((ai * 128 + wr * 64 + m * 16 + fr) * 2 + bj) * 4 + wc] = q; }
            LDS_WAIT(); __builtin_amdgcn_s_barrier(); asm volatile("" ::: "memory");
            { const int t = threadIdx.x, row = t & 255, bj = t >> 8; const f32x4 q = *(const LAS f32x4*)(X + (row * 2 + bj) * 4);
              float v = fmaxf(q[0] + q[1], q[2] + q[3]) * 1.01f;
#pragma unroll
              for (int off = 1; off < 64; off <<= 1) v = fmaxf(v, __shfl_xor(v, off));
              if ((t & 63) == 0) __hip_atomic_fetch_max(WSP(unsigned, WS_KMAX) + (u.pm >> 3) * 8 + 2 * (u.pn - 4) + bj, __float_as_uint(v), __ATOMIC_RELAXED, __HIP_MEMORY_SCOPE_AGENT); }
            LDS_WAIT(); __builtin_amdgcn_s_barrier(); asm volatile("" ::: "memory");
        }
    }
};

struct JobP1x {
    Ptrs P; int G, c; int K, lda, ldb;
    __device__ __forceinline__ bool next(int i, pg::GUnit& u) const {
        int L = i * G + c;
        if (L < 1024) { pg::xcd_map(L, 256, 4, u.pm, u.pn); u.job = 0; u.A = (const char*)P.out + 128 * MiB + (size_t)u.pm * (256 * 1024); u.B = (const char*)(P.ws + WS_WXQ8) + (size_t)u.pn * (256 * 1024); return true; }
        L -= 1024;
        if (L < 256) { pg::xcd_map(L, 32, 8, u.pm, u.pn); u.job = 2; u.A = (const char*)(P.ws + WS_MN8) + (size_t)u.pm * (256 * 1024); u.B = (const char*)(P.ws + WS_WMKV8) + (size_t)u.pn * (256 * 1024); return true; }
        if (!WA_FP8) return false;
        L -= 256;
        const char* h8 = (const char*)P.out + 128 * MiB; const char* w8 = (const char*)(P.ws + WS_WWA8);
        if (L < 1280) { pg::xcd_map(L, 256, 5, u.pm, u.pn); u.job = 3; u.A = h8 + (size_t)u.pm * (256 * 1024); u.B = w8 + (size_t)u.pn * (256 * 1024); return true; }
        L -= 1280;
        if (L < 256) { u.pm = 0; u.pn = L; u.job = 4; u.A = w8 + (size_t)1280 * 1024; u.B = h8 + (size_t)u.pn * (256 * 1024); return true; }
        return false;
    }
    __device__ __forceinline__ const int* rows(const pg::GUnit&) const { return nullptr; }
    __device__ __forceinline__ void epi(const f32x4 (&acc)[2][2][4][2], const pg::GUnit& u, int wr, int wc, int fr, int fq) const {
        bf16_t* O; float sc = 1.0f / W8_SCALE;
        if (u.job >= 3) {
            int ldo = 1024;
            if (u.job == 4) { O = WSP(bf16_t, WS_WAVT) + (size_t)u.pn * 256; ldo = MTOK; }
            else if (u.pn < 4) { O = WSP(bf16_t, WS_WAQ) + (size_t)u.pm * 256 * 1024 + u.pn * 256; sc *= 0.125f * LOG2E; }
            else { O = WSP(bf16_t, WS_WAK) + (size_t)u.pm * 256 * 256; ldo = 256; }
            pg::store_tile_bf16(acc, O, ldo, sc, wr, wc, fr, fq);
            return; }
        if (u.job == 0) { O = WSP(bf16_t, WS_XAQ) + (size_t)u.pm * 256 * 1024 + u.pn * 256; sc *= 0.0625f * LOG2E; }
        else if (u.pn < 4) O = WSP(bf16_t, WS_MK) + (size_t)u.pm * 256 * 1024 + u.pn * 256;
        else O = WSP(bf16_t, WS_MV) + (size_t)u.pm * 256 * 1024 + (u.pn - 4) * 256;
        if (XS_FP8) {
            if (u.job == 0) sc *= XQ8_SCALE;
            char* O8 = (char*)(P.ws + (u.job == 0 ? WS_XAQ : (u.pn < 4 ? WS_MK : WS_MV))) + (size_t)u.pm * 256 * 1024 + (u.pn & 3) * 256;
            const unsigned loff = (unsigned)((wr * 64 + fr) * 1024 + wc * 32 + 8 * fq);
#pragma unroll
            for (int ai = 0; ai < 2; ++ai)
#pragma unroll
                for (int m = 0; m < 4; ++m)
#pragma unroll
                    for (int bj = 0; bj < 2; ++bj) { const f32x4 a = acc[ai][bj][m][0] * sc, b2 = acc[ai][bj][m][1] * sc;
                        u32x2 w; w.x = pk4_fp8(a[0], a[1], a[2], a[3]); w.y = pk4_fp8(b2[0], b2[1], b2[2], b2[3]);
                        *(u32x2*)(O8 + (size_t)(ai * 128 + m * 16) * 1024 + bj * 128 + loff) = w; }
            return; }
        pg::store_tile_bf16(acc, O, 1024, sc, wr, wc, fr, fq);
    }
};

struct JobXA {
    Ptrs P; int G, c; int K, lda, ldb; LAS float* scr;
    __device__ __forceinline__ bool next(int i, pg::GUnit& u) const {
        const int L = i * G + c; if (L >= 1024) return false;
        u.job = 0; u.pm = L >> 2; u.pn = L & 3;
        if (XS_FP8) { u.A = (const char*)(P.ws + WS_XAQ) + (size_t)u.pm * (256 * 1024) + u.pn * 256;
                      u.B = (const char*)(P.ws + WS_MK) + (size_t)(u.pm >> 3) * (256 * 1024) + u.pn * 256; return true; }
        u.A = (const char*)(P.ws + WS_XAQ) + (size_t)u.pm * (256 * 1024 * 2) + u.pn * 512;
        u.B = (const char*)(P.ws + WS_MK) + (size_t)(u.pm >> 3) * (256 * 1024 * 2) + u.pn * 512; return true;
    }
    __device__ __forceinline__ const int* rows(const pg::GUnit&) const { return nullptr; }
    __device__ __forceinline__ void epi(f32x4 (&acc)[2][2][4][2], const pg::GUnit& u, int wr, int wc, int fr, int fq) const {
        LAS f32x2* X = (LAS f32x2*)scr;
        if (XS_FP8) {
#pragma unroll
            for (int ai = 0; ai < 2; ++ai)
#pragma unroll
                for (int bj = 0; bj < 2; ++bj)
#pragma unroll
                    for (int m = 0; m < 4; ++m)
#pragma unroll
                        for (int n = 0; n < 2; ++n) acc[ai][bj][m][n] = acc[ai][bj][m][n] * (1.0f / XQ8_SCALE); }
        float lm[2][4];
#pragma unroll
        for (int ai = 0; ai < 2; ++ai)
#pragma unroll
            for (int m = 0; m < 4; ++m) { float v = -3.0e38f;
#pragma unroll
                for (int bj = 0; bj < 2; ++bj)
#pragma unroll
                    for (int n = 0; n < 2; ++n) { const f32x4 a = acc[ai][bj][m][n]; v = fmaxf(v, fmaxf(fmaxf(a[0], a[1]), fmaxf(a[2], a[3]))); }
                v = fmaxf(v, __shfl_xor(v, 16)); v = fmaxf(v, __shfl_xor(v, 32));
                float sm = 0.f;
#pragma unroll
                for (int bj = 0; bj < 2; ++bj)
#pragma unroll
                    for (int n = 0; n < 2; ++n) { f32x4 a = acc[ai][bj][m][n];
#pragma unroll
                        for (int j = 0; j < 4; ++j) { a[j] = __builtin_amdgcn_exp2f(a[j] - v); sm += a[j]; }
                        acc[ai][bj][m][n] = a; }
                sm += __shfl_xor(sm, 16); sm += __shfl_xor(sm, 32);
                lm[ai][m] = v; if (fq == 0) X[(ai * 128 + wr * 64 + m * 16 + fr) * 4 + wc] = (f32x2){v, sm}; }
        LDS_WAIT(); __builtin_amdgcn_s_barrier(); asm volatile("" ::: "memory");
#pragma unroll
        for (int ai = 0; ai < 2; ++ai)
#pragma unroll
            for (int m = 0; m < 4; ++m) { const LAS f32x2* xp = X + (ai * 128 + wr * 64 + m * 16 + fr) * 4;
                const f32x2 p0 = xp[0], p1 = xp[1], p2 = xp[2], p3 = xp[3];
                const float M = fmaxf(fmaxf(p0[0], p1[0]), fmaxf(p2[0], p3[0]));
                const float tot = (p0[1] * __builtin_amdgcn_exp2f(p0[0] - M) + p1[1] * __builtin_amdgcn_exp2f(p1[0] - M)) + (p2[1] * __builtin_amdgcn_exp2f(p2[0] - M) + p3[1] * __builtin_amdgcn_exp2f(p3[0] - M));
                const float f = __builtin_amdgcn_exp2f(lm[ai][m] - M) / tot;
#pragma unroll
                for (int bj = 0; bj < 2; ++bj)
#pragma unroll
                    for (int n = 0; n < 2; ++n) acc[ai][bj][m][n] = acc[ai][bj][m][n] * f; }
        if (YC_FP8) { char* O8 = (char*)P.out + (size_t)u.pm * 256 * 1024 + u.pn * 256; const unsigned loff = (unsigned)((wr * 64 + fr) * 1024 + wc * 32 + 8 * fq);
#pragma unroll
            for (int ai = 0; ai < 2; ++ai)
#pragma unroll
                for (int m = 0; m < 4; ++m)
#pragma unroll
                    for (int bj = 0; bj < 2; ++bj) { const f32x4 a = acc[ai][bj][m][0] * P8_SCALE, b2 = acc[ai][bj][m][1] * P8_SCALE;
                        u32x2 w; w.x = pk4_fp8(a[0], a[1], a[2], a[3]); w.y = pk4_fp8(b2[0], b2[1], b2[2], b2[3]);
                        *(u32x2*)(O8 + (size_t)(ai * 128 + m * 16) * 1024 + bj * 128 + loff) = w; } }
        else { bf16_t* O = (bf16_t*)P.out + (size_t)u.pm * 256 * 1024 + u.pn * 256;
            pg::store_tile_bf16(acc, O, 1024, 1.f, wr, wc, fr, fq); }
        LDS_WAIT(); __builtin_amdgcn_s_barrier(); asm volatile("" ::: "memory");
    }
};
struct JobMVW {
    Ptrs P; int G, c; int K, lda, ldb;
    __device__ __forceinline__ bool next(int i, pg::GUnit& u) const {
        const int L = i * G + c; if (L >= 512) return false;
        u.job = 0; u.pm = L & 3; u.pn = L >> 2;
        if (XS_FP8) { u.A = (const char*)(P.ws + WS_WXAO) + (size_t)u.pm * (256 * 1024) + (u.pn & 3) * 256;
                      u.B = (const char*)(P.ws + WS_MV) + (size_t)(u.pn >> 2) * (256 * 1024) + (u.pn & 3) * 256; return true; }
        u.A = (const char*)(P.ws + WS_WXAO) + (size_t)u.pm * (256 * 1024 * 2) + (u.pn & 3) * 512;
        u.B = (const char*)(P.ws + WS_MV) + (size_t)(u.pn >> 2) * (256 * 1024 * 2) + (u.pn & 3) * 512; return true;
    }
    __device__ __forceinline__ const int* rows(const pg::GUnit&) const { return nullptr; }
    __device__ __forceinline__ void epi(const f32x4 (&acc)[2][2][4][2], const pg::GUnit& u, int wr, int wc, int fr, int fq) const {
        if (YC_FP8) { char* O8 = (char*)(P.ws + WS_MVW) + (size_t)(u.pn >> 2) * (1024 * 1024) + (size_t)u.pm * 256 * 1024 + (u.pn & 3) * 256;
            const unsigned loff = (unsigned)((wr * 64 + fr) * 1024 + wc * 32 + 8 * fq);
#pragma unroll
            for (int ai = 0; ai < 2; ++ai)
#pragma unroll
                for (int m = 0; m < 4; ++m)
#pragma unroll
                    for (int bj = 0; bj < 2; ++bj) { const float ms = XS_FP8 ? MVW8_SCALE / W8_SCALE : MVW8_SCALE; const f32x4 a = acc[ai][bj][m][0] * ms, b2 = acc[ai][bj][m][1] * ms;
                        u32x2 w; w.x = pk4_fp8(a[0], a[1], a[2], a[3]); w.y = pk4_fp8(b2[0], b2[1], b2[2], b2[3]);
                        *(u32x2*)(O8 + (size_t)(ai * 128 + m * 16) * 1024 + bj * 128 + loff) = w; } }
        else { bf16_t* O = WSP(bf16_t, WS_MVW) + (size_t)(u.pn >> 2) * (1024 * 1024) + (size_t)u.pm * 256 * 1024 + (u.pn & 3) * 256;
            pg::store_tile_bf16(acc, O, 1024, 1.f, wr, wc, fr, fq); }
    }
};

__device__ __forceinline__ char* sg_base(const Ptrs& P, int br) {
    return br == 0 ? (char*)(P.ws + WS_SG0) : br == 1 ? (char*)(P.ws + WS_SG1) : (GATES_FP8 ? (char*)(P.ws + WS_H) : (char*)P.out + 128 * MiB);
}
struct JobMergeG {
    Ptrs P; int G, c; int K, lda, ldb;
    __device__ __forceinline__ bool next(int i, pg::GUnit& u) const {
        if (i >= 12) return false;
        const int ti = i / 3, br = i - ti * 3;
        pg::xcd_map(ti * G + c, 256, 4, u.pm, u.pn); u.job = br;
        if (GATES_FP8) { u.A = (const char*)P.out + 128 * MiB + (size_t)u.pm * (256 * 1024); u.B = (const char*)(P.ws + (INPROJ_FP8 ? WS_WIN + (size_t)R_GATE * 1024 : WS_WG8)) + (size_t)(br * 1024 + u.pn * 256) * 1024; }
        else { u.A = (const char*)(P.ws + WS_H) + (size_t)u.pm * (256 * 1024 * 2); u.B = (const char*)(P.ws + WS_WIN) + (size_t)(R_GATE + br * 1024 + u.pn * 256) * 2048; }
        return true;
    }
    __device__ __forceinline__ const int* rows(const pg::GUnit&) const { return nullptr; }
    __device__ __forceinline__ void epi(const f32x4 (&acc)[2][2][4][2], const pg::GUnit& u, int wr, int wc, int fr, int fq) const {
        char* OB = sg_base(P, u.job) + ((size_t)u.pm * 256 * 1024 + u.pn * 256) * 2;
        const unsigned loff = (unsigned)((wr * 64 + fr) * 1024 + wc * 32 + 8 * fq) * 2u;
        constexpr float sc = GATES_FP8 ? (1.0f / W8_SCALE) : 1.0f;
#pragma unroll
        for (int ai = 0; ai < 2; ++ai)
#pragma unroll
            for (int m = 0; m < 4; ++m)
#pragma unroll
                for (int bj = 0; bj < 2; ++bj) { const unsigned uo = (unsigned)((ai * 128 + m * 16) * 1024 + bj * 128) * 2u;
                    const f32x4 a = acc[ai][bj][m][0] * (-LOG2E * sc), b = acc[ai][bj][m][1] * (-LOG2E * sc);
#define MG_SIG(v) __builtin_amdgcn_rcpf(1.0f + __builtin_amdgcn_exp2f(v))
                    u32x4 w; w.x = cvt_pk_bf16_c(MG_SIG(a[0]), MG_SIG(a[1])); w.y = cvt_pk_bf16_c(MG_SIG(a[2]), MG_SIG(a[3]));
                    w.z = cvt_pk_bf16_c(MG_SIG(b[0]), MG_SIG(b[1])); w.w = cvt_pk_bf16_c(MG_SIG(b[2]), MG_SIG(b[3]));
#undef MG_SIG
                    *(u32x4*)(OB + uo + loff) = w; }
    }
};
struct JobMergeY {
    Ptrs P; int G, c; int K, lda, ldb; int mode;
    __device__ __forceinline__ bool next(int i, pg::GUnit& u) const {
        int ti, br;
        if (mode == 0) { if (i >= 12) return false; ti = i / 3; br = i - ti * 3; }
        else if (mode == 1) { if (i >= 8) return false; ti = 3 - (i >> 1); br = i & 1; }
        else { if (i >= 4) return false; ti = i; br = 2; }
        pg::xcd_map(ti * G + c, 256, 4, u.pm, u.pn); u.job = br;
        if (mode == 2) { u.A = (const char*)P.out + (size_t)u.pm * (256 * 1024); u.B = (const char*)(P.ws + WS_MVW) + (size_t)(u.pm >> 3) * (1024 * 1024) + (size_t)u.pn * (256 * 1024); return true; }
        if (br == 0) { u.A = (const char*)(P.ws + WS_DAQ) + (size_t)u.pm * (256 * 1024 * 2); u.B = (const char*)(P.ws + WS_WDAO) + (size_t)u.pn * (256 * 1024 * 2); }
        else if (br == 1) { u.A = (const char*)(P.ws + WS_WAQ) + (size_t)u.pm * (256 * 1024 * 2); u.B = (const char*)(P.ws + WS_WWAO) + (size_t)u.pn * (256 * 1024 * 2); }
        else { u.A = (const char*)P.out + (size_t)u.pm * (256 * 1024 * 2); u.B = (const char*)(P.ws + WS_MVW) + (size_t)(u.pm >> 3) * (1024 * 1024 * 2) + (size_t)u.pn * (256 * 1024 * 2); }
        return true;
    }
    __device__ __forceinline__ const int* rows(const pg::GUnit&) const { return nullptr; }
    __device__ __forceinline__ void epi(const f32x4 (&acc)[2][2][4][2], const pg::GUnit& u, int wr, int wc, int fr, int fq) const {
        const size_t tileoff = ((size_t)u.pm * 256 * 1024 + u.pn * 256) * 2;
        const char* SGb = sg_base(P, u.job) + tileoff; char* MGb = (char*)(P.ws + WS_MERGED) + tileoff;
        const unsigned loff = (unsigned)((wr * 64 + fr) * 1024 + wc * 32 + 8 * fq) * 2u;
        const bool hasPrev = u.job != 0;
        const float ysc = (mode == 2) ? 1.0f / (P8_SCALE * MVW8_SCALE) : 1.0f;
#pragma unroll
        for (int ai = 0; ai < 2; ++ai) {
            u32x4 g[4][2], pv[4][2];
#pragma unroll
            for (int m = 0; m < 4; ++m)
#pragma unroll
                for (int bj = 0; bj < 2; ++bj) { const unsigned uo = (unsigned)((ai * 128 + m * 16) * 1024 + bj * 128) * 2u;
                    g[m][bj] = __builtin_nontemporal_load((const u32x4*)(SGb + uo + loff));
                    pv[m][bj] = (u32x4){0u, 0u, 0u, 0u};
                    if (hasPrev) pv[m][bj] = __builtin_nontemporal_load((const u32x4*)(MGb + uo + loff)); }
#pragma unroll
            for (int m = 0; m < 4; ++m)
#pragma unroll
                for (int bj = 0; bj < 2; ++bj) { const unsigned uo = (unsigned)((ai * 128 + m * 16) * 1024 + bj * 128) * 2u;
                    const f32x4 a = acc[ai][bj][m][0] * ysc, b = acc[ai][bj][m][1] * ysc;
                    const u32x4 gq = g[m][bj], pq = pv[m][bj];
                    u32x4 w;
                    w.x = cvt_pk_bf16(bf_lo(pq.x) + bf_lo(gq.x) * a[0], bf_hi(pq.x) + bf_hi(gq.x) * a[1]);
                    w.y = cvt_pk_bf16(bf_lo(pq.y) + bf_lo(gq.y) * a[2], bf_hi(pq.y) + bf_hi(gq.y) * a[3]);
                    w.z = cvt_pk_bf16(bf_lo(pq.z) + bf_lo(gq.z) * b[0], bf_hi(pq.z) + bf_hi(gq.z) * b[1]);
                    w.w = cvt_pk_bf16(bf_lo(pq.w) + bf_lo(gq.w) * b[2], bf_hi(pq.w) + bf_hi(gq.w) * b[3]);
                    *(u32x4*)(MGb + uo + loff) = w; }
            asm volatile("" ::: "memory"); }
    }
};

struct JobOut {
    Ptrs P; int G, c; int K, lda, ldb;
    __device__ __forceinline__ bool next(int i, pg::GUnit& u) const {
        const int L = i * G + c; if (L >= 1024) return false;
        pg::xcd_map(L, 256, 4, u.pm, u.pn); u.job = 0;
        u.A = (const char*)(P.ws + WS_MERGED) + (size_t)u.pm * (256 * 1024 * 2); u.B = (const char*)(P.ws + WS_WOUT) + (size_t)u.pn * (256 * 1024 * 2); return true;
    }
    __device__ __forceinline__ const int* rows(const pg::GUnit&) const { return nullptr; }
    __device__ __forceinline__ void epi(const f32x4 (&acc)[2][2][4][2], const pg::GUnit& u, int wr, int wc, int fr, int fq) const {
        const int row0 = u.pm * 256 + wr * 64 + fr, col0 = u.pn * 256 + wc * 32 + 8 * fq;
#pragma unroll
        for (int ai = 0; ai < 2; ++ai)
#pragma unroll
            for (int m = 0; m < 4; ++m) { const size_t off = (size_t)(row0 + ai * 128 + m * 16) * 1024 + col0;
#pragma unroll
                for (int bj = 0; bj < 2; ++bj) { const f32x4 x0 = *(const f32x4*)(P.x + off + bj * 128), x1 = *(const f32x4*)(P.x + off + bj * 128 + 4);
                    const f32x4 v0 = x0 + acc[ai][bj][m][0], v1 = x1 + acc[ai][bj][m][1];
                    u32x4 w; w.x = cvt_pk_bf16(v0[0], v0[1]); w.y = cvt_pk_bf16(v0[2], v0[3]); w.z = cvt_pk_bf16(v1[0], v1[1]); w.w = cvt_pk_bf16(v1[2], v1[3]);
                    *(u32x4*)(WSP(bf16_t, WS_X1) + off + bj * 128) = w; } }
    }
};
struct JobGU {
    Ptrs P; int G, c; int K, lda, ldb;
    __device__ __forceinline__ bool next(int i, pg::GUnit& u) const {
        const int L = i * G + c; if (L >= 8192) return false;
        pg::xcd_map(L, 512, 16, u.pm, u.pn); u.job = 0;
        u.A = (const char*)(P.ws + WS_H2);
        u.B = (const char*)(P.ws + WS_WGU) + (size_t)(u.pm >> 5) * (4096 * 1024) + (size_t)u.pn * (256 * 1024); return true;
    }
    __device__ __forceinline__ const int* rows(const pg::GUnit& u) const { const int e = u.pm >> 5, b = u.pm & 31; return WSP(const int, WS_IDX) + (b * 16 + e) * 256; }
    __device__ __forceinline__ void epi(const f32x4 (&acc)[2][2][4][2], const pg::GUnit& u, int wr, int wc, int fr, int fq) const {
        char* O = (char*)(P.ws + WS_ACTB) + (size_t)u.pm * 256 * 2048 + u.pn * 128;
        const unsigned loff = (unsigned)((wr * 64 + fr) * 2048 + wc * 32 + 8 * fq);
        constexpr float IS = 1.0f / W8_SCALE, KX = -LOG2E * IS, IC = 1.0f / (IS * IS * ACT8_SCALE);
#pragma unroll
        for (int ai = 0; ai < 2; ++ai)
#pragma unroll
            for (int m = 0; m < 4; ++m) {
                f32x2 o[2][2];
#pragma unroll
                for (int n = 0; n < 2; ++n)
#pragma unroll
                    for (int p = 0; p < 2; ++p) {
                        const f32x2 g = p ? __builtin_shufflevector(acc[ai][0][m][n], acc[ai][0][m][n], 2, 3) : __builtin_shufflevector(acc[ai][0][m][n], acc[ai][0][m][n], 0, 1);
                        const f32x2 up = p ? __builtin_shufflevector(acc[ai][1][m][n], acc[ai][1][m][n], 2, 3) : __builtin_shufflevector(acc[ai][1][m][n], acc[ai][1][m][n], 0, 1);
                        const f32x2 t = g * up, x = g * KX;
                        f32x2 e; e.x = __builtin_amdgcn_exp2f(x.x); e.y = __builtin_amdgcn_exp2f(x.y);
                        const f32x2 d = e * IC + IC;
                        f32x2 r; r.x = __builtin_amdgcn_rcpf(d.x); r.y = __builtin_amdgcn_rcpf(d.y);
                        o[n][p] = t * r; }
                u32x2 w; w.x = pk4_fp8(o[0][0].x, o[0][0].y, o[0][1].x, o[0][1].y); w.y = pk4_fp8(o[1][0].x, o[1][0].y, o[1][1].x, o[1][1].y);
                *(u32x2*)(O + (size_t)(ai * 128 + m * 16) * 2048 + loff) = w; }
    }
};
struct JobDown {
    Ptrs P; int G, c; int K, lda, ldb;
    __device__ __forceinline__ bool next(int i, pg::GUnit& u) const {
        const int L = i * G + c; if (L >= 2048) return false;
        pg::xcd_map(L, 512, 4, u.pm, u.pn); u.pm = 511 - u.pm; u.job = 0;
        u.A = (const char*)(P.ws + WS_ACTB) + (size_t)u.pm * (256 * 2048);
        u.B = (const char*)(P.ws + WS_WD) + (size_t)(u.pm >> 5) * (1024 * 2048) + (size_t)u.pn * (256 * 2048); return true;
    }
    __device__ __forceinline__ const int* rows(const pg::GUnit&) const { return nullptr; }
    __device__ __forceinline__ void epi(const f32x4 (&acc)[2][2][4][2], const pg::GUnit& u, int wr, int wc, int fr, int fq) const {
        char* O = (char*)(P.ws + WS_YE) + (size_t)u.pm * 256 * 1024 + u.pn * 256;
        const unsigned loff = (unsigned)((wr * 64 + fr) * 1024 + wc * 32 + 8 * fq);
        constexpr float sc = YE8_SCALE / (W8_SCALE * ACT8_SCALE);
#pragma unroll
        for (int ai = 0; ai < 2; ++ai)
#pragma unroll
            for (int m = 0; m < 4; ++m)
#pragma unroll
                for (int bj = 0; bj < 2; ++bj) { const f32x4 a = acc[ai][bj][m][0] * sc, b2 = acc[ai][bj][m][1] * sc;
                    u32x2 w; w.x = pk4_fp8(a[0], a[1], a[2], a[3]); w.y = pk4_fp8(b2[0], b2[1], b2[2], b2[3]);
                    *(u32x2*)(O + (size_t)(ai * 128 + m * 16) * 1024 + bj * 128 + loff) = w; }
    }
};

namespace fa {
__device__ __forceinline__ void glds16(const void* g, LAS unsigned char* l) { __builtin_amdgcn_global_load_lds((const unsigned*)g, (LAS unsigned*)l, 16, 0, 0); }
__device__ __forceinline__ void glds16_s(const char* sbase, unsigned voff, unsigned ldsaddr) { unsigned keep;
    asm volatile("s_mov_b32 %0, m0\n\ts_mov_b32 m0, %3\n\ts_nop 0\n\tglobal_load_lds_dwordx4 %1, %2\n\ts_mov_b32 m0, %0" : "=&s"(keep) : "v"(voff), "s"(sbase), "s"(ldsaddr) : "memory"); }
__device__ __forceinline__ float max3f(float a, float b, float c) { float r; asm volatile("v_max3_f32 %0, %1, %2, %3" : "=v"(r) : "v"(a), "v"(b), "v"(c)); return r; }
#define FA_ROWMAX(_m, Y0, Y1) do { \
        float _g0 = __builtin_amdgcn_fmed3f(Y0[0], Y0[1], Y0[2]); asm volatile("" : "+v"(_g0)); \
        float _g1 = __builtin_amdgcn_fmed3f(Y1[0], Y1[1], Y1[2]); asm volatile("" : "+v"(_g1)); \
        _m = max3f(Y0[0], Y0[1], Y0[2]); float _m2 = max3f(Y1[0], Y1[1], Y1[2]); \
        _Pragma("unroll") for (int _r = 3; _r < 15; _r += 2) { _m = max3f(_m, Y0[_r], Y0[_r + 1]); _m2 = max3f(_m2, Y1[_r], Y1[_r + 1]); } \
        _m = max3f(_m, Y0[15], Y1[15]); _m = max3f(_m, _m2, _m2); { float _o = __shfl_xor(_m, 32); _m = max3f(_m, _o, _o); } } while (0)
constexpr float THR = 16.0f;
#define FA_SB() __builtin_amdgcn_sched_barrier(0)

template <int MODE>
__device__ __forceinline__ void flash_unit(LAS unsigned char* lds, const Ptrs& P, int b, int hd, int qblk, float lam) {
    constexpr bool DA = (MODE == 0);
    constexpr int NDB = DA ? 4 : 2;
    constexpr int NPV = 4 * NDB;
    constexpr int STG = DA ? 32768 : 16384, VOFF = DA ? 16384 : 8192;
    const int tid = threadIdx.x, lane = tid & 63, r32 = lane & 31, hi = lane >> 5, w = __builtin_amdgcn_readfirstlane(tid >> 6);
    int q0, qw, NT, tlo, ts, thi; bool notrack = false;
    const bf16_t *Qp, *Kp, *Vp; bf16_t* Op; int kld; float slope2;
    if constexpr (DA) {
        q0 = qblk * 128; const int map = w >> 2; qw = q0 + (w & 3) * 32;
        Qp = WSP(const bf16_t, WS_DAQ) + (size_t)(b * SEQ) * 1024 + hd * 128 + map * 64;
        Kp = WSP(const bf16_t, WS_DAK) + (size_t)(b * SEQ) * 1024 + hd * 128;
        Vp = WSP(const bf16_t, WS_DAVT) + (size_t)(hd * 128) * MTOK + (size_t)b * SEQ;
        Op = WSP(bf16_t, WS_DAQ) + (size_t)(b * SEQ) * 1024 + hd * 128;
        kld = 1024; NT = 32; tlo = 0; thi = 31; ts = q0 >> 6;
        slope2 = LOG2E * __builtin_amdgcn_exp2f(-(float)(hd + 1));
    } else {
        q0 = qblk * 256; qw = q0 + w * 32; const int kvh = hd >> 2;
        Qp = WSP(const bf16_t, WS_WAQ) + (size_t)(b * SEQ) * 1024 + hd * 64;
        Kp = WSP(const bf16_t, WS_WAK) + (size_t)(b * SEQ) * 256 + kvh * 64;
        Vp = WSP(const bf16_t, WS_WAVT) + (size_t)(kvh * 64) * MTOK + (size_t)b * SEQ;
        Op = WSP(bf16_t, WS_WAQ) + (size_t)(b * SEQ) * 1024 + hd * 64;
        kld = 256; tlo = 4 * qblk - 2; if (tlo < 0) tlo = 0; thi = 4 * qblk + 5; if (thi > 31) thi = 31; ts = 4 * qblk; NT = thi - tlo + 1;
        slope2 = LOG2E * __builtin_amdgcn_exp2f(-0.5f * (float)(hd + 1));
    }
    const int Rk = w * 8 + (lane >> 3), slot = lane & 7;
    const bf16_t* srcK0 = Kp + (size_t)Rk * kld + ((slot ^ ((Rk >> 1) & 7)) * 8);
    const bf16_t* srcV0 = Vp + (size_t)Rk * MTOK + ((slot ^ ((Rk >> 1) & 7)) * 8);
    const bf16_t* srcV1 = Vp + (size_t)(Rk + 64) * MTOK + ((slot ^ (((Rk + 64) >> 1) & 7)) * 8);
    const unsigned koffb = (unsigned)(Rk * kld + ((slot ^ ((Rk >> 1) & 7)) * 8)) * 2u;
    const unsigned voffb0 = (unsigned)(Rk * MTOK + ((slot ^ ((Rk >> 1) & 7)) * 8)) * 2u, voffb1 = (unsigned)((Rk + 64) * MTOK + ((slot ^ (((Rk + 64) >> 1) & 7)) * 8)) * 2u;
    const unsigned ldsw0 = (unsigned)__builtin_amdgcn_readfirstlane((int)((unsigned)(uintptr_t)lds + (unsigned)w * 1024u));
#define FA_DMAK(t, stg) do { LAS unsigned char* _s = lds + (stg) * STG; \
        if constexpr (DA) { const char* _kb = (const char*)Kp + (size_t)(t) * (64 * 1024 * 2); const unsigned _la = ldsw0 + (unsigned)((stg) * STG); \
            glds16_s(_kb, koffb, _la); glds16_s(_kb, koffb + 128u, _la + 8192u); } \
        else { glds16(srcK0 + (size_t)(t) * 64 * 256, _s + w * 1024); } } while (0)
#define FA_DMAV(t, stg) do { LAS unsigned char* _s = lds + (stg) * STG; \
        if constexpr (DA) { const char* _vb = (const char*)Vp + (size_t)(t) * 128; const unsigned _la = ldsw0 + (unsigned)((stg) * STG + VOFF); \
            glds16_s(_vb, voffb0, _la); glds16_s(_vb, voffb1, _la + 8192u); } \
        else { glds16(srcV0 + (t) * 64, _s + VOFF + w * 1024); } } while (0)
#define FA_TILE(i) ((ts + (i) <= thi) ? ts + (i) : tlo + ((i) - (thi - ts + 1)))
    FA_DMAK(FA_TILE(0), 0);
    bf16x8 qf[4];
    { const bf16_t* qp = Qp + (size_t)(qw + r32) * 1024 + hi * 8;
#pragma unroll
      for (int d = 0; d < 4; ++d) qf[d] = *(const bf16x8*)(qp + d * 16); }
    if constexpr (DA) {
        float qs = 0.f;
#pragma unroll
        for (int d = 0; d < 4; ++d)
#pragma unroll
            for (int jj = 0; jj < 8; ++jj) { const float x = __uint_as_float(((unsigned)(unsigned short)qf[d][jj]) << 16); qs += x * x; }
        qs += __shfl_xor(qs, 32);
#pragma unroll
        for (int off = 1; off < 32; off <<= 1) qs = fmaxf(qs, __shfl_xor(qs, off));
        volatile LAS float* qsc = (volatile LAS float*)(lds + MISC_OFF + 64);
        if (lane == 0) qsc[w] = qs;
        LDS_WAIT(); __builtin_amdgcn_s_barrier(); asm volatile("" ::: "memory");
        float qn2 = qsc[0];
#pragma unroll
        for (int i = 1; i < 8; ++i) qn2 = fmaxf(qn2, qsc[i]);
        const float kn2 = __uint_as_float(WSP(const unsigned, WS_KMAX)[b * 8 + hd]);
        const float qk = sqrtf(qn2 * kn2);
        notrack = __builtin_amdgcn_readfirstlane((int)(qk < 100.0f)) != 0;
        float wf = (46.0f + 2.0f * qk) / slope2; wf = fminf(wf, 4096.0f);
        const int W = __builtin_amdgcn_readfirstlane((int)wf + 1);
        tlo = (q0 - W) < 0 ? 0 : ((q0 - W) >> 6); thi = (q0 + 127 + W) >> 6; if (thi > 31) thi = 31;
        if (((thi - tlo) & 1) == 0) { if (thi < 31) ++thi; else --tlo; }
        NT = thi - tlo + 1;
    }
    const int krow = (r32 & 0x13) | ((r32 & 4) << 1) | ((r32 & 8) >> 1), ksw = (krow >> 1) & 7, vsw = (r32 >> 1) & 7;
    const LAS unsigned char* kp[4]; const LAS unsigned char* vp[4];
#pragma unroll
    for (int d = 0; d < 4; ++d) kp[d] = lds + (DA ? (w >> 2) * 8192 : 0) + krow * 128 + (((2 * d + hi) ^ ksw) * 16);
#pragma unroll
    for (int ks = 0; ks < 4; ++ks) vp[ks] = lds + r32 * 128 + (((4 * (ks >> 1) + 2 * (ks & 1) + hi) ^ vsw) * 16);
    f32x16 o[NDB];
#pragma unroll
    for (int d = 0; d < NDB; ++d) o[d] = (f32x16){0.f, 0.f, 0.f, 0.f, 0.f, 0.f, 0.f, 0.f, 0.f, 0.f, 0.f, 0.f, 0.f, 0.f, 0.f, 0.f};
    f32x16 A0, A1, B0, B1;
    B0 = o[0]; B1 = o[0];
    float mref = 0.f, negm = 0.f, l = 0.f, fsave = 1.f; bool resc = false;
    const int qpos = qw + r32; const float nslope = -slope2;
    u32x4 pk[4]; bf16x8 kf[4], vf[8];
#define FA_EL(X0, X1, e) (((e) < 16) ? X0[(e) & 15] : X1[(e) & 15])
#define FA_SETEL(X0, X1, e, v) do { if ((e) < 16) X0[(e) & 15] = (v); else X1[(e) & 15] = (v); } while (0)
#define FA_NOFF(e) (32 * ((e) >> 4) + 16 * (((e) & 15) >> 3) + ((e) & 7))
#define FA_BIAS1(X0, X1, e) do { const float _x = t0n - (float)FA_NOFF(e); float _c = __builtin_fmaf(nslope, __builtin_fabsf(_x), negm); \
        if constexpr (!DA) _c = (__builtin_fabsf(_x) > 128.0f) ? -1.0e30f : _c; asm volatile("" : "+v"(_c)); FA_SETEL(X0, X1, e, _c); } while (0)
#define FA_BIASC(X0, X1, e) do { float _c = __builtin_fmaf(bd1, (float)FA_NOFF(e), bbase); asm volatile("" : "+v"(_c)); FA_SETEL(X0, X1, e, _c); } while (0)
#define FA_T0(dst, t) do { float _t = (float)(qpos - 64 * (t) - 8 * hi); asm volatile("" : "+v"(_t)); dst = _t; } while (0)
#define FA_STEP(Y0, Y1, X0, X1, KS, VB, T, TN, HASN, TRK, PV, CH) do { \
        if (HASN) FA_DMAK(TN, (KS) ^ 1); \
        FA_DMAV(T, KS); \
        _Pragma("unroll") for (int _j = 0; _j < 4; ++_j) kf[_j] = *(const LAS bf16x8*)(kp[_j >> 1] + (KS) * STG + (_j & 1) * 4096); \
        if (PV) { _Pragma("unroll") for (int _f = 0; _f < 8; ++_f) vf[_f] = *(const LAS bf16x8*)(vp[DA ? (_f >> 2) : (_f >> 1)] + (VB) + (DA ? (_f & 3) : (_f & 1)) * 4096); } \
        float t0n; FA_T0(t0n, TN); \
        float sacc = 0.f; FA_SB(); \
        _Pragma("unroll") for (int _j = 0; _j < 8; ++_j) { \
            if (_j & 1) Y1 = __builtin_amdgcn_mfma_f32_32x32x16_bf16(kf[_j & 3], qf[_j >> 1], Y1, 0, 0, 0); \
            else        Y0 = __builtin_amdgcn_mfma_f32_32x32x16_bf16(kf[_j & 3], qf[_j >> 1], Y0, 0, 0, 0); \
            if (_j < 4) kf[_j] = *(const LAS bf16x8*)(kp[(_j + 4) >> 1] + (KS) * STG + (_j & 1) * 4096); \
            { const float _a = FA_EL(X0, X1, 4 * _j), _b = FA_EL(X0, X1, 4 * _j + 1), _c = FA_EL(X0, X1, 4 * _j + 2), _d = FA_EL(X0, X1, 4 * _j + 3); \
              sacc += (_a + _b) + (_c + _d); asm volatile("" : "+v"(sacc)); pk[_j >> 1][2 * (_j & 1)] = cvt_pk_bf16(_a, _b); pk[_j >> 1][2 * (_j & 1) + 1] = cvt_pk_bf16(_c, _d); } \
            FA_SB(); } \
        l += sacc; \
        if (TRK) { float _m; FA_ROWMAX(_m, Y0, Y1); resc = false; \
          if (__builtin_expect(__any(_m > THR), 0)) { const float _dl = fmaxf(_m, 0.f); mref += _dl; negm = -mref; fsave = __builtin_amdgcn_exp2f(-_dl); l *= fsave; resc = true; \
              _Pragma("unroll") for (int _r = 0; _r < 16; ++_r) { Y0[_r] -= _dl; Y1[_r] -= _dl; } } } \
        float bbase = 0.f, bd1 = 0.f; if (CH) { const float _sn = ((TN) > ts) ? -nslope : nslope; bbase = __builtin_fmaf(_sn, t0n, negm); bd1 = -_sn; } \
        FA_SB(); \
        _Pragma("unroll") for (int _i = 0; _i < NPV; ++_i) { \
            if (PV) { o[DA ? (_i & 3) : (_i & 1)] = __builtin_amdgcn_mfma_f32_32x32x16_bf16(vf[_i & 7], __builtin_bit_cast(bf16x8, pk[DA ? (_i >> 2) : (_i >> 1)]), o[DA ? (_i & 3) : (_i & 1)], 0, 0, 0); \
              if (DA && _i < 8) vf[_i] = *(const LAS bf16x8*)(vp[(_i + 8) >> 2] + (VB) + ((_i + 8) & 3) * 4096); } \
            _Pragma("unroll") for (int _e = 0; _e < 32 / NPV; ++_e) { const int _q = (32 / NPV) * _i + _e; \
                { float _ev = __builtin_amdgcn_exp2f(FA_EL(Y0, Y1, _q)); asm volatile("" : "+v"(_ev)); FA_SETEL(Y0, Y1, _q, _ev); } if (CH) FA_BIASC(X0, X1, _q); else FA_BIAS1(X0, X1, _q); } \
            FA_SB(); } \
        asm volatile("s_waitcnt vmcnt(0) lgkmcnt(0)" ::: "memory"); __builtin_amdgcn_s_barrier(); asm volatile("" ::: "memory"); \
        if (TRK && __builtin_expect(resc, 0)) { _Pragma("unroll") for (int _d = 0; _d < NDB; ++_d) _Pragma("unroll") for (int _r = 0; _r < 16; ++_r) o[_d][_r] *= fsave; } \
    } while (0)
    { float t0n; FA_T0(t0n, FA_TILE(0));
#pragma unroll
      for (int e = 0; e < 32; ++e) FA_BIAS1(A0, A1, e); }
    asm volatile("s_waitcnt vmcnt(0)" ::: "memory"); __builtin_amdgcn_s_barrier(); asm volatile("" ::: "memory");
    const bool trk = !(DA && notrack);
    { const int t0_ = FA_TILE(0), t1_ = FA_TILE(1), t2_ = FA_TILE(2);
      FA_STEP(A0, A1, B0, B1, 0, 0, t0_, t1_, true, trk, false, false);
      FA_STEP(B0, B1, A0, A1, 1, VOFF, t1_, t2_, true, trk, true, DA); }
    for (int i = 2; i < NT; i += 2) {
        const int ta = FA_TILE(i), tb = FA_TILE(i + 1), tc = (i + 2 < NT) ? FA_TILE(i + 2) : FA_TILE(i + 1);
        FA_STEP(A0, A1, B0, B1, 0, STG + VOFF, ta, tb, true, trk, true, DA);
        FA_STEP(B0, B1, A0, A1, 1, VOFF, tb, tc, (i + 2 < NT), trk, true, DA); }
    { float sacc = 0.f;
#pragma unroll
      for (int j = 0; j < 8; ++j) { const float a_ = FA_EL(B0, B1, 4 * j), b_ = FA_EL(B0, B1, 4 * j + 1), c_ = FA_EL(B0, B1, 4 * j + 2), d_ = FA_EL(B0, B1, 4 * j + 3);
          sacc += (a_ + b_) + (c_ + d_); pk[j >> 1][2 * (j & 1)] = cvt_pk_bf16(a_, b_); pk[j >> 1][2 * (j & 1) + 1] = cvt_pk_bf16(c_, d_); }
      l += sacc;
#pragma unroll
      for (int i = 0; i < NPV; ++i) { const int ks = DA ? (i >> 2) : (i >> 1), d = DA ? (i & 3) : (i & 1);
          const bf16x8 v = *(const LAS bf16x8*)(vp[ks] + STG + VOFF + d * 4096);
          o[d] = __builtin_amdgcn_mfma_f32_32x32x16_bf16(v, __builtin_bit_cast(bf16x8, pk[ks]), o[d], 0, 0, 0); } }
    LDS_WAIT(); __builtin_amdgcn_s_barrier(); asm volatile("" ::: "memory");
    l += __shfl_xor(l, 32);
    if constexpr (DA) {
        const float il = 1.0f / l;
        LAS float* ex = (LAS float*)lds + (w & 3) * 4096;
        if (w >= 4) {
#pragma unroll
            for (int d = 0; d < 4; ++d)
#pragma unroll
                for (int r = 0; r < 16; ++r) ex[(d * 16 + r) * 64 + lane] = o[d][r] * il;
        }
        LDS_WAIT(); __builtin_amdgcn_s_barrier(); asm volatile("" ::: "memory");
        if (w < 4) {
            float ss = 0.f;
#pragma unroll
            for (int d = 0; d < 4; ++d)
#pragma unroll
                for (int r = 0; r < 16; ++r) { const float v = o[d][r] * il - lam * ex[(d * 16 + r) * 64 + lane]; o[d][r] = v; ss += v * v; }
            ss += __shfl_xor(ss, 32);
            const float rs = (1.0f - LAM_INIT) * __builtin_amdgcn_rsqf(ss * (1.0f / 128.0f) + EPS);
            bf16_t* op = Op + (size_t)(qw + r32) * 1024;
#pragma unroll
            for (int d = 0; d < 4; ++d)
#pragma unroll
                for (int gp = 0; gp < 2; ++gp) { u32x2 pw[2];
#pragma unroll
                    for (int gg = 0; gg < 2; ++gg) { const int g = 2 * gp + gg, dd = d * 32 + 8 * g + 4 * hi; const f32x4 sg = *(const f32x4*)(P.subln_g + dd);
                        pw[gg].x = cvt_pk_bf16(o[d][4 * g] * rs * sg[0], o[d][4 * g + 1] * rs * sg[1]); pw[gg].y = cvt_pk_bf16(o[d][4 * g + 2] * rs * sg[2], o[d][4 * g + 3] * rs * sg[3]); }
                    const unsigned sx = hi ? pw[0].x : pw[1].x, sy = hi ? pw[0].y : pw[1].y;
                    const unsigned rx = (unsigned)__shfl_xor((int)sx, 32), ry = (unsigned)__shfl_xor((int)sy, 32);
                    u32x4 wv; if (hi) { wv.x = rx; wv.y = ry; wv.z = pw[1].x; wv.w = pw[1].y; } else { wv.x = pw[0].x; wv.y = pw[0].y; wv.z = rx; wv.w = ry; }
                    *(u32x4*)(op + d * 32 + 16 * gp + 8 * hi) = wv; }
        }
    } else {
        const float sink2 = P.wa_sink[hd] * LOG2E;
        const float lt = l + __builtin_amdgcn_exp2f(sink2 - mref);
        const float il = 1.0f / lt;
        bf16_t* op = Op + (size_t)(qw + r32) * 1024;
#pragma unroll
        for (int d = 0; d < 2; ++d)
#pragma unroll
            for (int g = 0; g < 4; ++g) { const int dd = d * 32 + 8 * g + 4 * hi;
                u32x2 wv; wv.x = cvt_pk_bf16(o[d][4 * g] * il, o[d][4 * g + 1] * il); wv.y = cvt_pk_bf16(o[d][4 * g + 2] * il, o[d][4 * g + 3] * il);
                *(u32x2*)(op + dd) = wv; }
    }
    asm volatile("s_waitcnt vmcnt(0) lgkmcnt(0)" ::: "memory"); __builtin_amdgcn_s_barrier(); asm volatile("" ::: "memory");
#undef FA_DMAK
#undef FA_DMAV
#undef FA_TILE
#undef FA_EL
#undef FA_SETEL
#undef FA_NOFF
#undef FA_BIAS1
#undef FA_BIASC
#undef FA_T0
#undef FA_STEP
}
#undef FA_SB
__device__ __forceinline__ void wa_group(LAS unsigned char* lds, const Ptrs& P, int b, int kvh, int qblk) {
    constexpr int NDB = 2, NPV = 8, TSZ = 16384, VOFF = 8192;
    const int tid = threadIdx.x, lane = tid & 63, r32 = lane & 31, hi = lane >> 5, w = __builtin_amdgcn_readfirstlane(tid >> 6);
    const int q0 = qblk * 256, qw = q0 + w * 32;
    int tlo = 4 * qblk - 2; if (tlo < 0) tlo = 0; int thi = 4 * qblk + 5; if (thi > 31) thi = 31; const int NTW = thi - tlo + 1;
    { const bf16_t* Kp = WSP(const bf16_t, WS_WAK) + (size_t)(b * SEQ) * 256 + kvh * 64;
      const bf16_t* Vp = WSP(const bf16_t, WS_WAVT) + (size_t)(kvh * 64) * MTOK + (size_t)b * SEQ;
      const int Rk = w * 8 + (lane >> 3), slot = lane & 7;
      const bf16_t* srcK0 = Kp + (size_t)Rk * 256 + ((slot ^ ((Rk >> 1) & 7)) * 8);
      const bf16_t* srcV0 = Vp + (size_t)Rk * MTOK + ((slot ^ ((Rk >> 1) & 7)) * 8);
      for (int j = 0; j < NTW; ++j) { const int t = tlo + j; glds16(srcK0 + (size_t)t * 64 * 256, lds + j * TSZ + w * 1024); glds16(srcV0 + t * 64, lds + j * TSZ + VOFF + w * 1024); } }
    int tw0 = (qw - 128) >> 6; const int tw0r = tw0; if (tw0 > thi - 4) tw0 = thi - 4; if (tw0 < tlo) tw0 = tlo;
    const bool regular = __builtin_amdgcn_readfirstlane((int)(tw0 == tw0r)) != 0;
    const int krow = (r32 & 0x13) | ((r32 & 4) << 1) | ((r32 & 8) >> 1), ksw = (krow >> 1) & 7, vsw = (r32 >> 1) & 7;
    const LAS unsigned char* kp[4]; const LAS unsigned char* vp[4];
#pragma unroll
    for (int d = 0; d < 4; ++d) kp[d] = lds + krow * 128 + (((2 * d + hi) ^ ksw) * 16);
#pragma unroll
    for (int ks = 0; ks < 4; ++ks) vp[ks] = lds + r32 * 128 + (((4 * (ks >> 1) + 2 * (ks & 1) + hi) ^ vsw) * 16);
    const int qpos = qw + r32;
    asm volatile("s_waitcnt vmcnt(0)" ::: "memory"); __builtin_amdgcn_s_barrier(); asm volatile("" ::: "memory");
    float kmx;
    { float kn2 = 0.f;
      if (w < NTW) { const LAS unsigned char* kr = lds + w * TSZ + lane * 128;
#pragma unroll
          for (int c = 0; c < 8; ++c) { const bf16x8 v = *(const LAS bf16x8*)(kr + c * 16);
#pragma unroll
              for (int jj = 0; jj < 8; ++jj) { const float x = __uint_as_float(((unsigned)(unsigned short)v[jj]) << 16); kn2 += x * x; } } }
#pragma unroll
      for (int off = 1; off < 64; off <<= 1) kn2 = fmaxf(kn2, __shfl_xor(kn2, off));
      volatile LAS float* ksc = (volatile LAS float*)(lds + MISC_OFF + 64);
      if (lane == 0) ksc[w] = kn2;
      LDS_WAIT(); __builtin_amdgcn_s_barrier(); asm volatile("" ::: "memory");
      kmx = ksc[0];
#pragma unroll
      for (int i = 1; i < 8; ++i) kmx = fmaxf(kmx, ksc[i]); }
#define FA_SB() __builtin_amdgcn_sched_barrier(0)
#define FA_EL(X0, X1, e) (((e) < 16) ? X0[(e) & 15] : X1[(e) & 15])
#define FA_SETEL(X0, X1, e, v) do { if ((e) < 16) X0[(e) & 15] = (v); else X1[(e) & 15] = (v); } while (0)
#define FA_NOFF(e) (32 * ((e) >> 4) + 16 * (((e) & 15) >> 3) + ((e) & 7))
#define FA_BIAS1(X0, X1, e) do { const float _x = t0n - (float)FA_NOFF(e); float _c = __builtin_fmaf(nslope, __builtin_fabsf(_x), negm); \
        _c = (__builtin_fabsf(_x) > 128.0f) ? -1.0e30f : _c; asm volatile("" : "+v"(_c)); FA_SETEL(X0, X1, e, _c); } while (0)
#define FW_BIAS(BM, SG, X0, X1, e) do { if ((BM) != 4) { float _c; \
        if ((BM) == 0 || (BM) == 2) { const float _x = t0n - (float)FA_NOFF(e); _c = __builtin_fmaf(nslope, __builtin_fabsf(_x), negm); \
            if ((BM) == 0) _c = (__builtin_fabsf(_x) > 128.0f) ? -1.0e30f : _c; } \
        else { _c = __builtin_fmaf(bd1, (float)FA_NOFF(e), bbase); \
            if ((BM) == 3) _c = (((SG) > 0) ? ((float)FA_NOFF(e) < blim) : ((float)FA_NOFF(e) > blim)) ? -1.0e30f : _c; } \
        asm volatile("" : "+v"(_c)); FA_SETEL(X0, X1, e, _c); } } while (0)
#define FA_T0(dst, t) do { float _t = (float)(qpos - 64 * (t) - 8 * hi); asm volatile("" : "+v"(_t)); dst = _t; } while (0)
#define FW_STEP(Y0, Y1, X0, X1, KOFF, VBOFF, TN, PV, BM, SG) do { \
        const LAS unsigned char* kq[4]; const LAS unsigned char* vq[4]; \
        _Pragma("unroll") for (int _d = 0; _d < 4; ++_d) { kq[_d] = kp[_d] + (KOFF); vq[_d] = vp[_d] + (VBOFF); } \
        _Pragma("unroll") for (int _j = 0; _j < 4; ++_j) kf[_j] = *(const LAS bf16x8*)(kq[_j >> 1] + (_j & 1) * 4096); \
        if (PV) { _Pragma("unroll") for (int _f = 0; _f < 8; ++_f) vf[_f] = *(const LAS bf16x8*)(vq[_f >> 1] + (_f & 1) * 4096); } \
        float t0n; FA_T0(t0n, TN); \
        float sacc = 0.f; FA_SB(); \
        _Pragma("unroll") for (int _j = 0; _j < 8; ++_j) { \
            if (_j & 1) Y1 = __builtin_amdgcn_mfma_f32_32x32x16_bf16(kf[_j & 3], qf[_j >> 1], Y1, 0, 0, 0); \
            else        Y0 = __builtin_amdgcn_mfma_f32_32x32x16_bf16(kf[_j & 3], qf[_j >> 1], Y0, 0, 0, 0); \
            if (_j < 4) kf[_j] = *(const LAS bf16x8*)(kq[(_j + 4) >> 1] + (_j & 1) * 4096); \
            { const float _a = FA_EL(X0, X1, 4 * _j), _b = FA_EL(X0, X1, 4 * _j + 1), _c = FA_EL(X0, X1, 4 * _j + 2), _d = FA_EL(X0, X1, 4 * _j + 3); \
              sacc += (_a + _b) + (_c + _d); asm volatile("" : "+v"(sacc)); pk[_j >> 1][2 * (_j & 1)] = cvt_pk_bf16(_a, _b); pk[_j >> 1][2 * (_j & 1) + 1] = cvt_pk_bf16(_c, _d); } \
            FA_SB(); } \
        l += sacc; \
        if (trk) { float _m; FA_ROWMAX(_m, Y0, Y1); resc = false; \
          if (__builtin_expect(__any(_m > THR), 0)) { const float _dl = fmaxf(_m, 0.f); mref += _dl; negm = -mref; fsave = __builtin_amdgcn_exp2f(-_dl); l *= fsave; resc = true; \
              _Pragma("unroll") for (int _r = 0; _r < 16; ++_r) { Y0[_r] -= _dl; Y1[_r] -= _dl; } } } \
        float bbase = 0.f, bd1 = 0.f, blim = 0.f; if ((BM) == 1 || (BM) == 3) { const float _sn = ((SG) > 0) ? nslope : -nslope; bbase = __builtin_fmaf(_sn, t0n, negm); bd1 = -_sn; blim = ((SG) > 0) ? t0n - 128.0f : t0n + 128.0f; } \
        FA_SB(); \
        _Pragma("unroll") for (int _i = 0; _i < NPV; ++_i) { \
            if (PV) o[_i & 1] = __builtin_amdgcn_mfma_f32_32x32x16_bf16(vf[_i], __builtin_bit_cast(bf16x8, pk[_i >> 1]), o[_i & 1], 0, 0, 0); \
            _Pragma("unroll") for (int _e = 0; _e < 4; ++_e) { const int _q = 4 * _i + _e; \
                { float _ev = __builtin_amdgcn_exp2f(FA_EL(Y0, Y1, _q)); asm volatile("" : "+v"(_ev)); FA_SETEL(Y0, Y1, _q, _ev); } FW_BIAS(BM, SG, X0, X1, _q); } \
            FA_SB(); } \
        if (trk && __builtin_expect(resc, 0)) { _Pragma("unroll") for (int _d = 0; _d < NDB; ++_d) _Pragma("unroll") for (int _r = 0; _r < 16; ++_r) o[_d][_r] *= fsave; } \
    } while (0)
    for (int hq = 0; hq < 4; ++hq) {
        const int hd = kvh * 4 + hq;
        const float slope2 = LOG2E * __builtin_amdgcn_exp2f(-0.5f * (float)(hd + 1)), nslope = -slope2;
        bf16x8 qf[4];
        { const bf16_t* qp = WSP(const bf16_t, WS_WAQ) + (size_t)(b * SEQ + qw + r32) * 1024 + hd * 64 + hi * 8;
#pragma unroll
          for (int d = 0; d < 4; ++d) qf[d] = *(const bf16x8*)(qp + d * 16); }
        bool trk;
        { float qs = 0.f;
#pragma unroll
          for (int d = 0; d < 4; ++d)
#pragma unroll
              for (int jj = 0; jj < 8; ++jj) { const float x = __uint_as_float(((unsigned)(unsigned short)qf[d][jj]) << 16); qs += x * x; }
          qs += __shfl_xor(qs, 32);
#pragma unroll
          for (int off = 1; off < 32; off <<= 1) qs = fmaxf(qs, __shfl_xor(qs, off));
          trk = __builtin_amdgcn_readfirstlane((int)(sqrtf(qs * kmx) < 100.0f)) == 0; }
        f32x16 o[NDB];
#pragma unroll
        for (int d = 0; d < NDB; ++d) o[d] = (f32x16){0.f, 0.f, 0.f, 0.f, 0.f, 0.f, 0.f, 0.f, 0.f, 0.f, 0.f, 0.f, 0.f, 0.f, 0.f, 0.f};
        f32x16 A0, A1, B0, B1; B0 = o[0]; B1 = o[0];
        float mref = 0.f, negm = 0.f, l = 0.f, fsave = 1.f; bool resc = false;
        u32x4 pk[4]; bf16x8 kf[4], vf[8];
        const int kb0 = (tw0 - tlo) * TSZ;
        if (regular) {
            { float t0n; FA_T0(t0n, tw0); const float bbase = __builtin_fmaf(nslope, t0n, negm), bd1 = -nslope, blim = t0n - 128.0f;
#pragma unroll
              for (int e = 0; e < 32; ++e) FW_BIAS(3, 1, A0, A1, e); }
            FW_STEP(A0, A1, B0, B1, kb0, kb0, tw0 + 1, false, 1, 1);
            FW_STEP(B0, B1, A0, A1, kb0 + TSZ, kb0 + VOFF, tw0 + 2, true, 2, 0);
            FW_STEP(A0, A1, B0, B1, kb0 + 2 * TSZ, kb0 + TSZ + VOFF, tw0 + 3, true, 1, -1);
            FW_STEP(B0, B1, A0, A1, kb0 + 3 * TSZ, kb0 + 2 * TSZ + VOFF, tw0 + 4, true, 3, -1);
            FW_STEP(A0, A1, B0, B1, kb0 + 4 * TSZ, kb0 + 3 * TSZ + VOFF, tw0 + 4, true, 4, 0);
        } else {
            { float t0n; FA_T0(t0n, tw0); const float bbase = 0.f, bd1 = 0.f, blim = 0.f;
#pragma unroll
              for (int e = 0; e < 32; ++e) FW_BIAS(0, 0, A0, A1, e); }
            FW_STEP(A0, A1, B0, B1, kb0, kb0, tw0 + 1, false, 0, 0);
            FW_STEP(B0, B1, A0, A1, kb0 + TSZ, kb0 + VOFF, tw0 + 2, true, 0, 0);
            FW_STEP(A0, A1, B0, B1, kb0 + 2 * TSZ, kb0 + TSZ + VOFF, tw0 + 3, true, 0, 0);
            FW_STEP(B0, B1, A0, A1, kb0 + 3 * TSZ, kb0 + 2 * TSZ + VOFF, tw0 + 4, true, 0, 0);
            FW_STEP(A0, A1, B0, B1, kb0 + 4 * TSZ, kb0 + 3 * TSZ + VOFF, tw0 + 4, true, 4, 0);
        }
        { float sacc = 0.f;
#pragma unroll
          for (int j = 0; j < 8; ++j) { const float a_ = FA_EL(A0, A1, 4 * j), b_ = FA_EL(A0, A1, 4 * j + 1), c_ = FA_EL(A0, A1, 4 * j + 2), d_ = FA_EL(A0, A1, 4 * j + 3);
              sacc += (a_ + b_) + (c_ + d_); pk[j >> 1][2 * (j & 1)] = cvt_pk_bf16(a_, b_); pk[j >> 1][2 * (j & 1) + 1] = cvt_pk_bf16(c_, d_); }
          l += sacc;
#pragma unroll
          for (int i = 0; i < NPV; ++i) { const int ks = i >> 1, d = i & 1;
              const bf16x8 v = *(const LAS bf16x8*)(vp[ks] + kb0 + 4 * TSZ + VOFF + d * 4096);
              o[d] = __builtin_amdgcn_mfma_f32_32x32x16_bf16(v, __builtin_bit_cast(bf16x8, pk[ks]), o[d], 0, 0, 0); } }
        l += __shfl_xor(l, 32);
        { const float sink2 = P.wa_sink[hd] * LOG2E;
          const float il = 1.0f / (l + __builtin_amdgcn_exp2f(sink2 - mref));
          bf16_t* op = WSP(bf16_t, WS_WAQ) + (size_t)(b * SEQ + qw + r32) * 1024 + hd * 64;
#pragma unroll
          for (int d = 0; d < 2; ++d)
#pragma unroll
              for (int gp = 0; gp < 2; ++gp) { u32x2 pw[2];
#pragma unroll
                  for (int gg = 0; gg < 2; ++gg) { const int g = 2 * gp + gg; pw[gg].x = cvt_pk_bf16(o[d][4 * g] * il, o[d][4 * g + 1] * il); pw[gg].y = cvt_pk_bf16(o[d][4 * g + 2] * il, o[d][4 * g + 3] * il); }
                  const unsigned sx = hi ? pw[0].x : pw[1].x, sy = hi ? pw[0].y : pw[1].y;
                  const unsigned rx = (unsigned)__shfl_xor((int)sx, 32), ry = (unsigned)__shfl_xor((int)sy, 32);
                  u32x4 wv; if (hi) { wv.x = rx; wv.y = ry; wv.z = pw[1].x; wv.w = pw[1].y; } else { wv.x = pw[0].x; wv.y = pw[0].y; wv.z = rx; wv.w = ry; }
                  *(u32x4*)(op + d * 32 + 16 * gp + 8 * hi) = wv; } }
    }
    asm volatile("s_waitcnt vmcnt(0) lgkmcnt(0)" ::: "memory"); __builtin_amdgcn_s_barrier(); asm volatile("" ::: "memory");
#undef FW_STEP
#undef FW_BIAS
#undef FA_EL
#undef FA_SETEL
#undef FA_NOFF
#undef FA_BIAS1
#undef FA_T0
#undef FA_SB
}
}

struct Frame { LAS unsigned char* lds; int tid, lane, wave, vcu, G; };

__device__ __forceinline__ void transpose_item(const float* W, int K, int N, bf16_t* WT, int k0, int n0, int drow0, LAS float* scr, int lane) {
#pragma unroll 8
    for (int i = 0; i < 32; ++i) { const int kk = 2 * i + (lane >> 5); scr[kk * 33 + (lane & 31)] = W[(size_t)(k0 + kk) * N + n0 + (lane & 31)]; }
    LDS_WAIT(); asm volatile("" ::: "memory");
    const int c = lane & 7;
#pragma unroll
    for (int j = 0; j < 4; ++j) { const int n = (lane >> 3) + 8 * j; const LAS float* s = scr + (8 * c) * 33 + n;
        u32x4 o; o.x = cvt_pk_bf16(s[0 * 33], s[1 * 33]); o.y = cvt_pk_bf16(s[2 * 33], s[3 * 33]); o.z = cvt_pk_bf16(s[4 * 33], s[5 * 33]); o.w = cvt_pk_bf16(s[6 * 33], s[7 * 33]);
        *(u32x4*)(WT + (size_t)(drow0 + n) * K + k0 + 8 * c) = o; }
    LDS_WAIT(); asm volatile("" ::: "memory");
}
__device__ __forceinline__ void transpose_item_fp8(const float* W, int K, int N, unsigned char* WT, int k0, int n0, int drow0, float sc, LAS float* scr, int lane) {
#pragma unroll 8
    for (int i = 0; i < 32; ++i) { const int kk = 2 * i + (lane >> 5); scr[kk * 33 + (lane & 31)] = W[(size_t)(k0 + kk) * N + n0 + (lane & 31)]; }
    LDS_WAIT(); asm volatile("" ::: "memory");
    const int c = lane & 7;
#pragma unroll
    for (int j = 0; j < 4; ++j) { const int n = (lane >> 3) + 8 * j; const LAS float* q = scr + (8 * c) * 33 + n;
        u32x2 o; o.x = pk4_fp8(q[0 * 33] * sc, q[1 * 33] * sc, q[2 * 33] * sc, q[3 * 33] * sc); o.y = pk4_fp8(q[4 * 33] * sc, q[5 * 33] * sc, q[6 * 33] * sc, q[7 * 33] * sc);
        *(u32x2*)(WT + (size_t)(drow0 + n) * K + k0 + 8 * c) = o; }
    LDS_WAIT(); asm volatile("" ::: "memory");
}
__device__ __forceinline__ int win_dst_row(int n) {
    if (n < 1024) return R_DAQ + n; if (n < 2048) return R_DAK + (n - 1024); if (n < 3072) return R_DAV + (n - 2048); if (n < 4096) return R_WAQ + (n - 3072);
    if (n < 4352) return R_WAK + (n - 4096); if (n < 4608) return R_WAV + (n - 4352); if (n < 5632) return R_XAQ + (n - 4608); return R_GATE + (n - 5632);
}
__device__ __forceinline__ void rms_row_to_bf16(const float* xrow, const float* g, bf16_t* orow, int lane, unsigned* orow8 = nullptr) {
    const f32x4* xr = (const f32x4*)xrow + lane; const f32x4* gr = (const f32x4*)g + lane;
    f32x4 v[4]; float s = 0.f;
#pragma unroll
    for (int j = 0; j < 4; ++j) { v[j] = xr[64 * j]; s += (v[j][0] * v[j][0] + v[j][1] * v[j][1]) + (v[j][2] * v[j][2] + v[j][3] * v[j][3]); }
    const float rstd = 1.0f / sqrtf(wave_sum(s) * (1.0f / 1024.0f) + EPS);
    u32x2* o8 = (u32x2*)orow + lane;
#pragma unroll
    for (int j = 0; j < 4; ++j) { const f32x4 gg = gr[64 * j]; u32x2 wv; wv.x = cvt_pk_bf16(v[j][0] * rstd * gg[0], v[j][1] * rstd * gg[1]); wv.y = cvt_pk_bf16(v[j][2] * rstd * gg[2], v[j][3] * rstd * gg[3]); if (orow) o8[64 * j] = wv;
        if (orow8) orow8[lane + 64 * j] = pk4_fp8(v[j][0] * rstd * gg[0], v[j][1] * rstd * gg[1], v[j][2] * rstd * gg[2], v[j][3] * rstd * gg[3]); }
}
template <int NR>
__device__ __forceinline__ void rms_rows(const float* x0, const float* g, bf16_t* o0, unsigned* o80, int lane) {
    const f32x4* gr = (const f32x4*)g + lane;
    f32x4 v[NR][4]; float rstd[NR];
#pragma unroll
    for (int r = 0; r < NR; ++r) { const f32x4* xr = (const f32x4*)(x0 + (size_t)r * 1024) + lane;
#pragma unroll
        for (int j = 0; j < 4; ++j) v[r][j] = xr[64 * j]; }
#pragma unroll
    for (int r = 0; r < NR; ++r) { float s = 0.f;
#pragma unroll
        for (int j = 0; j < 4; ++j) s += (v[r][j][0] * v[r][j][0] + v[r][j][1] * v[r][j][1]) + (v[r][j][2] * v[r][j][2] + v[r][j][3] * v[r][j][3]);
        rstd[r] = 1.0f / sqrtf(wave_sum(s) * (1.0f / 1024.0f) + EPS); }
#pragma unroll
    for (int j = 0; j < 4; ++j) { const f32x4 gg = gr[64 * j];
#pragma unroll
        for (int r = 0; r < NR; ++r) { const float a = v[r][j][0] * rstd[r] * gg[0], b = v[r][j][1] * rstd[r] * gg[1], c = v[r][j][2] * rstd[r] * gg[2], d = v[r][j][3] * rstd[r] * gg[3];
            if (o0) { u32x2 wv; wv.x = cvt_pk_bf16(a, b); wv.y = cvt_pk_bf16(c, d); ((u32x2*)(o0 + (size_t)r * 1024))[lane + 64 * j] = wv; }
            if (o80) o80[(size_t)r * 256 + lane + 64 * j] = pk4_fp8(a, b, c, d); } }
}
__device__ __forceinline__ void phase_prologue(Frame& F, const Ptrs& P) {
    LAS float* scr = (LAS float*)(F.lds + F.wave * 16384);
    const int gw = F.vcu * 8 + F.wave, NGW = F.G * 8;
    constexpr int I_IN = 16 * 272, I_KV = 16 * 64, I_SQ = 16 * 32;
    constexpr int NIT = I_IN + I_KV + 4 * I_SQ;
    for (int it = gw; it < NIT; it += NGW) {
        int r = it;
        if (r < I_IN) { const int kb = r / 272, nb = r % 272;
            if (WA_FP8 && 32 * nb >= 3072 && 32 * nb < 4608) transpose_item_fp8(P.w_in, 1024, INW, WSP(unsigned char, WS_WWA8), 64 * kb, 32 * nb, 32 * nb - 3072, W8_SCALE, scr, F.lane);
            else if (XA_FP8 && 32 * nb >= 4608 && 32 * nb < 5632) transpose_item_fp8(P.w_in, 1024, INW, WSP(unsigned char, WS_WXQ8), 64 * kb, 32 * nb, 32 * nb - 4608, W8_SCALE, scr, F.lane);
            else if (INPROJ_FP8) transpose_item_fp8(P.w_in, 1024, INW, WSP(unsigned char, WS_WIN), 64 * kb, 32 * nb, win_dst_row(32 * nb), W8_SCALE, scr, F.lane);
            else if (GATES_FP8 && 32 * nb >= 5632) transpose_item_fp8(P.w_in, 1024, INW, WSP(unsigned char, WS_WG8), 64 * kb, 32 * nb, 32 * nb - 5632, W8_SCALE, scr, F.lane);
            else transpose_item(P.w_in, 1024, INW, WSP(bf16_t, WS_WIN), 64 * kb, 32 * nb, win_dst_row(32 * nb), scr, F.lane);
            continue; } r -= I_IN;
        if (r < I_KV) { const int kb = r / 64, nb = r % 64;
            if (XA_FP8) transpose_item_fp8(P.w_mkv, 1024, 2048, WSP(unsigned char, WS_WMKV8), 64 * kb, 32 * nb, 32 * nb, W8_SCALE, scr, F.lane);
            else if (INPROJ_FP8) transpose_item_fp8(P.w_mkv, 1024, 2048, WSP(unsigned char, WS_WMKV), 64 * kb, 32 * nb, 32 * nb, W8_SCALE, scr, F.lane);
            else transpose_item(P.w_mkv, 1024, 2048, WSP(bf16_t, WS_WMKV), 64 * kb, 32 * nb, 32 * nb, scr, F.lane);
            continue; } r -= I_KV;
        const int which = r / I_SQ; r -= which * I_SQ; const int kb = r / 32, nb = r % 32;
        const float* src = which == 0 ? P.w_da_o : which == 1 ? P.w_wa_o : which == 2 ? P.w_xa_o : P.w_out;
        bf16_t* dst = which == 0 ? WSP(bf16_t, WS_WDAO) : which == 1 ? WSP(bf16_t, WS_WWAO) : which == 2 ? WSP(bf16_t, WS_WXAO) : WSP(bf16_t, WS_WOUT);
        if (XS_FP8 && which == 2) transpose_item_fp8(src, 1024, 1024, (unsigned char*)dst, 64 * kb, 32 * nb, 32 * nb, W8_SCALE, scr, F.lane);
        else transpose_item(src, 1024, 1024, dst, 64 * kb, 32 * nb, 32 * nb, scr, F.lane);
    }
    for (int m = 2 * gw; m < MTOK; m += 2 * NGW) rms_rows<2>(P.x + (size_t)m * 1024, P.attn_g, INPROJ_FP8 ? nullptr : WSP(bf16_t, WS_H) + (size_t)m * 1024, GATES_FP8 ? (unsigned*)((char*)P.out + 128 * MiB) + (size_t)m * 256 : nullptr, F.lane);
    for (int m = gw; m < MMEM; m += NGW) rms_row_to_bf16(P.mem + (size_t)m * 1024, P.mem_g, (INPROJ_FP8 || XA_FP8) ? nullptr : WSP(bf16_t, WS_MN) + (size_t)m * 1024, F.lane, XA_FP8 ? WSP(unsigned, WS_MN8) + (size_t)m * 256 : INPROJ_FP8 ? WSP(unsigned, WS_MN) + (size_t)m * 256 : nullptr);
    { u32x4* inv = WSP(u32x4, WS_INV); const int n16 = MTOK * 16 * 2 / 16;
      for (int i = F.vcu * 512 + F.tid; i < n16; i += F.G * 512) inv[i] = (u32x4){0xffffffffu, 0xffffffffu, 0xffffffffu, 0xffffffffu}; }
}

__device__ __forceinline__ void convert_expert_weights(Frame& F, const Ptrs& P, LAS float* scr);
__device__ __forceinline__ void phase_norm_router(Frame& F, const Ptrs& P) {
    LAS float* wl = (LAS float*)F.lds;
    LAS float* gl = wl + 64 * 260;
    for (int i = F.tid; i < 1024 * 16; i += 512) { const int k = i >> 4, e = i & 15; wl[(((k >> 4) & 3) * 16 + e) * 260 + (k >> 6) * 16 + (k & 15)] = P.w_router[i] * P.ffn_g[k]; }
    for (int i = F.tid; i < 1024; i += 512) gl[i] = P.ffn_g[i];
    __syncthreads();
    const int lane = F.lane, t = lane & 15, kq = lane >> 4;
    const LAS float* wrow = wl + (kq * 16 + t) * 260;
    const LAS float* grow = gl + kq * 16;
    LAS float* cscr = (LAS float*)(F.lds + 70656 + F.wave * 8448);
    static_assert(70656 + 8 * 8448 <= MISC_OFF, "conversion tiles overlap the barrier words");
    if (F.wave & 1) convert_expert_weights(F, P, cscr);
    for (int g = F.vcu * 8 + F.wave; g < MTOK / 16; g += F.G * 8) {
        const int m0 = 16 * g;
        const u32x4* xr = (const u32x4*)(WSP(const unsigned char, WS_X1) + (size_t)(m0 + t) * 2048 + kq * 32);
        u32x4 xp[32];
#pragma unroll
        for (int J = 0; J < 16; ++J) { xp[2 * J] = xr[8 * J]; xp[2 * J + 1] = xr[8 * J + 1]; }
        f32x4 a0 = (f32x4){0.f, 0.f, 0.f, 0.f}, a1 = a0; float ss = 0.f;
        f32x4 w0 = *(const LAS f32x4*)(wrow), w1 = *(const LAS f32x4*)(wrow + 4);
#pragma unroll
        for (int j = 0; j < 32; ++j) {
            asm volatile("" ::: "memory");
            const f32x4 w0n = *(const LAS f32x4*)(wrow + 8 * ((j + 1) & 31)), w1n = *(const LAS f32x4*)(wrow + 8 * ((j + 1) & 31) + 4);
            asm volatile("" : "+v"(xp[j]));
            const u32x4 d = xp[j];
            const float x0 = bf_lo(d.x), x1 = bf_hi(d.x), x2 = bf_lo(d.y), x3 = bf_hi(d.y), x4 = bf_lo(d.z), x5 = bf_hi(d.z), x6 = bf_lo(d.w), x7 = bf_hi(d.w);
            a0 = __builtin_amdgcn_mfma_f32_16x16x4f32(w0[0], x0, a0, 0, 0, 0); a1 = __builtin_amdgcn_mfma_f32_16x16x4f32(w0[1], x1, a1, 0, 0, 0);
            a0 = __builtin_amdgcn_mfma_f32_16x16x4f32(w0[2], x2, a0, 0, 0, 0); a1 = __builtin_amdgcn_mfma_f32_16x16x4f32(w0[3], x3, a1, 0, 0, 0);
            a0 = __builtin_amdgcn_mfma_f32_16x16x4f32(w1[0], x4, a0, 0, 0, 0); a1 = __builtin_amdgcn_mfma_f32_16x16x4f32(w1[1], x5, a1, 0, 0, 0);
            a0 = __builtin_amdgcn_mfma_f32_16x16x4f32(w1[2], x6, a0, 0, 0, 0); a1 = __builtin_amdgcn_mfma_f32_16x16x4f32(w1[3], x7, a1, 0, 0, 0);
            ss += ((x0 * x0 + x1 * x1) + (x2 * x2 + x3 * x3)) + ((x4 * x4 + x5 * x5) + (x6 * x6 + x7 * x7));
            w0 = w0n; w1 = w1n; __builtin_amdgcn_sched_barrier(0); }
        ss += __shfl_xor(ss, 16); ss += __shfl_xor(ss, 32);
        const float rstd = 1.0f / sqrtf(ss * (1.0f / 1024.0f) + EPS);
        const f32x4 lg = (a0 + a1) * rstd;
        float mx = fmaxf(fmaxf(lg[0], lg[1]), fmaxf(lg[2], lg[3])); mx = fmaxf(mx, __shfl_xor(mx, 16)); mx = fmaxf(mx, __shfl_xor(mx, 32));
        f32x4 ex; ex[0] = __expf(lg[0] - mx); ex[1] = __expf(lg[1] - mx); ex[2] = __expf(lg[2] - mx); ex[3] = __expf(lg[3] - mx);
        float den = (ex[0] + ex[1]) + (ex[2] + ex[3]); den += __shfl_xor(den, 16); den += __shfl_xor(den, 32);
        *(f32x4*)(WSP(float, WS_AFF) + (size_t)(m0 + t) * 16 + 4 * kq) = ex / den;
        unsigned char* hrow = WSP(unsigned char, WS_H2) + (size_t)(m0 + t) * 1024 + kq * 16;
#pragma unroll
        for (int J = 0; J < 16; ++J) { u32x4 o;
#pragma unroll
            for (int h = 0; h < 2; ++h) { asm volatile("" : "+v"(xp[2 * J + h]) :: "memory"); const u32x4 d = xp[2 * J + h];
                const f32x4 g0 = *(const LAS f32x4*)(grow + 64 * J + 8 * h), g1 = *(const LAS f32x4*)(grow + 64 * J + 8 * h + 4);
                const unsigned lo = pk4_fp8(bf_lo(d.x) * rstd * g0[0], bf_hi(d.x) * rstd * g0[1], bf_lo(d.y) * rstd * g0[2], bf_hi(d.y) * rstd * g0[3]);
                const unsigned hi = pk4_fp8(bf_lo(d.z) * rstd * g1[0], bf_hi(d.z) * rstd * g1[1], bf_lo(d.w) * rstd * g1[2], bf_hi(d.w) * rstd * g1[3]);
                if (h == 0) { o.x = lo; o.y = hi; } else { o.z = lo; o.w = hi; } }
            *(u32x4*)(hrow + 64 * J) = o; __builtin_amdgcn_sched_barrier(0); }
    }
    if (!(F.wave & 1)) convert_expert_weights(F, P, cscr);
}

__device__ __forceinline__ void convert_expert_weights(Frame& F, const Ptrs& P, LAS float* scr) {
    {
        const int gw = F.vcu * 8 + F.wave, NGW = F.G * 8;
        for (int it = gw; it < 3 * 16 * 1024; it += NGW) {
            const int mat = it >> 14, r = it & 16383, e = r >> 10, q = r & 1023;
            if (mat < 2) { const int kb = q >> 6, nb = q & 63, n0 = 32 * nb;
                transpose_item_fp8((mat == 0 ? P.w_eg : P.w_eu) + (size_t)e * 1024 * 2048, 1024, 2048, WSP(unsigned char, WS_WGU) + (size_t)e * 4096 * 1024, 64 * kb, n0, (n0 >> 7) * 256 + mat * 128 + (n0 & 127), W8_SCALE, scr, F.lane); }
            else { const int kb = q >> 5, nb = q & 31;
                transpose_item_fp8(P.w_ed + (size_t)e * 2048 * 1024, 2048, 1024, WSP(unsigned char, WS_WD) + (size_t)e * 1024 * 2048, 64 * kb, 32 * nb, 32 * nb, W8_SCALE, scr, F.lane); }
        }
    }
}
__device__ __forceinline__ void phase_topk_convert(Frame& F, const Ptrs& P) {
    LAS float* vals = (LAS float*)F.lds;
    LAS unsigned* hist = (LAS unsigned*)(F.lds + 8192);
    LAS unsigned* ctl = hist + 256;
    for (int task = F.vcu; task < NB * NEXP; task += F.G) {
        const int b = task >> 4, e = task & 15;
        __syncthreads();
        float v[4]; unsigned u[4];
#pragma unroll
        for (int j = 0; j < 4; ++j) { const int t = F.tid + 512 * j; v[j] = WSP(const float, WS_AFF)[(size_t)(b * SEQ + t) * 16 + e]; vals[t] = v[j]; u[j] = __float_as_uint(v[j]); }
        unsigned prefix = 0u, need = (unsigned)CAP;
        for (int pass = 0; pass < 4; ++pass) {
            const int shift = 24 - 8 * pass;
            if (F.tid < 256) hist[F.tid] = 0u;
            if (F.tid == 0) { ctl[2] = 0u; ctl[4] = 0u; }
            __syncthreads();
#pragma unroll
            for (int j = 0; j < 4; ++j) if (pass == 0 || (u[j] >> (shift + 8)) == prefix) __hip_atomic_fetch_add(&hist[(u[j] >> shift) & 255u], 1u, __ATOMIC_RELAXED, __HIP_MEMORY_SCOPE_WORKGROUP);
            __syncthreads();
            if (F.wave == 0) {
                const u32x4 h4 = *(const LAS u32x4*)(hist + 4 * F.lane);
                const unsigned sl = (h4.x + h4.y) + (h4.z + h4.w);
                unsigned S = sl;
#pragma unroll
                for (int off = 1; off < 64; off <<= 1) { const unsigned t = __shfl_down(S, off); S += (F.lane + off < 64) ? t : 0u; }
                const unsigned long long mk = __ballot(S >= need);
                const int L = 63 - __builtin_clzll(mk);
                if (F.lane == L) { unsigned c = S - sl; int d = 4 * L; unsigned bc = 0u;
                    if (c + h4.w >= need) { d = 4 * L + 3; bc = h4.w; } else { c += h4.w;
                    if (c + h4.z >= need) { d = 4 * L + 2; bc = h4.z; } else { c += h4.z;
                    if (c + h4.y >= need) { d = 4 * L + 1; bc = h4.y; } else { c += h4.y; d = 4 * L; bc = h4.x; } } }
                    ctl[0] = (prefix << 8) | (unsigned)d; ctl[1] = need - c; ctl[3] = bc; }
            }
            __syncthreads();
            prefix = ctl[0]; need = ctl[1];
        }
        const unsigned T = prefix, cnt_eq = ctl[3], ngt = (unsigned)CAP - need;
#pragma unroll
        for (int j = 0; j < 4; ++j) { const int t = F.tid + 512 * j; int slot = -1;
            if (u[j] > T) slot = (int)__hip_atomic_fetch_add(&ctl[2], 1u, __ATOMIC_RELAXED, __HIP_MEMORY_SCOPE_WORKGROUP);
            else if (u[j] == T) {
                if (cnt_eq == need) slot = (int)(ngt + __hip_atomic_fetch_add(&ctl[4], 1u, __ATOMIC_RELAXED, __HIP_MEMORY_SCOPE_WORKGROUP));
                else { unsigned eq = 0u; for (int i = 0; i < t; ++i) eq += (vals[i] == v[j]) ? 1u : 0u; if (eq < need) slot = (int)(ngt + eq); } }
            if (slot >= 0) {
                WSP(int, WS_IDX)[(b * 16 + e) * 256 + slot] = b * SEQ + t;
                WSP(float, WS_GL)[(b * 16 + e) * 256 + slot] = v[j];
                WSP(short, WS_INV)[(size_t)(b * SEQ + t) * 16 + e] = (short)slot; } }
    }
}

__device__ __forceinline__ void phase_final(Frame& F, const Ptrs& P) {
    constexpr int FR = 4;
    const int gw = F.vcu * 8 + F.wave, NGW = F.G * 8, lane = F.lane;
    const short* INV = WSP(const short, WS_INV); const float* GLp = WSP(const float, WS_GL); const unsigned* YEp = WSP(const unsigned, WS_YE);
    f32x4 gg[4];
#pragma unroll
    for (int j = 0; j < 4; ++j) gg[j] = ((const f32x4*)P.final_g)[lane + 64 * j];
    for (int m0 = gw; m0 < MTOK; m0 += FR * NGW) {
        int sl[FR]; u32x2 xq[FR][4]; unsigned yq[FR][4][4]; float glv[FR]; int ek[FR][4]; unsigned rest[FR];
#pragma unroll
        for (int r = 0; r < FR; ++r) { const int m = m0 + r * NGW; sl[r] = (m < MTOK && lane < 16) ? (int)INV[(size_t)m * 16 + lane] : -1; }
#pragma unroll
        for (int r = 0; r < FR; ++r) { const int m = m0 + r * NGW; if (m < MTOK) { const u32x2* xr = WSP(const u32x2, WS_X1) + (size_t)m * 256 + lane;
#pragma unroll
            for (int j = 0; j < 4; ++j) xq[r][j] = xr[64 * j]; } }
#pragma unroll
        for (int r = 0; r < FR; ++r) { const int m = m0 + r * NGW, b = m >> 11;
            unsigned mk = (unsigned)__ballot(sl[r] >= 0) & 0xffffu;
            glv[r] = (sl[r] >= 0) ? GLp[(b * 16 + lane) * 256 + sl[r]] : 0.f;
#pragma unroll
            for (int k = 0; k < 4; ++k) { ek[r][k] = mk ? (int)__builtin_ctz(mk) : -1; mk &= mk - 1u;
                if (ek[r][k] >= 0) { const int s_ = __builtin_amdgcn_readlane(sl[r], ek[r][k]); const unsigned* yr = YEp + (size_t)((ek[r][k] * 32 + b) * 256 + s_) * 256 + lane;
#pragma unroll
                    for (int j = 0; j < 4; ++j) yq[r][k][j] = yr[64 * j]; } }
            rest[r] = mk; }
#pragma unroll
        for (int r = 0; r < FR; ++r) { const int m = m0 + r * NGW, b = m >> 11; if (m >= MTOK) break;
            f32x4 v[4];
#pragma unroll
            for (int j = 0; j < 4; ++j) v[j] = (f32x4){bf_lo(xq[r][j].x), bf_hi(xq[r][j].x), bf_lo(xq[r][j].y), bf_hi(xq[r][j].y)};
#pragma unroll
            for (int k = 0; k < 4; ++k) if (ek[r][k] >= 0) { const float g = __uint_as_float((unsigned)__builtin_amdgcn_readlane((int)__float_as_uint(glv[r]), ek[r][k])) * (1.0f / YE8_SCALE);
#pragma unroll
                for (int j = 0; j < 4; ++j) { const int y = (int)yq[r][k][j]; const f32x2 lo = __builtin_amdgcn_cvt_pk_f32_fp8(y, false), hi2 = __builtin_amdgcn_cvt_pk_f32_fp8(y, true);
                    v[j][0] += g * lo[0]; v[j][1] += g * lo[1]; v[j][2] += g * hi2[0]; v[j][3] += g * hi2[1]; } }
            unsigned rs_ = rest[r];
            while (rs_) { const int e = (int)__builtin_ctz(rs_); rs_ &= rs_ - 1u;
                const int s2 = __builtin_amdgcn_readlane(sl[r], e); const float g = __uint_as_float((unsigned)__builtin_amdgcn_readlane((int)__float_as_uint(glv[r]), e)) * (1.0f / YE8_SCALE);
                const unsigned* yr = YEp + (size_t)((e * 32 + b) * 256 + s2) * 256 + lane;
#pragma unroll
                for (int j = 0; j < 4; ++j) { const int y = (int)yr[64 * j]; const f32x2 lo = __builtin_amdgcn_cvt_pk_f32_fp8(y, false), hi2 = __builtin_amdgcn_cvt_pk_f32_fp8(y, true);
                    v[j][0] += g * lo[0]; v[j][1] += g * lo[1]; v[j][2] += g * hi2[0]; v[j][3] += g * hi2[1]; } }
            float s = 0.f;
#pragma unroll
            for (int j = 0; j < 4; ++j) s += (v[j][0] * v[j][0] + v[j][1] * v[j][1]) + (v[j][2] * v[j][2] + v[j][3] * v[j][3]);
            const float rstd = 1.0f / sqrtf(wave_sum(s) * (1.0f / 1024.0f) + EPS);
            f32x4* orow = (f32x4*)(P.out + (size_t)m * 1024) + lane;
#pragma unroll
            for (int j = 0; j < 4; ++j) { f32x4 o; o[0] = v[j][0] * rstd * gg[j][0]; o[1] = v[j][1] * rstd * gg[j][1]; o[2] = v[j][2] * rstd * gg[j][2]; o[3] = v[j][3] * rstd * gg[j][3]; orow[64 * j] = o; } }
    }
}

constexpr int N_PHASES = 10;
struct Args { Ptrs P; int ph_lo, ph_hi; };
__global__ void __launch_bounds__(512, 2) fwd(Args args) {
    extern __shared__ __attribute__((aligned(16))) unsigned char lds_raw[];
    LAS unsigned char* lds = (LAS unsigned char*)lds_raw;
    const Ptrs& P = args.P;
    Frame F; F.lds = lds; F.tid = threadIdx.x; F.lane = F.tid & 63; F.wave = __builtin_amdgcn_readfirstlane(F.tid >> 6);
    F.G = gridDim.x; { const int bx = blockIdx.x; F.vcu = (F.G % 8 == 0) ? (bx % 8) * (F.G / 8) + bx / 8 : bx; }
    volatile LAS unsigned* MISC = (volatile LAS unsigned*)(lds + MISC_OFF);
    if (F.tid < 64) MISC[F.tid] = 0u;
    __syncthreads();
    XcdBarrier bar; bar.bar = WSP(unsigned, WS_CTL) + 1024; bar.x = 0; bar.st = nullptr;
    if (MK_N_LAUNCHES == 1) bar = xcd_barrier_post(WSP(unsigned, WS_CTL) + 1024, MISC + 8);
    const int lo = args.ph_lo, hi = args.ph_hi;
#ifndef PHMASK
#define PHMASK 0x3ff
#endif
#define IN(k) (((PHMASK >> (k)) & 1) && lo <= (k) && (k) < hi)
#define SEAM(k) do { if (IN(k) && IN((k) + 1)) xcd_barrier(bar); } while (0)

    if (IN(0)) { phase_prologue(F, P); } SEAM(0);
    if (IN(1)) { JobP1 J{P, F.G, (int)blockIdx.x, INPROJ_FP8 ? 512 : 1024, INPROJ_FP8 ? 512 : 1024, INPROJ_FP8 ? 512 : 1024, (LAS float*)(lds + EPI_OFF)}; pg::gemm_phase<JobP1, true, false, INPROJ_FP8 != 0>(lds, J);
        if (XA_FP8) { JobP1x Jx{P, F.G, (int)blockIdx.x, 512, 512, 512}; pg::gemm_phase<JobP1x, true, false, true>(lds, Jx); } } SEAM(1);
    if (IN(2)) {
        for (int i = 0; i < 4; ++i) { const int u_ = i * F.G + F.vcu; fa::wa_group(lds, P, u_ >> 5, (u_ >> 3) & 3, u_ & 7); }
        { JobXA J{P, F.G, (int)blockIdx.x, XS_FP8 ? 128 : 256, XS_FP8 ? 512 : 1024, XS_FP8 ? 512 : 1024, (LAS float*)(lds + EPI_OFF)}; pg::gemm_phase<JobXA, true, false, XS_FP8 != 0>(lds, J); }
        { JobMVW J{P, F.G, (int)blockIdx.x, XS_FP8 ? 128 : 256, XS_FP8 ? 512 : 1024, XS_FP8 ? 512 : 1024}; pg::gemm_phase<JobMVW, true, false, XS_FP8 != 0>(lds, J); }
        { float lam;
          { const float a = P.lq1[F.lane] * P.lk1[F.lane], b2 = P.lq2[F.lane] * P.lk2[F.lane];
            lam = __expf(wave_sum(a)) - __expf(wave_sum(b2)) + LAM_INIT; }
          const int g_ = F.vcu >> 4, qb0 = F.vcu & 15;
          for (int i = 0; i < 16; ++i) { const int ih = i & 7, ib = i >> 3; fa::flash_unit<0>(lds, P, 2 * g_ + ib, (ih + g_) & 7, (qb0 + 3 * ih + 8 * ib) & 15, lam); } }
    } SEAM(2);
    if (IN(3)) {
        { JobMergeG J{P, F.G, (int)blockIdx.x, GATES_FP8 ? 512 : 1024, GATES_FP8 ? 512 : 1024, GATES_FP8 ? 512 : 1024}; pg::gemm_phase<JobMergeG, true, false, GATES_FP8 != 0>(lds, J); }
        if (YC_FP8) { { JobMergeY J{P, F.G, (int)blockIdx.x, 1024, 1024, 1024, 1}; pg::gemm_phase<JobMergeY, true, false>(lds, J); }
                      { JobMergeY J{P, F.G, (int)blockIdx.x, 512, 512, 512, 2}; pg::gemm_phase<JobMergeY, true, false, true>(lds, J); } }
        else { JobMergeY J{P, F.G, (int)blockIdx.x, 1024, 1024, 1024, 0}; pg::gemm_phase<JobMergeY, true, false>(lds, J); }
    } SEAM(3);
    if (IN(4)) { JobOut J{P, F.G, (int)blockIdx.x, 1024, 1024, 1024}; pg::gemm_phase<JobOut, true, false>(lds, J); } SEAM(4);
    if (IN(5)) { phase_norm_router(F, P); } SEAM(5);
    if (IN(6)) { phase_topk_convert(F, P); } SEAM(6);
    if (IN(7)) { JobGU J{P, F.G, (int)blockIdx.x, 512, 512, 512}; pg::gemm_phase<JobGU, true, true, true>(lds, J); } SEAM(7);
    if (IN(8)) { JobDown J{P, F.G, (int)blockIdx.x, 1024, 1024, 1024}; pg::gemm_phase<JobDown, true, false, true>(lds, J); } SEAM(8);
    if (IN(9)) { phase_final(F, P); }
#undef IN
#undef SEAM
}

extern "C" void kernel_launch(void* const* d_in, const int* in_sizes, int n_in, void* d_out, int out_size, void* d_ws, size_t ws_size, hipStream_t stream) {
    static int grid = 0;
    if (grid == 0) {
        if (n_in != 22 || in_sizes[0] != MTOK * DM || out_size != MTOK * DM || ws_size < WS_END) {
            fprintf(stderr, "kernel_launch: unexpected shapes (n_in %d, in0 %d, out %d, ws %zu)\n", n_in, n_in > 0 ? in_sizes[0] : -1, out_size, ws_size); grid = -1; return; }
        int dev = 0, cus = 0;
        if (hipGetDevice(&dev) != hipSuccess || hipDeviceGetAttribute(&cus, hipDeviceAttributeMultiprocessorCount, dev) != hipSuccess) { grid = -1; return; }
        if (hipFuncSetAttribute((const void*)fwd, hipFuncAttributeMaxDynamicSharedMemorySize, LDS_BYTES) != hipSuccess) { fprintf(stderr, "kernel_launch: hipFuncSetAttribute failed\n"); grid = -1; return; }
        int per_cu = 0;
        if (hipOccupancyMaxActiveBlocksPerMultiprocessor(&per_cu, (const void*)fwd, 512, LDS_BYTES) != hipSuccess || per_cu < 1) fprintf(stderr, "kernel_launch: occupancy query says %d\n", per_cu);
        (void)hipGetLastError();
        grid = cus;
        if (grid != 256) fprintf(stderr, "kernel_launch: %d CUs (built for 256)\n", grid);
    }
    if (grid < 0) return;
    (void)hipMemsetAsync((char*)d_ws + WS_CTL, 0, CTL_ZERO_BYTES, stream);
    Args a{};
    Ptrs& P = a.P;
    P.x = (const float*)d_in[0]; P.mem = (const float*)d_in[1]; P.attn_g = (const float*)d_in[2]; P.mem_g = (const float*)d_in[3]; P.w_in = (const float*)d_in[4]; P.w_mkv = (const float*)d_in[5];
    P.lq1 = (const float*)d_in[6]; P.lk1 = (const float*)d_in[7]; P.lq2 = (const float*)d_in[8]; P.lk2 = (const float*)d_in[9]; P.subln_g = (const float*)d_in[10]; P.wa_sink = (const float*)d_in[11];
    P.w_da_o = (const float*)d_in[12]; P.w_wa_o = (const float*)d_in[13]; P.w_xa_o = (const float*)d_in[14]; P.w_out = (const float*)d_in[15]; P.ffn_g = (const float*)d_in[16]; P.w_router = (const float*)d_in[17];
    P.w_eg = (const float*)d_in[18]; P.w_eu = (const float*)d_in[19]; P.w_ed = (const float*)d_in[20]; P.final_g = (const float*)d_in[21];
    P.out = (float*)d_out; P.ws = (unsigned char*)d_ws;
    if (MK_N_LAUNCHES == 1) { a.ph_lo = 0; a.ph_hi = N_PHASES; hipLaunchKernelGGL(fwd, dim3(grid), dim3(512), LDS_BYTES, stream, a); }
    else { for (int p = 0; p < N_PHASES; ++p) { a.ph_lo = p; a.ph_hi = p + 1; hipLaunchKernelGGL(fwd, dim3(grid), dim3(512), LDS_BYTES, stream, a); } }
}
```

```cpp
#include <hip/hip_runtime.h>
#include <cstdio>
#include <cstdint>

#define GATES_FP8 1
#define INPROJ_FP8 0
#define XA_FP8 1
#define YC_FP8 1
#define WA_FP8 1
#define XS_FP8 1
constexpr float XQ8_SCALE = 16.0f;
constexpr float P8_SCALE = 256.0f, MVW8_SCALE = 8.0f;
#ifndef MK_N_LAUNCHES
#define MK_N_LAUNCHES 1
#endif

#define LAS __attribute__((address_space(3)))
#define GAS __attribute__((address_space(1)))
typedef unsigned short bf16_t;
typedef short bf16x8 __attribute__((ext_vector_type(8)));
typedef float f32x4 __attribute__((ext_vector_type(4)));
typedef float f32x2 __attribute__((ext_vector_type(2)));
typedef float f32x16 __attribute__((ext_vector_type(16)));
typedef unsigned u32x4 __attribute__((ext_vector_type(4)));
typedef unsigned u32x2 __attribute__((ext_vector_type(2)));

constexpr int DM = 1024, NB = 32, SEQ = 2048, MTOK = NB * SEQ;
constexpr int MEML = 256, MMEM = NB * MEML;
constexpr int NEXP = 16, CAP = 256, DEXP = 2048;
constexpr int INW = 8704;
constexpr float EPS = 1e-6f;
constexpr float LOG2E = 1.4426950408889634f;
constexpr float LAM_INIT = 0.2f;

constexpr size_t MiB = 1u << 20;
constexpr size_t WS_CTL = 0, CTL_ZERO_BYTES = 64 * 1024;
constexpr size_t WS_KMAX = 32 * 1024;
constexpr size_t WS_GL = 1 * MiB;
constexpr size_t WS_IDX = 1 * MiB + 512 * 1024;
constexpr size_t WS_INV = 2 * MiB;
constexpr size_t WS_WIN = 4 * MiB;
constexpr size_t WS_WMKV = 21 * MiB;
constexpr size_t WS_WDAO = 25 * MiB, WS_WWAO = 27 * MiB, WS_WXAO = 29 * MiB, WS_WOUT = 31 * MiB;
constexpr size_t WS_MN = 33 * MiB;
constexpr size_t WS_MK = 49 * MiB, WS_MV = 65 * MiB;
constexpr size_t WS_MVW = 81 * MiB;
constexpr size_t WS_AFF = 145 * MiB;
constexpr size_t WS_SG0 = 448 * MiB, WS_SG1 = 768 * MiB;
constexpr size_t WS_WXQ8 = 152 * MiB, WS_WMKV8 = 153 * MiB, WS_MN8 = 155 * MiB;
constexpr size_t WS_WWA8 = 163 * MiB;
constexpr size_t WS_WG8 = 149 * MiB;
constexpr size_t WS_ACT0 = 192 * MiB;
constexpr size_t WS_DAQ = 192 * MiB, WS_DAK = 320 * MiB, WS_DAVT = 448 * MiB, WS_WAQ = 576 * MiB, WS_WAK = 704 * MiB, WS_WAVT = 736 * MiB,
                 WS_XAQ = 768 * MiB, WS_H = 896 * MiB, WS_END = 1024 * MiB;
constexpr size_t WS_MERGED = WS_DAK;
constexpr size_t WS_X1 = 192 * MiB;
constexpr size_t WS_H2 = 320 * MiB;
constexpr size_t WS_WGU = 384 * MiB;
constexpr size_t WS_WD = 448 * MiB;
constexpr size_t WS_ACTB = 480 * MiB;
constexpr size_t WS_YE = 736 * MiB;

constexpr int R_DAQ = 0, R_DAK = 1024, R_WAQ = 2048, R_XAQ = 3072, R_WAK = 4096, R_DAV = 4352, R_WAV = 5376, R_GATE = 5632;

constexpr int RING_BYTES = 131072;
constexpr int EPI_OFF = RING_BYTES;
constexpr int MISC_OFF = RING_BYTES + 8192;
constexpr int LDS_BYTES = 147456;

#define LDS_WAIT() asm volatile("s_waitcnt lgkmcnt(0)" ::: "memory")
#define VM_WAIT() asm volatile("s_waitcnt vmcnt(0)" ::: "memory")
__device__ __forceinline__ unsigned cvt_pk_bf16(float lo, float hi) { unsigned r; asm volatile("v_cvt_pk_bf16_f32 %0, %1, %2" : "=v"(r) : "v"(lo), "v"(hi)); return r; }
typedef __bf16 bf16x2_t __attribute__((ext_vector_type(2)));
__device__ __forceinline__ unsigned cvt_pk_bf16_c(float lo, float hi) { f32x2 v; v.x = lo; v.y = hi; return __builtin_bit_cast(unsigned, __builtin_convertvector(v, bf16x2_t)); }
__device__ __forceinline__ float bf_lo(unsigned w) { return __uint_as_float(w << 16); }
__device__ __forceinline__ float bf_hi(unsigned w) { return __uint_as_float(w & 0xffff0000u); }
__device__ __forceinline__ float wave_sum(float v) {
#pragma unroll
    for (int o = 1; o < 64; o <<= 1) v += __shfl_xor(v, o);
    return v;
}
typedef int v8i __attribute__((ext_vector_type(8)));
typedef int v4i __attribute__((ext_vector_type(4)));
constexpr float W8_SCALE = 64.0f, ACT8_SCALE = 8.0f, YE8_SCALE = 8.0f;
__device__ __forceinline__ float clamp8(float v) { return fminf(fmaxf(v, -448.0f), 448.0f); }
__device__ __forceinline__ unsigned pk4_fp8(float a, float b, float c, float d) {
    int w = 0; w = __builtin_amdgcn_cvt_pk_fp8_f32(clamp8(a), clamp8(b), w, false); w = __builtin_amdgcn_cvt_pk_fp8_f32(clamp8(c), clamp8(d), w, true); return (unsigned)w; }
__device__ __forceinline__ float fast_sigmoid(float v) { return __builtin_amdgcn_rcpf(1.0f + __builtin_amdgcn_exp2f(-LOG2E * v)); }

#define XB_TMO      128
#define XB_XCNT(j)  (256  + 64 * (j))
#define XB_XSUB(j)  (1280 + 64 * (j))
#define XB_XGEN(j)  (2304 + 64 * (j))
#define XB_TOP      3328
#define XB_TOPGEN   3392
#define XCD_BAR_WORDS 3456
#define XB_SPIN_CAP (1u << 18)
__device__ __forceinline__ unsigned xb_ld(unsigned* p)              { return __hip_atomic_load(p, __ATOMIC_RELAXED, __HIP_MEMORY_SCOPE_AGENT); }
__device__ __forceinline__ unsigned xb_add(unsigned* p, unsigned v) { return __hip_atomic_fetch_add(p, v, __ATOMIC_RELAXED, __HIP_MEMORY_SCOPE_AGENT); }
__device__ __forceinline__ unsigned xb_xcc_id() { return (unsigned)__builtin_amdgcn_s_getreg((3 << 11) | 20) & 0xFu; }
#define XB_SPIN(cond, bar) do { unsigned _sp = 0; while (cond) { __builtin_amdgcn_s_sleep(1); \
    if ((++_sp & 255u) == 0u) { if (xb_ld(&(bar)[XB_TMO])) break; if (_sp > XB_SPIN_CAP) { atomicAdd(&(bar)[XB_TMO], 1u); break; } } } } while (0)
struct XcdBarrier { unsigned* bar; unsigned x; volatile LAS unsigned* st; };
__device__ __forceinline__ XcdBarrier xcd_barrier_post(unsigned* bar, volatile LAS unsigned* st) {
    XcdBarrier b; b.bar = bar; b.x = xb_xcc_id(); b.st = st;
    if (threadIdx.x == 0) (void)xb_add(&bar[XB_XCNT(b.x)], 1u);
    return b;
}
__device__ __forceinline__ void xcd_barrier_complete(unsigned* bar, unsigned x, unsigned& nloc, unsigned& nx) {
    const unsigned G = gridDim.x * gridDim.y * gridDim.z;
    unsigned sum, cnt, mine, sp = 0u;
    for (;;) {
        sum = 0u; cnt = 0u; mine = 0u;
#pragma unroll
        for (unsigned j = 0; j < 16; ++j) { const unsigned c = xb_ld(&bar[XB_XCNT(j)]); sum += c; cnt += (c > 0u) ? 1u : 0u; mine = (j == x) ? c : mine; }
        if (sum == G) break;
        __builtin_amdgcn_s_sleep(1);
        if ((++sp & 255u) == 0u) { if (xb_ld(&bar[XB_TMO])) break; if (sp > XB_SPIN_CAP) { atomicAdd(&bar[XB_TMO], 1u); break; } }
    }
    nloc = mine > 0u ? mine : 1u; nx = cnt > 0u ? cnt : 1u;
}
__device__ __forceinline__ void xcd_barrier(const XcdBarrier& b) {
    asm volatile("s_waitcnt vmcnt(0)" ::: "memory");
    __syncthreads();
    if (threadIdx.x == 0) {
        unsigned* bar = b.bar;
        __builtin_amdgcn_s_waitcnt(0);
        unsigned nloc = b.st[0], nx = b.st[1];
        if (nloc == 0u) { xcd_barrier_complete(bar, b.x, nloc, nx); b.st[0] = nloc; b.st[1] = nx; }
        const unsigned old = xb_add(&bar[XB_XSUB(b.x)], 1u);
        const unsigned gen = old / nloc;
        if (old + 1u == (gen + 1u) * nloc) {
            __builtin_amdgcn_fence(__ATOMIC_RELEASE, "agent");
            asm volatile("s_waitcnt vmcnt(0)" ::: "memory");
            const unsigned og = xb_add(&bar[XB_TOP], 1u);
            const unsigned tg = og / nx;
            if (og + 1u == (tg + 1u) * nx) xb_add(&bar[XB_TOPGEN], 1u);
            else XB_SPIN(xb_ld(&bar[XB_TOPGEN]) == tg, bar);
            __builtin_amdgcn_fence(__ATOMIC_ACQUIRE, "agent");
            xb_add(&bar[XB_XGEN(b.x)], 1u);
            asm volatile("s_waitcnt vmcnt(0)" ::: "memory");
        } else {
            XB_SPIN(xb_ld(&bar[XB_XGEN(b.x)]) == gen, bar);
            __builtin_amdgcn_fence(__ATOMIC_ACQUIRE, "agent");
            asm volatile("s_waitcnt vmcnt(0)" ::: "memory");
        }
    }
    __syncthreads();
}

namespace pg {
constexpr int BM = 256, BK = 64, HALF = 128, HTB = HALF * BK * 2, STAGE_BYTES = 8 * HTB, NXCD = 8, WGM = 8;
__host__ __device__ __forceinline__ int lds_byte(int r, int c) { const int st = (r >> 4) * 2 + (c >> 5), rr = r & 15, cc = c & 31, ob = rr * 64 + cc * 2; return st * 1024 + (ob ^ (((ob >> 9) & 1) << 5)); }
__host__ __device__ __forceinline__ void stage_rc(int b, int& R, int& C) { const int st = b / 1024, sb = b % 1024, swz = sb ^ (((sb >> 9) & 1) << 5); R = (st >> 1) * 16 + swz / 64; C = (st & 1) * 32 + (swz % 64) / 2; }
__host__ __device__ __forceinline__ int perm32(int rho) { const int n = rho >> 4, i = rho & 15; return 8 * (i >> 2) + 4 * n + (i & 3); }
__device__ __forceinline__ void xcd_map(int L, int nM, int nN, int& pm, int& pn) {
    const int nwg = nM * nN; int wgid = L;
    { const int q = nwg / NXCD, r = nwg % NXCD, xcd = wgid % NXCD, off = wgid / NXCD; wgid = (xcd < r ? xcd * (q + 1) : r * (q + 1) + (xcd - r) * q) + off; }
    const int nig = WGM * nN, gid = wgid / nig, fm = gid * WGM, gsz = (nM - fm) < WGM ? (nM - fm) : WGM;
    pm = fm + ((wgid % nig) % gsz); pn = (wgid % nig) / gsz;
}
struct GUnit { const char* A; const char* B; int pm, pn, job; };

#ifndef PG_SP2
#define PG_SP2 1
#endif
template <class Job, bool PERM, bool GATHER, bool FP8 = false>
__device__ __forceinline__ void gemm_phase(LAS unsigned char* lds, const Job& J) {
    const int tid = threadIdx.x, wid = __builtin_amdgcn_readfirstlane(tid >> 6), lane = tid & 63, wr = wid >> 2, wc = wid & 3, fr = lane & 15, fq = lane >> 4;
    const int K = J.K, nt = K / BK, lda = J.lda, ldb = J.ldb;
    int R0, C0, R1, C1; stage_rc(tid * 16, R0, C0); stage_rc(tid * 16 + 8192, R1, C1);
    unsigned vA[2][2], vAn[2][2], vB[2];
    { const int Rb0 = PERM ? ((R0 & ~31) + perm32(R0 & 31)) : R0, Rb1 = PERM ? ((R1 & ~31) + perm32(R1 & 31)) : R1;
      vB[0] = (unsigned)(Rb0 * ldb + C0) * 2u; vB[1] = (unsigned)(Rb1 * ldb + C1) * 2u; }
    const size_t kstep = (size_t)(BK * 2);
    const size_t hstepB = (size_t)HALF * ldb * 2;
    const unsigned ldsw = (unsigned)wid * 1024u;
    const unsigned ldsb = (unsigned)__builtin_amdgcn_readfirstlane((int)((unsigned)(uintptr_t)lds + ldsw));
    const int aoff = lds_byte(wr * 64 + fr, fq * 8), boff = lds_byte(wc * 32 + fr, fq * 8);
#define PG_SA(b, h) (((b) * 2 + (h)) * HTB)
#define PG_SB(b, h) ((4 + (b) * 2 + (h)) * HTB)
#define PG_STAGE(bufoff, gbase, voff) do { _Pragma("unroll") for (int _i = 0; _i < 2; ++_i) { unsigned _keep; \
        asm volatile("s_mov_b32 %0, m0\n\ts_mov_b32 m0, %3\n\ts_nop 0\n\tglobal_load_lds_dwordx4 %1, %2\n\ts_mov_b32 m0, %0" \
            : "=&s"(_keep) : "v"((voff)[_i]), "s"((const char*)(gbase)), "s"(ldsb + (unsigned)((bufoff) + _i * 8192)) : "memory"); } } while (0)
#define PG_LDA(dst, b, h) do { _Pragma("unroll") for (int m = 0; m < 4; ++m) _Pragma("unroll") for (int k = 0; k < 2; ++k) dst[m][k] = *(const LAS bf16x8*)(lds + PG_SA(b, h) + aoff + m * 2048 + k * 1024); } while (0)
#define PG_LDB(dst, b, h) do { _Pragma("unroll") for (int n = 0; n < 2; ++n) _Pragma("unroll") for (int k = 0; k < 2; ++k) dst[n][k] = *(const LAS bf16x8*)(lds + PG_SB(b, h) + boff + n * 2048 + k * 1024); } while (0)
#define PG_CAT8(x) __builtin_shufflevector(__builtin_bit_cast(v4i, (x)[0]), __builtin_bit_cast(v4i, (x)[1]), 0, 1, 2, 3, 4, 5, 6, 7)
#define PG_MMA(ai, bj, At, Bt) do { __builtin_amdgcn_s_setprio(1); _Pragma("unroll") for (int m = 0; m < 4; ++m) _Pragma("unroll") for (int n = 0; n < 2; ++n) { \
        if constexpr (FP8) { asm volatile("v_mfma_scale_f32_16x16x128_f8f6f4 %0, %1, %2, %0, %3, %3 op_sel_hi:[0,0,0]" : "+v"(acc[ai][bj][m][n]) : "v"(PG_CAT8(Bt[n])), "v"(PG_CAT8(At[m])), "v"(sc8)); } \
        else { _Pragma("unroll") for (int k = 0; k < 2; ++k) acc[ai][bj][m][n] = __builtin_amdgcn_mfma_f32_16x16x32_bf16(Bt[n][k], At[m][k], acc[ai][bj][m][n], 0, 0, 0); } } \
        __builtin_amdgcn_s_setprio(0); } while (0)
#define PG_WAIT_V(n) asm volatile("s_waitcnt vmcnt(" #n ")" ::: "memory")
#define PG_WAIT_L(n) asm volatile("s_waitcnt lgkmcnt(" #n ")" ::: "memory")
#define PG_BAR __builtin_amdgcn_s_barrier()
#define PG_SCHED __builtin_amdgcn_sched_barrier(0)
#define PG_SETV(dst, u) do { if constexpr (GATHER) { const int* _rw = J.rows(u); \
        dst[0][0] = (unsigned)(_rw[R0] * lda + C0) * 2u; dst[0][1] = (unsigned)(_rw[R1] * lda + C1) * 2u; \
        dst[1][0] = (unsigned)(_rw[HALF + R0] * lda + C0) * 2u; dst[1][1] = (unsigned)(_rw[HALF + R1] * lda + C1) * 2u; } \
      else { dst[0][0] = (unsigned)(R0 * lda + C0) * 2u; dst[0][1] = (unsigned)(R1 * lda + C1) * 2u; \
        dst[1][0] = (unsigned)((HALF + R0) * lda + C0) * 2u; dst[1][1] = (unsigned)((HALF + R1) * lda + C1) * 2u; } } while (0)
    const int sc8 = 0x7f7f7f7f;
    GUnit cur, nxt; int ui = 0;
    if (!J.next(0, cur)) return;
    f32x4 acc[2][2][4][2];
#pragma unroll
    for (int a = 0; a < 2; ++a)
#pragma unroll
        for (int b = 0; b < 2; ++b)
#pragma unroll
            for (int m = 0; m < 4; ++m)
#pragma unroll
                for (int n = 0; n < 2; ++n) acc[a][b][m][n] = (f32x4){0.f, 0.f, 0.f, 0.f};
    bf16x8 At[4][2], B0[2][2], B1[2][2];
    const char* cA = cur.A; const char* cB = cur.B;
    PG_SETV(vA, cur);
    if (PG_SP2) {
    PG_STAGE(PG_SB(0, 0), cB, vB); PG_STAGE(PG_SB(0, 1), cB + hstepB, vB); PG_STAGE(PG_SA(0, 0), cA, vA[0]); PG_STAGE(PG_SA(0, 1), cA, vA[1]);
    if (wr == 1) PG_BAR;
    PG_WAIT_V(2); PG_BAR;
    PG_STAGE(PG_SB(1, 0), cB + kstep, vB); PG_STAGE(PG_SA(1, 0), cA + kstep, vA[0]); PG_STAGE(PG_SB(1, 1), cB + hstepB + kstep, vB);
    PG_WAIT_V(6); PG_BAR;
    } else {
    PG_STAGE(PG_SB(0, 0), cB, vB); PG_STAGE(PG_SA(0, 0), cA, vA[0]); PG_STAGE(PG_SB(0, 1), cB + hstepB, vB); PG_STAGE(PG_SA(0, 1), cA, vA[1]);
    if (wr == 1) PG_BAR;
    PG_WAIT_V(4); PG_BAR;
    PG_STAGE(PG_SB(1, 0), cB + kstep, vB); PG_STAGE(PG_SA(1, 0), cA + kstep, vA[0]); PG_STAGE(PG_SB(1, 1), cB + hstepB + kstep, vB);
    PG_WAIT_V(6); PG_BAR;
    }
    for (;;) {
        const bool has_next = J.next(ui + 1, nxt);
        const char* nA = has_next ? nxt.A : cA; const char* nB = has_next ? nxt.B : cB;
        if constexpr (GATHER) { if (has_next) { PG_SETV(vAn, nxt); } else {
#pragma unroll
            for (int h = 0; h < 2; ++h) { vAn[h][0] = vA[h][0]; vAn[h][1] = vA[h][1]; } } }
        for (int t = 0; t < nt; t += 2) {
            const bool last = (t == nt - 2);
            const char* a1 = cA + (size_t)(t + 1) * kstep;
            const char* a2 = last ? nA : cA + (size_t)(t + 2) * kstep; const char* b2 = last ? nB : cB + (size_t)(t + 2) * kstep;
            const char* a3 = a2 + kstep; const char* b3 = b2 + kstep;
            unsigned vq[2][2];
#pragma unroll
            for (int h = 0; h < 2; ++h)
#pragma unroll
                for (int i = 0; i < 2; ++i) vq[h][i] = (GATHER && last) ? vAn[h][i] : vA[h][i];
            if (PG_SP2) {
            PG_LDB(B0, 0, 0); PG_LDB(B1, 0, 1); PG_SCHED; PG_LDA(At, 0, 0); PG_STAGE(PG_SA(1, 1), a1, vA[1]);
            PG_WAIT_V(8); PG_WAIT_L(0); PG_BAR; PG_MMA(0, 0, At, B0); PG_MMA(0, 1, At, B1); PG_BAR; PG_SCHED;
            PG_LDA(At, 0, 1); PG_STAGE(PG_SB(0, 0), b2, vB); PG_STAGE(PG_SB(0, 1), b2 + hstepB, vB); PG_STAGE(PG_SA(0, 0), a2, vq[0]);
            PG_WAIT_V(8); PG_WAIT_L(0); PG_BAR; PG_MMA(1, 0, At, B0); PG_MMA(1, 1, At, B1); PG_BAR; PG_SCHED;
            PG_LDB(B0, 1, 0); PG_LDB(B1, 1, 1); PG_SCHED; PG_LDA(At, 1, 0); PG_STAGE(PG_SA(0, 1), a2, vq[1]);
            PG_WAIT_V(8); PG_WAIT_L(0); PG_BAR; PG_MMA(0, 0, At, B0); PG_MMA(0, 1, At, B1); PG_BAR; PG_SCHED;
            PG_LDA(At, 1, 1); PG_STAGE(PG_SB(1, 0), b3, vB); PG_STAGE(PG_SB(1, 1), b3 + hstepB, vB); PG_STAGE(PG_SA(1, 0), a3, vq[0]);
            PG_WAIT_V(8); PG_WAIT_L(0); PG_BAR; PG_MMA(1, 0, At, B0); PG_MMA(1, 1, At, B1); PG_BAR; PG_SCHED;
            } else {
            PG_LDB(B0, 0, 0); PG_SCHED; PG_LDA(At, 0, 0); PG_STAGE(PG_SA(1, 1), a1, vA[1]);
            PG_WAIT_L(8); PG_BAR; PG_WAIT_L(0); PG_MMA(0, 0, At, B0); PG_BAR; PG_SCHED;
            PG_LDB(B1, 0, 1); PG_STAGE(PG_SB(0, 0), b2, vB);
            PG_BAR; PG_WAIT_L(0); PG_MMA(0, 1, At, B1); PG_BAR;
            PG_LDA(At, 0, 1); PG_STAGE(PG_SA(0, 0), a2, vq[0]);
            PG_BAR; PG_WAIT_L(0); PG_MMA(1, 0, At, B0); PG_BAR; PG_SCHED;
            PG_STAGE(PG_SB(0, 1), b2 + hstepB, vB);
            PG_WAIT_V(6); PG_BAR; PG_MMA(1, 1, At, B1); PG_BAR;
            PG_LDB(B0, 1, 0); PG_SCHED; PG_LDA(At, 1, 0); PG_STAGE(PG_SA(0, 1), a2, vq[1]);
            PG_WAIT_L(8); PG_BAR; PG_WAIT_L(0); PG_MMA(0, 0, At, B0); PG_BAR; PG_SCHED;
            PG_LDB(B1, 1, 1); PG_STAGE(PG_SB(1, 0), b3, vB);
            PG_BAR; PG_WAIT_L(0); PG_MMA(0, 1, At, B1); PG_BAR;
            PG_LDA(At, 1, 1); PG_STAGE(PG_SA(1, 0), a3, vq[0]);
            PG_BAR; PG_WAIT_L(0); PG_MMA(1, 0, At, B0); PG_BAR; PG_SCHED;
            PG_STAGE(PG_SB(1, 1), b3 + hstepB, vB);
            PG_WAIT_V(6); PG_BAR; PG_MMA(1, 1, At, B1); PG_BAR;
            }
        }
        if constexpr (FP8) asm volatile("s_nop 15\n\ts_nop 7" ::: "memory");
        if (wr == 0) PG_BAR;
        J.epi(acc, cur, wr, wc, fr, fq);
        if (!has_next) break;
#pragma unroll
        for (int a = 0; a < 2; ++a)
#pragma unroll
            for (int b = 0; b < 2; ++b)
#pragma unroll
                for (int m = 0; m < 4; ++m)
#pragma unroll
                    for (int n = 0; n < 2; ++n) acc[a][b][m][n] = (f32x4){0.f, 0.f, 0.f, 0.f};
        cur = nxt; cA = nA; cB = nB; ++ui;
        if constexpr (GATHER) {
#pragma unroll
            for (int h = 0; h < 2; ++h) { vA[h][0] = vAn[h][0]; vA[h][1] = vAn[h][1]; } }
        if (wr == 1) PG_BAR;
    }
    PG_WAIT_V(0);
    PG_BAR;
#undef PG_SA
#undef PG_SB
#undef PG_STAGE
#undef PG_LDA
#undef PG_LDB
#undef PG_MMA
#undef PG_CAT8
#undef PG_WAIT_V
#undef PG_WAIT_L
#undef PG_BAR
#undef PG_SCHED
#undef PG_SETV
}

__device__ __forceinline__ void store_tile_bf16(const f32x4 (&acc)[2][2][4][2], bf16_t* O, int ldo, float sc, int wr, int wc, int fr, int fq) {
    const unsigned loff = (unsigned)((wr * 64 + fr) * ldo + wc * 32 + 8 * fq) * 2u;
#pragma unroll
    for (int ai = 0; ai < 2; ++ai)
#pragma unroll
        for (int m = 0; m < 4; ++m) { char* rowb = (char*)O + (size_t)(ai * HALF + m * 16) * ldo * 2;
#pragma unroll
            for (int bj = 0; bj < 2; ++bj) { const f32x4 v0 = acc[ai][bj][m][0] * sc, v1 = acc[ai][bj][m][1] * sc;
                u32x4 w; w.x = cvt_pk_bf16(v0[0], v0[1]); w.y = cvt_pk_bf16(v0[2], v0[3]); w.z = cvt_pk_bf16(v1[0], v1[1]); w.w = cvt_pk_bf16(v1[2], v1[3]);
                *(u32x4*)(rowb + bj * HALF * 2 + loff) = w; } }
}
}

struct Ptrs {
    const float* x; const float* mem; const float* attn_g; const float* mem_g; const float* w_in; const float* w_mkv;
    const float* lq1; const float* lk1; const float* lq2; const float* lk2; const float* subln_g; const float* wa_sink;
    const float* w_da_o; const float* w_wa_o; const float* w_xa_o; const float* w_out; const float* ffn_g; const float* w_router;
    const float* w_eg; const float* w_eu; const float* w_ed; const float* final_g;
    float* out; unsigned char* ws;
};
#define WSP(T, off) ((T*)(P.ws + (off)))

struct JobP1 {
    Ptrs P; int G, c; int K, lda, ldb; LAS float* scr;
    __device__ __forceinline__ bool next(int i, pg::GUnit& u) const {
        int L = i * G + c;
        constexpr size_t RB = INPROJ_FP8 ? 1024 : 2048;
        const char* h = INPROJ_FP8 ? (const char*)P.out + 128 * MiB : (const char*)(P.ws + WS_H); const char* w = (const char*)(P.ws + WS_WIN);
        if (XA_FP8 && WA_FP8) {
            if (L < 2048) { pg::xcd_map(L, 256, 8, u.pm, u.pn); u.job = 0; u.A = h + (size_t)u.pm * (256 * RB); u.B = w + (size_t)u.pn * (256 * RB); return true; }
            L -= 2048;
            if (L < 1024) { pg::xcd_map(L, 4, 256, u.pm, u.pn); u.job = 1; u.A = w + (size_t)(R_DAV + u.pm * 256) * RB; u.B = h + (size_t)u.pn * (256 * RB); return true; }
            return false;
        }
        if (XA_FP8) {
            if (L < 3328) { pg::xcd_map(L, 256, 13, u.pm, u.pn); if (u.pn == 12) u.pn = 16; u.job = 0; u.A = h + (size_t)u.pm * (256 * RB); u.B = w + (size_t)u.pn * (256 * RB); return true; }
            L -= 3328;
            if (L < 1280) { pg::xcd_map(L, 5, 256, u.pm, u.pn); u.job = 1; u.A = w + (size_t)(R_DAV + u.pm * 256) * RB; u.B = h + (size_t)u.pn * (256 * RB); return true; }
            return false;
        }
        if (L < 4352) { pg::xcd_map(L, 256, 17, u.pm, u.pn); u.job = 0; u.A = h + (size_t)u.pm * (256 * RB); u.B = w + (size_t)u.pn * (256 * RB); return true; }
        L -= 4352;
        if (L < 1280) { pg::xcd_map(L, 5, 256, u.pm, u.pn); u.job = 1; u.A = w + (size_t)(R_DAV + u.pm * 256) * RB; u.B = h + (size_t)u.pn * (256 * RB); return true; }
        L -= 1280;
        if (L < 256) { pg::xcd_map(L, 32, 8, u.pm, u.pn); u.job = 2; u.A = (const char*)(P.ws + WS_MN) + (size_t)u.pm * (256 * RB); u.B = (const char*)(P.ws + WS_WMKV) + (size_t)u.pn * (256 * RB); return true; }
        return false;
    }
    __device__ __forceinline__ const int* rows(const pg::GUnit&) const { return nullptr; }
    __device__ __forceinline__ void epi(const f32x4 (&acc)[2][2][4][2], const pg::GUnit& u, int wr, int wc, int fr, int fq) const {
        bf16_t* O; int ldo = 1024; float sc = INPROJ_FP8 ? (1.0f / W8_SCALE) : 1.f;
        if (u.job == 0) {
            const int s = u.pn >> 2, q = u.pn & 3;
            if (s == 0) { O = WSP(bf16_t, WS_DAQ) + (size_t)u.pm * 256 * 1024 + q * 256; sc *= 0.125f * LOG2E; }
            else if (s == 1) { O = WSP(bf16_t, WS_DAK) + (size_t)u.pm * 256 * 1024 + q * 256; }
            else if (s == 2) { O = WSP(bf16_t, WS_WAQ) + (size_t)u.pm * 256 * 1024 + q * 256; sc *= 0.125f * LOG2E; }
            else if (s == 3) { O = WSP(bf16_t, WS_XAQ) + (size_t)u.pm * 256 * 1024 + q * 256; sc *= 0.0625f * LOG2E; }
            else { O = WSP(bf16_t, WS_WAK) + (size_t)u.pm * 256 * 256; ldo = 256; }
        } else if (u.job == 1) {
            ldo = MTOK;
            if (u.pm < 4) O = WSP(bf16_t, WS_DAVT) + (size_t)u.pm * 256 * MTOK + (size_t)u.pn * 256;
            else O = WSP(bf16_t, WS_WAVT) + (size_t)u.pn * 256;
        } else {
            if (u.pn < 4) O = WSP(bf16_t, WS_MK) + (size_t)u.pm * 256 * 1024 + u.pn * 256;
            else O = WSP(bf16_t, WS_MV) + (size_t)u.pm * 256 * 1024 + (u.pn - 4) * 256;
        }
        pg::store_tile_bf16(acc, O, ldo, sc, wr, wc, fr, fq);
        if (u.job == 0 && (u.pn >> 2) == 1) {
            LAS float* X = scr;
#pragma unroll
            for (int ai = 0; ai < 2; ++ai)
#pragma unroll
                for (int m = 0; m < 4; ++m)
#pragma unroll
                    for (int bj = 0; bj < 2; ++bj) { const f32x4 a = acc[ai][bj][m][0] * sc, b2 = acc[ai][bj][m][1] * sc;
                        float q = (a[0] * a[0] + a[1] * a[1]) + (a[2] * a[2] + a[3] * a[3]) + (b2[0] * b2[0] + b2[1] * b2[1]) + (b2[2] * b2[2] + b2[3] * b2[3]);
                        q += __shfl_xor(q, 16); q += __shfl_xor(q, 32);
                        if (fq == 0) X[((ai * 128 + wr * 64 + m * 16 + fr) * 2 + bj) * 4 + wc] = q; }
            LDS_WAIT(); __builtin_amdgcn_s_barrier(); asm volatile("" ::: "memory");
            { const int t = threadIdx.x, row = t & 255, bj = t >> 8; const f32x4 q = *(const LAS f32x4*)(X + (row * 2 + bj) * 4);
              float v = fmaxf(q[0] + q[1], q[2] + q[3]) * 1.01f;
#pragma unroll
              for (int off = 1; off < 64; off <<= 1) v = fmaxf(v, __shfl_xor(v, off));
              if ((t & 63) == 0) __hip_atomic_fetch_max(WSP(unsigned, WS_KMAX) + (u.pm >> 3) * 8 + 2 * (u.pn - 4) + bj, __float_as_uint(v), __ATOMIC_RELAXED, __HIP_MEMORY_SCOPE_AGENT); }
            LDS_WAIT(); __builtin_amdgcn_s_barrier(); asm volatile("" ::: "memory");
        }
    }
};

struct JobP1x {
    Ptrs P; int G, c; int K, lda, ldb;
    __device__ __forceinline__ bool next(int i, pg::GUnit& u) const {
        int L = i * G + c;
        if (L < 1024) { pg::xcd_map(L, 256, 4, u.pm, u.pn); u.job = 0; u.A = (const char*)P.out + 128 * MiB + (size_t)u.pm * (256 * 1024); u.B = (const char*)(P.ws + WS_WXQ8) + (size_t)u.pn * (256 * 1024); return true; }
        L -= 1024;
        if (L < 256) { pg::xcd_map(L, 32, 8, u.pm, u.pn); u.job = 2; u.A = (const char*)(P.ws + WS_MN8) + (size_t)u.pm * (256 * 1024); u.B = (const char*)(P.ws + WS_WMKV8) + (size_t)u.pn * (256 * 1024); return true; }
        if (!WA_FP8) return false;
        L -= 256;
        const char* h8 = (const char*)P.out + 128 * MiB; const char* w8 = (const char*)(P.ws + WS_WWA8);
        if (L < 1280) { pg::xcd_map(L, 256, 5, u.pm, u.pn); u.job = 3; u.A = h8 + (size_t)u.pm * (256 * 1024); u.B = w8 + (size_t)u.pn * (256 * 1024); return true; }
        L -= 1280;
        if (L < 256) { u.pm = 0; u.pn = L; u.job = 4; u.A = w8 + (size_t)1280 * 1024; u.B = h8 + (size_t)u.pn * (256 * 1024); return true; }
        return false;
    }
    __device__ __forceinline__ const int* rows(const pg::GUnit&) const { return nullptr; }
    __device__ __forceinline__ void epi(const f32x4 (&acc)[2][2][4][2], const pg::GUnit& u, int wr, int wc, int fr, int fq) const {
        bf16_t* O; float sc = 1.0f / W8_SCALE;
        if (u.job >= 3) {
            int ldo = 1024;
            if (u.job == 4) { O = WSP(bf16_t, WS_WAVT) + (size_t)u.pn * 256; ldo = MTOK; }
            else if (u.pn < 4) { O = WSP(bf16_t, WS_WAQ) + (size_t)u.pm * 256 * 1024 + u.pn * 256; sc *= 0.125f * LOG2E; }
            else { O = WSP(bf16_t, WS_WAK) + (size_t)u.pm * 256 * 256; ldo = 256; }
            pg::store_tile_bf16(acc, O, ldo, sc, wr, wc, fr, fq);
            return; }
        if (u.job == 0) { O = WSP(bf16_t, WS_XAQ) + (size_t)u.pm * 256 * 1024 + u.pn * 256; sc *= 0.0625f * LOG2E; }
        else if (u.pn < 4) O = WSP(bf16_t, WS_MK) + (size_t)u.pm * 256 * 1024 + u.pn * 256;
        else O = WSP(bf16_t, WS_MV) + (size_t)u.pm * 256 * 1024 + (u.pn - 4) * 256;
        if (XS_FP8) {
            if (u.job == 0) sc *= XQ8_SCALE;
            char* O8 = (char*)(P.ws + (u.job == 0 ? WS_XAQ : (u.pn < 4 ? WS_MK : WS_MV))) + (size_t)u.pm * 256 * 1024 + (u.pn & 3) * 256;
            const unsigned loff = (unsigned)((wr * 64 + fr) * 1024 + wc * 32 + 8 * fq);
#pragma unroll
            for (int ai = 0; ai < 2; ++ai)
#pragma unroll
                for (int m = 0; m < 4; ++m)
#pragma unroll
                    for (int bj = 0; bj < 2; ++bj) { const f32x4 a = acc[ai][bj][m][0] * sc, b2 = acc[ai][bj][m][1] * sc;
                        u32x2 w; w.x = pk4_fp8(a[0], a[1], a[2], a[3]); w.y = pk4_fp8(b2[0], b2[1], b2[2], b2[3]);
                        *(u32x2*)(O8 + (size_t)(ai * 128 + m * 16) * 1024 + bj * 128 + loff) = w; }
            return; }
        pg::store_tile_bf16(acc, O, 1024, sc, wr, wc, fr, fq);
    }
};

struct JobXA {
    Ptrs P; int G, c; int K, lda, ldb; LAS float* scr;
    __device__ __forceinline__ bool next(int i, pg::GUnit& u) const {
        const int L = i * G + c; if (L >= 1024) return false;
        u.job = 0; u.pm = L >> 2; u.pn = L & 3;
        if (XS_FP8) { u.A = (const char*)(P.ws + WS_XAQ) + (size_t)u.pm * (256 * 1024) + u.pn * 256;
                      u.B = (const char*)(P.ws + WS_MK) + (size_t)(u.pm >> 3) * (256 * 1024) + u.pn * 256; return true; }
        u.A = (const char*)(P.ws + WS_XAQ) + (size_t)u.pm * (256 * 1024 * 2) + u.pn * 512;
        u.B = (const char*)(P.ws + WS_MK) + (size_t)(u.pm >> 3) * (256 * 1024 * 2) + u.pn * 512; return true;
    }
    __device__ __forceinline__ const int* rows(const pg::GUnit&) const { return nullptr; }
    __device__ __forceinline__ void epi(f32x4 (&acc)[2][2][4][2], const pg::GUnit& u, int wr, int wc, int fr, int fq) const {
        LAS f32x2* X = (LAS f32x2*)scr;
        if (XS_FP8) {
#pragma unroll
            for (int ai = 0; ai < 2; ++ai)
#pragma unroll
                for (int bj = 0; bj < 2; ++bj)
#pragma unroll
                    for (int m = 0; m < 4; ++m)
#pragma unroll
                        for (int n = 0; n < 2; ++n) acc[ai][bj][m][n] = acc[ai][bj][m][n] * (1.0f / XQ8_SCALE); }
        float lm[2][4];
#pragma unroll
        for (int ai = 0; ai < 2; ++ai)
#pragma unroll
            for (int m = 0; m < 4; ++m) { float v = -3.0e38f;
#pragma unroll
                for (int bj = 0; bj < 2; ++bj)
#pragma unroll
                    for (int n = 0; n < 2; ++n) { const f32x4 a = acc[ai][bj][m][n]; v = fmaxf(v, fmaxf(fmaxf(a[0], a[1]), fmaxf(a[2], a[3]))); }
                v = fmaxf(v, __shfl_xor(v, 16)); v = fmaxf(v, __shfl_xor(v, 32));
                float sm = 0.f;
#pragma unroll
                for (int bj = 0; bj < 2; ++bj)
#pragma unroll
                    for (int n = 0; n < 2; ++n) { f32x4 a = acc[ai][bj][m][n];
#pragma unroll
                        for (int j = 0; j < 4; ++j) { a[j] = __builtin_amdgcn_exp2f(a[j] - v); sm += a[j]; }
                        acc[ai][bj][m][n] = a; }
                sm += __shfl_xor(sm, 16); sm += __shfl_xor(sm, 32);
                lm[ai][m] = v; if (fq == 0) X[(ai * 128 + wr * 64 + m * 16 + fr) * 4 + wc] = (f32x2){v, sm}; }
        LDS_WAIT(); __builtin_amdgcn_s_barrier(); asm volatile("" ::: "memory");
#pragma unroll
        for (int ai = 0; ai < 2; ++ai)
#pragma unroll
            for (int m = 0; m < 4; ++m) { const LAS f32x2* xp = X + (ai * 128 + wr * 64 + m * 16 + fr) * 4;
                const f32x2 p0 = xp[0], p1 = xp[1], p2 = xp[2], p3 = xp[3];
                const float M = fmaxf(fmaxf(p0[0], p1[0]), fmaxf(p2[0], p3[0]));
                const float tot = (p0[1] * __builtin_amdgcn_exp2f(p0[0] - M) + p1[1] * __builtin_amdgcn_exp2f(p1[0] - M)) + (p2[1] * __builtin_amdgcn_exp2f(p2[0] - M) + p3[1] * __builtin_amdgcn_exp2f(p3[0] - M));
                const float f = __builtin_amdgcn_exp2f(lm[ai][m] - M) / tot;
#pragma unroll
                for (int bj = 0; bj < 2; ++bj)
#pragma unroll
                    for (int n = 0; n < 2; ++n) acc[ai][bj][m][n] = acc[ai][bj][m][n] * f; }
        if (YC_FP8) { char* O8 = (char*)P.out + (size_t)u.pm * 256 * 1024 + u.pn * 256; const unsigned loff = (unsigned)((wr * 64 + fr) * 1024 + wc * 32 + 8 * fq);
#pragma unroll
            for (int ai = 0; ai < 2; ++ai)
#pragma unroll
                for (int m = 0; m < 4; ++m)
#pragma unroll
                    for (int bj = 0; bj < 2; ++bj) { const f32x4 a = acc[ai][bj][m][0] * P8_SCALE, b2 = acc[ai][bj][m][1] * P8_SCALE;
                        u32x2 w; w.x = pk4_fp8(a[0], a[1], a[2], a[3]); w.y = pk4_fp8(b2[0], b2[1], b2[2], b2[3]);
                        *(u32x2*)(O8 + (size_t)(ai * 128 + m * 16) * 1024 + bj * 128 + loff) = w; } }
        else { bf16_t* O = (bf16_t*)P.out + (size_t)u.pm * 256 * 1024 + u.pn * 256;
            pg::store_tile_bf16(acc, O, 1024, 1.f, wr, wc, fr, fq); }
        LDS_WAIT(); __builtin_amdgcn_s_barrier(); asm volatile("" ::: "memory");
    }
};
struct JobMVW {
    Ptrs P; int G, c; int K, lda, ldb;
    __device__ __forceinline__ bool next(int i, pg::GUnit& u) const {
        const int L = i * G + c; if (L >= 512) return false;
        u.job = 0; u.pm = L & 3; u.pn = L >> 2;
        if (XS_FP8) { u.A = (const char*)(P.ws + WS_WXAO) + (size_t)u.pm * (256 * 1024) + (u.pn & 3) * 256;
                      u.B = (const char*)(P.ws + WS_MV) + (size_t)(u.pn >> 2) * (256 * 1024) + (u.pn & 3) * 256; return true; }
        u.A = (const char*)(P.ws + WS_WXAO) + (size_t)u.pm * (256 * 1024 * 2) + (u.pn & 3) * 512;
        u.B = (const char*)(P.ws + WS_MV) + (size_t)(u.pn >> 2) * (256 * 1024 * 2) + (u.pn & 3) * 512; return true;
    }
    __device__ __forceinline__ const int* rows(const pg::GUnit&) const { return nullptr; }
    __device__ __forceinline__ void epi(const f32x4 (&acc)[2][2][4][2], const pg::GUnit& u, int wr, int wc, int fr, int fq) const {
        if (YC_FP8) { char* O8 = (char*)(P.ws + WS_MVW) + (size_t)(u.pn >> 2) * (1024 * 1024) + (size_t)u.pm * 256 * 1024 + (u.pn & 3) * 256;
            const unsigned loff = (unsigned)((wr * 64 + fr) * 1024 + wc * 32 + 8 * fq);
#pragma unroll
            for (int ai = 0; ai < 2; ++ai)
#pragma unroll
                for (int m = 0; m < 4; ++m)
#pragma unroll
                    for (int bj = 0; bj < 2; ++bj) { const float ms = XS_FP8 ? MVW8_SCALE / W8_SCALE : MVW8_SCALE; const f32x4 a = acc[ai][bj][m][0] * ms, b2 = acc[ai][bj][m][1] * ms;
                        u32x2 w; w.x = pk4_fp8(a[0], a[1], a[2], a[3]); w.y = pk4_fp8(b2[0], b2[1], b2[2], b2[3]);
                        *(u32x2*)(O8 + (size_t)(ai * 128 + m * 16) * 1024 + bj * 128 + loff) = w; } }
        else { bf16_t* O = WSP(bf16_t, WS_MVW) + (size_t)(u.pn >> 2) * (1024 * 1024) + (size_t)u.pm * 256 * 1024 + (u.pn & 3) * 256;
            pg::store_tile_bf16(acc, O, 1024, 1.f, wr, wc, fr, fq); }
    }
};

__device__ __forceinline__ char* sg_base(const Ptrs& P, int br) {
    return br == 0 ? (char*)(P.ws + WS_SG0) : br == 1 ? (char*)(P.ws + WS_SG1) : (GATES_FP8 ? (char*)(P.ws + WS_H) : (char*)P.out + 128 * MiB);
}
struct JobMergeG {
    Ptrs P; int G, c; int K, lda, ldb;
    __device__ __forceinline__ bool next(int i, pg::GUnit& u) const {
        if (i >= 12) return false;
        const int ti = i / 3, br = i - ti * 3;
        pg::xcd_map(ti * G + c, 256, 4, u.pm, u.pn); u.job = br;
        if (GATES_FP8) { u.A = (const char*)P.out + 128 * MiB + (size_t)u.pm * (256 * 1024); u.B = (const char*)(P.ws + (INPROJ_FP8 ? WS_WIN + (size_t)R_GATE * 1024 : WS_WG8)) + (size_t)(br * 1024 + u.pn * 256) * 1024; }
        else { u.A = (const char*)(P.ws + WS_H) + (size_t)u.pm * (256 * 1024 * 2); u.B = (const char*)(P.ws + WS_WIN) + (size_t)(R_GATE + br * 1024 + u.pn * 256) * 2048; }
        return true;
    }
    __device__ __forceinline__ const int* rows(const pg::GUnit&) const { return nullptr; }
    __device__ __forceinline__ void epi(const f32x4 (&acc)[2][2][4][2], const pg::GUnit& u, int wr, int wc, int fr, int fq) const {
        char* OB = sg_base(P, u.job) + ((size_t)u.pm * 256 * 1024 + u.pn * 256) * 2;
        const unsigned loff = (unsigned)((wr * 64 + fr) * 1024 + wc * 32 + 8 * fq) * 2u;
        constexpr float sc = GATES_FP8 ? (1.0f / W8_SCALE) : 1.0f;
#pragma unroll
        for (int ai = 0; ai < 2; ++ai)
#pragma unroll
            for (int m = 0; m < 4; ++m)
#pragma unroll
                for (int bj = 0; bj < 2; ++bj) { const unsigned uo = (unsigned)((ai * 128 + m * 16) * 1024 + bj * 128) * 2u;
                    const f32x4 a = acc[ai][bj][m][0] * (-LOG2E * sc), b = acc[ai][bj][m][1] * (-LOG2E * sc);
#define MG_SIG(v) __builtin_amdgcn_rcpf(1.0f + __builtin_amdgcn_exp2f(v))
                    u32x4 w; w.x = cvt_pk_bf16_c(MG_SIG(a[0]), MG_SIG(a[1])); w.y = cvt_pk_bf16_c(MG_SIG(a[2]), MG_SIG(a[3]));
                    w.z = cvt_pk_bf16_c(MG_SIG(b[0]), MG_SIG(b[1])); w.w = cvt_pk_bf16_c(MG_SIG(b[2]), MG_SIG(b[3]));
#undef MG_SIG
                    *(u32x4*)(OB + uo + loff) = w; }
    }
};
struct JobMergeY {
    Ptrs P; int G, c; int K, lda, ldb; int mode;
    __device__ __forceinline__ bool next(int i, pg::GUnit& u) const {
        int ti, br;
        if (mode == 0) { if (i >= 12) return false; ti = i / 3; br = i - ti * 3; }
        else if (mode == 1) { if (i >= 8) return false; ti = i >> 1; br = i & 1; }
        else { if (i >= 4) return false; ti = i; br = 2; }
        pg::xcd_map(ti * G + c, 256, 4, u.pm, u.pn); u.job = br;
        if (mode == 2) { u.A = (const char*)P.out + (size_t)u.pm * (256 * 1024); u.B = (const char*)(P.ws + WS_MVW) + (size_t)(u.pm >> 3) * (1024 * 1024) + (size_t)u.pn * (256 * 1024); return true; }
        if (br == 0) { u.A = (const char*)(P.ws + WS_DAQ) + (size_t)u.pm * (256 * 1024 * 2); u.B = (const char*)(P.ws + WS_WDAO) + (size_t)u.pn * (256 * 1024 * 2); }
        else if (br == 1) { u.A = (const char*)(P.ws + WS_WAQ) + (size_t)u.pm * (256 * 1024 * 2); u.B = (const char*)(P.ws + WS_WWAO) + (size_t)u.pn * (256 * 1024 * 2); }
        else { u.A = (const char*)P.out + (size_t)u.pm * (256 * 1024 * 2); u.B = (const char*)(P.ws + WS_MVW) + (size_t)(u.pm >> 3) * (1024 * 1024 * 2) + (size_t)u.pn * (256 * 1024 * 2); }
        return true;
    }
    __device__ __forceinline__ const int* rows(const pg::GUnit&) const { return nullptr; }
    __device__ __forceinline__ void epi(const f32x4 (&acc)[2][2][4][2], const pg::GUnit& u, int wr, int wc, int fr, int fq) const {
        const size_t tileoff = ((size_t)u.pm * 256 * 1024 + u.pn * 256) * 2;
        const char* SGb = sg_base(P, u.job) + tileoff; char* MGb = (char*)(P.ws + WS_MERGED) + tileoff;
        const unsigned loff = (unsigned)((wr * 64 + fr) * 1024 + wc * 32 + 8 * fq) * 2u;
        const bool hasPrev = u.job != 0;
        const float ysc = (mode == 2) ? 1.0f / (P8_SCALE * MVW8_SCALE) : 1.0f;
#pragma unroll
        for (int ai = 0; ai < 2; ++ai) {
            u32x4 g[4][2], pv[4][2];
#pragma unroll
            for (int m = 0; m < 4; ++m)
#pragma unroll
                for (int bj = 0; bj < 2; ++bj) { const unsigned uo = (unsigned)((ai * 128 + m * 16) * 1024 + bj * 128) * 2u;
                    g[m][bj] = __builtin_nontemporal_load((const u32x4*)(SGb + uo + loff));
                    pv[m][bj] = (u32x4){0u, 0u, 0u, 0u};
                    if (hasPrev) pv[m][bj] = __builtin_nontemporal_load((const u32x4*)(MGb + uo + loff)); }
#pragma unroll
            for (int m = 0; m < 4; ++m)
#pragma unroll
                for (int bj = 0; bj < 2; ++bj) { const unsigned uo = (unsigned)((ai * 128 + m * 16) * 1024 + bj * 128) * 2u;
                    const f32x4 a = acc[ai][bj][m][0] * ysc, b = acc[ai][bj][m][1] * ysc;
                    const u32x4 gq = g[m][bj], pq = pv[m][bj];
                    u32x4 w;
                    w.x = cvt_pk_bf16(bf_lo(pq.x) + bf_lo(gq.x) * a[0], bf_hi(pq.x) + bf_hi(gq.x) * a[1]);
                    w.y = cvt_pk_bf16(bf_lo(pq.y) + bf_lo(gq.y) * a[2], bf_hi(pq.y) + bf_hi(gq.y) * a[3]);
                    w.z = cvt_pk_bf16(bf_lo(pq.z) + bf_lo(gq.z) * b[0], bf_hi(pq.z) + bf_hi(gq.z) * b[1]);
                    w.w = cvt_pk_bf16(bf_lo(pq.w) + bf_lo(gq.w) * b[2], bf_hi(pq.w) + bf_hi(gq.w) * b[3]);
                    *(u32x4*)(MGb + uo + loff) = w; }
            asm volatile("" ::: "memory"); }
    }
};

struct JobOut {
    Ptrs P; int G, c; int K, lda, ldb;
    __device__ __forceinline__ bool next(int i, pg::GUnit& u) const {
        const int L = i * G + c; if (L >= 1024) return false;
        pg::xcd_map(L, 256, 4, u.pm, u.pn); u.job = 0;
        u.A = (const char*)(P.ws + WS_MERGED) + (size_t)u.pm * (256 * 1024 * 2); u.B = (const char*)(P.ws + WS_WOUT) + (size_t)u.pn * (256 * 1024 * 2); return true;
    }
    __device__ __forceinline__ const int* rows(const pg::GUnit&) const { return nullptr; }
    __device__ __forceinline__ void epi(const f32x4 (&acc)[2][2][4][2], const pg::GUnit& u, int wr, int wc, int fr, int fq) const {
        const int row0 = u.pm * 256 + wr * 64 + fr, col0 = u.pn * 256 + wc * 32 + 8 * fq;
#pragma unroll
        for (int ai = 0; ai < 2; ++ai)
#pragma unroll
            for (int m = 0; m < 4; ++m) { const size_t off = (size_t)(row0 + ai * 128 + m * 16) * 1024 + col0;
#pragma unroll
                for (int bj = 0; bj < 2; ++bj) { const f32x4 x0 = *(const f32x4*)(P.x + off + bj * 128), x1 = *(const f32x4*)(P.x + off + bj * 128 + 4);
                    const f32x4 v0 = x0 + acc[ai][bj][m][0], v1 = x1 + acc[ai][bj][m][1];
                    u32x4 w; w.x = cvt_pk_bf16(v0[0], v0[1]); w.y = cvt_pk_bf16(v0[2], v0[3]); w.z = cvt_pk_bf16(v1[0], v1[1]); w.w = cvt_pk_bf16(v1[2], v1[3]);
                    *(u32x4*)(WSP(bf16_t, WS_X1) + off + bj * 128) = w; } }
    }
};
struct JobGU {
    Ptrs P; int G, c; int K, lda, ldb;
    __device__ __forceinline__ bool next(int i, pg::GUnit& u) const {
        const int L = i * G + c; if (L >= 8192) return false;
        pg::xcd_map(L, 512, 16, u.pm, u.pn); u.job = 0;
        u.A = (const char*)(P.ws + WS_H2);
        u.B = (const char*)(P.ws + WS_WGU) + (size_t)(u.pm >> 5) * (4096 * 1024) + (size_t)u.pn * (256 * 1024); return true;
    }
    __device__ __forceinline__ const int* rows(const pg::GUnit& u) const { const int e = u.pm >> 5, b = u.pm & 31; return WSP(const int, WS_IDX) + (b * 16 + e) * 256; }
    __device__ __forceinline__ void epi(const f32x4 (&acc)[2][2][4][2], const pg::GUnit& u, int wr, int wc, int fr, int fq) const {
        char* O = (char*)(P.ws + WS_ACTB) + (size_t)u.pm * 256 * 2048 + u.pn * 128;
        const unsigned loff = (unsigned)((wr * 64 + fr) * 2048 + wc * 32 + 8 * fq);
        constexpr float IS = 1.0f / W8_SCALE, KX = -LOG2E * IS, IC = 1.0f / (IS * IS * ACT8_SCALE);
#pragma unroll
        for (int ai = 0; ai < 2; ++ai)
#pragma unroll
            for (int m = 0; m < 4; ++m) {
                f32x2 o[2][2];
#pragma unroll
                for (int n = 0; n < 2; ++n)
#pragma unroll
                    for (int p = 0; p < 2; ++p) {
                        const f32x2 g = p ? __builtin_shufflevector(acc[ai][0][m][n], acc[ai][0][m][n], 2, 3) : __builtin_shufflevector(acc[ai][0][m][n], acc[ai][0][m][n], 0, 1);
                        const f32x2 up = p ? __builtin_shufflevector(acc[ai][1][m][n], acc[ai][1][m][n], 2, 3) : __builtin_shufflevector(acc[ai][1][m][n], acc[ai][1][m][n], 0, 1);
                        const f32x2 t = g * up, x = g * KX;
                        f32x2 e; e.x = __builtin_amdgcn_exp2f(x.x); e.y = __builtin_amdgcn_exp2f(x.y);
                        const f32x2 d = e * IC + IC;
                        f32x2 r; r.x = __builtin_amdgcn_rcpf(d.x); r.y = __builtin_amdgcn_rcpf(d.y);
                        o[n][p] = t * r; }
                u32x2 w; w.x = pk4_fp8(o[0][0].x, o[0][0].y, o[0][1].x, o[0][1].y); w.y = pk4_fp8(o[1][0].x, o[1][0].y, o[1][1].x, o[1][1].y);
                *(u32x2*)(O + (size_t)(ai * 128 + m * 16) * 2048 + loff) = w; }
    }
};
struct JobDown {
    Ptrs P; int G, c; int K, lda, ldb;
    __device__ __forceinline__ bool next(int i, pg::GUnit& u) const {
        const int L = i * G + c; if (L >= 2048) return false;
        pg::xcd_map(L, 512, 4, u.pm, u.pn); u.job = 0;
        u.A = (const char*)(P.ws + WS_ACTB) + (size_t)u.pm * (256 * 2048);
        u.B = (const char*)(P.ws + WS_WD) + (size_t)(u.pm >> 5) * (1024 * 2048) + (size_t)u.pn * (256 * 2048); return true;
    }
    __device__ __forceinline__ const int* rows(const pg::GUnit&) const { return nullptr; }
    __device__ __forceinline__ void epi(const f32x4 (&acc)[2][2][4][2], const pg::GUnit& u, int wr, int wc, int fr, int fq) const {
        char* O = (char*)(P.ws + WS_YE) + (size_t)u.pm * 256 * 1024 + u.pn * 256;
        const unsigned loff = (unsigned)((wr * 64 + fr) * 1024 + wc * 32 + 8 * fq);
        constexpr float sc = YE8_SCALE / (W8_SCALE * ACT8_SCALE);
#pragma unroll
        for (int ai = 0; ai < 2; ++ai)
#pragma unroll
            for (int m = 0; m < 4; ++m)
#pragma unroll
                for (int bj = 0; bj < 2; ++bj) { const f32x4 a = acc[ai][bj][m][0] * sc, b2 = acc[ai][bj][m][1] * sc;
                    u32x2 w; w.x = pk4_fp8(a[0], a[1], a[2], a[3]); w.y = pk4_fp8(b2[0], b2[1], b2[2], b2[3]);
                    *(u32x2*)(O + (size_t)(ai * 128 + m * 16) * 1024 + bj * 128 + loff) = w; }
    }
};

namespace fa {
__device__ __forceinline__ void glds16(const void* g, LAS unsigned char* l) { __builtin_amdgcn_global_load_lds((const unsigned*)g, (LAS unsigned*)l, 16, 0, 0); }
__device__ __forceinline__ void glds16_s(const char* sbase, unsigned voff, unsigned ldsaddr) { unsigned keep;
    asm volatile("s_mov_b32 %0, m0\n\ts_mov_b32 m0, %3\n\ts_nop 0\n\tglobal_load_lds_dwordx4 %1, %2\n\ts_mov_b32 m0, %0" : "=&s"(keep) : "v"(voff), "s"(sbase), "s"(ldsaddr) : "memory"); }
__device__ __forceinline__ float max3f(float a, float b, float c) { float r; asm volatile("v_max3_f32 %0, %1, %2, %3" : "=v"(r) : "v"(a), "v"(b), "v"(c)); return r; }
#define FA_ROWMAX(_m, Y0, Y1) do { \
        float _g0 = __builtin_amdgcn_fmed3f(Y0[0], Y0[1], Y0[2]); asm volatile("" : "+v"(_g0)); \
        float _g1 = __builtin_amdgcn_fmed3f(Y1[0], Y1[1], Y1[2]); asm volatile("" : "+v"(_g1)); \
        _m = max3f(Y0[0], Y0[1], Y0[2]); float _m2 = max3f(Y1[0], Y1[1], Y1[2]); \
        _Pragma("unroll") for (int _r = 3; _r < 15; _r += 2) { _m = max3f(_m, Y0[_r], Y0[_r + 1]); _m2 = max3f(_m2, Y1[_r], Y1[_r + 1]); } \
        _m = max3f(_m, Y0[15], Y1[15]); _m = max3f(_m, _m2, _m2); { float _o = __shfl_xor(_m, 32); _m = max3f(_m, _o, _o); } } while (0)
constexpr float THR = 16.0f;
#define FA_SB() __builtin_amdgcn_sched_barrier(0)

template <int MODE>
__device__ __forceinline__ void flash_unit(LAS unsigned char* lds, const Ptrs& P, int b, int hd, int qblk, float lam) {
    constexpr bool DA = (MODE == 0);
    constexpr int NDB = DA ? 4 : 2;
    constexpr int NPV = 4 * NDB;
    constexpr int STG = DA ? 32768 : 16384, VOFF = DA ? 16384 : 8192;
    const int tid = threadIdx.x, lane = tid & 63, r32 = lane & 31, hi = lane >> 5, w = __builtin_amdgcn_readfirstlane(tid >> 6);
    int q0, qw, NT, tlo, ts, thi; bool notrack = false;
    const bf16_t *Qp, *Kp, *Vp; bf16_t* Op; int kld; float slope2;
    if constexpr (DA) {
        q0 = qblk * 128; const int map = w >> 2; qw = q0 + (w & 3) * 32;
        Qp = WSP(const bf16_t, WS_DAQ) + (size_t)(b * SEQ) * 1024 + hd * 128 + map * 64;
        Kp = WSP(const bf16_t, WS_DAK) + (size_t)(b * SEQ) * 1024 + hd * 128;
        Vp = WSP(const bf16_t, WS_DAVT) + (size_t)(hd * 128) * MTOK + (size_t)b * SEQ;
        Op = WSP(bf16_t, WS_DAQ) + (size_t)(b * SEQ) * 1024 + hd * 128;
        kld = 1024; NT = 32; tlo = 0; thi = 31; ts = q0 >> 6;
        slope2 = LOG2E * __builtin_amdgcn_exp2f(-(float)(hd + 1));
    } else {
        q0 = qblk * 256; qw = q0 + w * 32; const int kvh = hd >> 2;
        Qp = WSP(const bf16_t, WS_WAQ) + (size_t)(b * SEQ) * 1024 + hd * 64;
        Kp = WSP(const bf16_t, WS_WAK) + (size_t)(b * SEQ) * 256 + kvh * 64;
        Vp = WSP(const bf16_t, WS_WAVT) + (size_t)(kvh * 64) * MTOK + (size_t)b * SEQ;
        Op = WSP(bf16_t, WS_WAQ) + (size_t)(b * SEQ) * 1024 + hd * 64;
        kld = 256; tlo = 4 * qblk - 2; if (tlo < 0) tlo = 0; thi = 4 * qblk + 5; if (thi > 31) thi = 31; ts = 4 * qblk; NT = thi - tlo + 1;
        slope2 = LOG2E * __builtin_amdgcn_exp2f(-0.5f * (float)(hd + 1));
    }
    const int Rk = w * 8 + (lane >> 3), slot = lane & 7;
    const bf16_t* srcK0 = Kp + (size_t)Rk * kld + ((slot ^ ((Rk >> 1) & 7)) * 8);
    const bf16_t* srcV0 = Vp + (size_t)Rk * MTOK + ((slot ^ ((Rk >> 1) & 7)) * 8);
    const bf16_t* srcV1 = Vp + (size_t)(Rk + 64) * MTOK + ((slot ^ (((Rk + 64) >> 1) & 7)) * 8);
    const unsigned koffb = (unsigned)(Rk * kld + ((slot ^ ((Rk >> 1) & 7)) * 8)) * 2u;
    const unsigned voffb0 = (unsigned)(Rk * MTOK + ((slot ^ ((Rk >> 1) & 7)) * 8)) * 2u, voffb1 = (unsigned)((Rk + 64) * MTOK + ((slot ^ (((Rk + 64) >> 1) & 7)) * 8)) * 2u;
    const unsigned ldsw0 = (unsigned)__builtin_amdgcn_readfirstlane((int)((unsigned)(uintptr_t)lds + (unsigned)w * 1024u));
#define FA_DMAK(t, stg) do { LAS unsigned char* _s = lds + (stg) * STG; \
        if constexpr (DA) { const char* _kb = (const char*)Kp + (size_t)(t) * (64 * 1024 * 2); const unsigned _la = ldsw0 + (unsigned)((stg) * STG); \
            glds16_s(_kb, koffb, _la); glds16_s(_kb, koffb + 128u, _la + 8192u); } \
        else { glds16(srcK0 + (size_t)(t) * 64 * 256, _s + w * 1024); } } while (0)
#define FA_DMAV(t, stg) do { LAS unsigned char* _s = lds + (stg) * STG; \
        if constexpr (DA) { const char* _vb = (const char*)Vp + (size_t)(t) * 128; const unsigned _la = ldsw0 + (unsigned)((stg) * STG + VOFF); \
            glds16_s(_vb, voffb0, _la); glds16_s(_vb, voffb1, _la + 8192u); } \
        else { glds16(srcV0 + (t) * 64, _s + VOFF + w * 1024); } } while (0)
#define FA_TILE(i) ((ts + (i) <= thi) ? ts + (i) : tlo + ((i) - (thi - ts + 1)))
    FA_DMAK(FA_TILE(0), 0);
    bf16x8 qf[4];
    { const bf16_t* qp = Qp + (size_t)(qw + r32) * 1024 + hi * 8;
#pragma unroll
      for (int d = 0; d < 4; ++d) qf[d] = *(const bf16x8*)(qp + d * 16); }
    if constexpr (DA) {
        float qs = 0.f;
#pragma unroll
        for (int d = 0; d < 4; ++d)
#pragma unroll
            for (int jj = 0; jj < 8; ++jj) { const float x = __uint_as_float(((unsigned)(unsigned short)qf[d][jj]) << 16); qs += x * x; }
        qs += __shfl_xor(qs, 32);
#pragma unroll
        for (int off = 1; off < 32; off <<= 1) qs = fmaxf(qs, __shfl_xor(qs, off));
        volatile LAS float* qsc = (volatile LAS float*)(lds + MISC_OFF + 64);
        if (lane == 0) qsc[w] = qs;
        LDS_WAIT(); __builtin_amdgcn_s_barrier(); asm volatile("" ::: "memory");
        float qn2 = qsc[0];
#pragma unroll
        for (int i = 1; i < 8; ++i) qn2 = fmaxf(qn2, qsc[i]);
        const float kn2 = __uint_as_float(WSP(const unsigned, WS_KMAX)[b * 8 + hd]);
        const float qk = sqrtf(qn2 * kn2);
        notrack = __builtin_amdgcn_readfirstlane((int)(qk < 100.0f)) != 0;
        float wf = (46.0f + 2.0f * qk) / slope2; wf = fminf(wf, 4096.0f);
        const int W = __builtin_amdgcn_readfirstlane((int)wf + 1);
        tlo = (q0 - W) < 0 ? 0 : ((q0 - W) >> 6); thi = (q0 + 127 + W) >> 6; if (thi > 31) thi = 31;
        if (((thi - tlo) & 1) == 0) { if (thi < 31) ++thi; else --tlo; }
        NT = thi - tlo + 1;
    }
    const int krow = (r32 & 0x13) | ((r32 & 4) << 1) | ((r32 & 8) >> 1), ksw = (krow >> 1) & 7, vsw = (r32 >> 1) & 7;
    const LAS unsigned char* kp[4]; const LAS unsigned char* vp[4];
#pragma unroll
    for (int d = 0; d < 4; ++d) kp[d] = lds + (DA ? (w >> 2) * 8192 : 0) + krow * 128 + (((2 * d + hi) ^ ksw) * 16);
#pragma unroll
    for (int ks = 0; ks < 4; ++ks) vp[ks] = lds + r32 * 128 + (((4 * (ks >> 1) + 2 * (ks & 1) + hi) ^ vsw) * 16);
    f32x16 o[NDB];
#pragma unroll
    for (int d = 0; d < NDB; ++d) o[d] = (f32x16){0.f, 0.f, 0.f, 0.f, 0.f, 0.f, 0.f, 0.f, 0.f, 0.f, 0.f, 0.f, 0.f, 0.f, 0.f, 0.f};
    f32x16 A0, A1, B0, B1;
    B0 = o[0]; B1 = o[0];
    float mref = 0.f, negm = 0.f, l = 0.f, fsave = 1.f; bool resc = false;
    const int qpos = qw + r32; const float nslope = -slope2;
    u32x4 pk[4]; bf16x8 kf[4], vf[8];
#define FA_EL(X0, X1, e) (((e) < 16) ? X0[(e) & 15] : X1[(e) & 15])
#define FA_SETEL(X0, X1, e, v) do { if ((e) < 16) X0[(e) & 15] = (v); else X1[(e) & 15] = (v); } while (0)
#define FA_NOFF(e) (32 * ((e) >> 4) + 16 * (((e) & 15) >> 3) + ((e) & 7))
#define FA_BIAS1(X0, X1, e) do { const float _x = t0n - (float)FA_NOFF(e); float _c = __builtin_fmaf(nslope, __builtin_fabsf(_x), negm); \
        if constexpr (!DA) _c = (__builtin_fabsf(_x) > 128.0f) ? -1.0e30f : _c; asm volatile("" : "+v"(_c)); FA_SETEL(X0, X1, e, _c); } while (0)
#define FA_BIASC(X0, X1, e) do { float _c = __builtin_fmaf(bd1, (float)FA_NOFF(e), bbase); asm volatile("" : "+v"(_c)); FA_SETEL(X0, X1, e, _c); } while (0)
#define FA_T0(dst, t) do { float _t = (float)(qpos - 64 * (t) - 8 * hi); asm volatile("" : "+v"(_t)); dst = _t; } while (0)
#define FA_STEP(Y0, Y1, X0, X1, KS, VB, T, TN, HASN, TRK, PV, CH) do { \
        if (HASN) FA_DMAK(TN, (KS) ^ 1); \
        FA_DMAV(T, KS); \
        _Pragma("unroll") for (int _j = 0; _j < 4; ++_j) kf[_j] = *(const LAS bf16x8*)(kp[_j >> 1] + (KS) * STG + (_j & 1) * 4096); \
        if (PV) { _Pragma("unroll") for (int _f = 0; _f < 8; ++_f) vf[_f] = *(const LAS bf16x8*)(vp[DA ? (_f >> 2) : (_f >> 1)] + (VB) + (DA ? (_f & 3) : (_f & 1)) * 4096); } \
        float t0n; FA_T0(t0n, TN); \
        float sacc = 0.f; FA_SB(); \
        _Pragma("unroll") for (int _j = 0; _j < 8; ++_j) { \
            if (_j & 1) Y1 = __builtin_amdgcn_mfma_f32_32x32x16_bf16(kf[_j & 3], qf[_j >> 1], Y1, 0, 0, 0); \
            else        Y0 = __builtin_amdgcn_mfma_f32_32x32x16_bf16(kf[_j & 3], qf[_j >> 1], Y0, 0, 0, 0); \
            if (_j < 4) kf[_j] = *(const LAS bf16x8*)(kp[(_j + 4) >> 1] + (KS) * STG + (_j & 1) * 4096); \
            { const float _a = FA_EL(X0, X1, 4 * _j), _b = FA_EL(X0, X1, 4 * _j + 1), _c = FA_EL(X0, X1, 4 * _j + 2), _d = FA_EL(X0, X1, 4 * _j + 3); \
              sacc += (_a + _b) + (_c + _d); asm volatile("" : "+v"(sacc)); pk[_j >> 1][2 * (_j & 1)] = cvt_pk_bf16(_a, _b); pk[_j >> 1][2 * (_j & 1) + 1] = cvt_pk_bf16(_c, _d); } \
            FA_SB(); } \
        l += sacc; \
        if (TRK) { float _m; FA_ROWMAX(_m, Y0, Y1); resc = false; \
          if (__builtin_expect(__any(_m > THR), 0)) { const float _dl = fmaxf(_m, 0.f); mref += _dl; negm = -mref; fsave = __builtin_amdgcn_exp2f(-_dl); l *= fsave; resc = true; \
              _Pragma("unroll") for (int _r = 0; _r < 16; ++_r) { Y0[_r] -= _dl; Y1[_r] -= _dl; } } } \
        float bbase = 0.f, bd1 = 0.f; if (CH) { const float _sn = ((TN) > ts) ? -nslope : nslope; bbase = __builtin_fmaf(_sn, t0n, negm); bd1 = -_sn; } \
        FA_SB(); \
        _Pragma("unroll") for (int _i = 0; _i < NPV; ++_i) { \
            if (PV) { o[DA ? (_i & 3) : (_i & 1)] = __builtin_amdgcn_mfma_f32_32x32x16_bf16(vf[_i & 7], __builtin_bit_cast(bf16x8, pk[DA ? (_i >> 2) : (_i >> 1)]), o[DA ? (_i & 3) : (_i & 1)], 0, 0, 0); \
              if (DA && _i < 8) vf[_i] = *(const LAS bf16x8*)(vp[(_i + 8) >> 2] + (VB) + ((_i + 8) & 3) * 4096); } \
            _Pragma("unroll") for (int _e = 0; _e < 32 / NPV; ++_e) { const int _q = (32 / NPV) * _i + _e; \
                { float _ev = __builtin_amdgcn_exp2f(FA_EL(Y0, Y1, _q)); asm volatile("" : "+v"(_ev)); FA_SETEL(Y0, Y1, _q, _ev); } if (CH) FA_BIASC(X0, X1, _q); else FA_BIAS1(X0, X1, _q); } \
            FA_SB(); } \
        asm volatile("s_waitcnt vmcnt(0) lgkmcnt(0)" ::: "memory"); __builtin_amdgcn_s_barrier(); asm volatile("" ::: "memory"); \
        if (TRK && __builtin_expect(resc, 0)) { _Pragma("unroll") for (int _d = 0; _d < NDB; ++_d) _Pragma("unroll") for (int _r = 0; _r < 16; ++_r) o[_d][_r] *= fsave; } \
    } while (0)
    { float t0n; FA_T0(t0n, FA_TILE(0));
#pragma unroll
      for (int e = 0; e < 32; ++e) FA_BIAS1(A0, A1, e); }
    asm volatile("s_waitcnt vmcnt(0)" ::: "memory"); __builtin_amdgcn_s_barrier(); asm volatile("" ::: "memory");
    const bool trk = !(DA && notrack);
    { const int t0_ = FA_TILE(0), t1_ = FA_TILE(1), t2_ = FA_TILE(2);
      FA_STEP(A0, A1, B0, B1, 0, 0, t0_, t1_, true, trk, false, false);
      FA_STEP(B0, B1, A0, A1, 1, VOFF, t1_, t2_, true, trk, true, DA); }
    for (int i = 2; i < NT; i += 2) {
        const int ta = FA_TILE(i), tb = FA_TILE(i + 1), tc = (i + 2 < NT) ? FA_TILE(i + 2) : FA_TILE(i + 1);
        FA_STEP(A0, A1, B0, B1, 0, STG + VOFF, ta, tb, true, trk, true, DA);
        FA_STEP(B0, B1, A0, A1, 1, VOFF, tb, tc, (i + 2 < NT), trk, true, DA); }
    { float sacc = 0.f;
#pragma unroll
      for (int j = 0; j < 8; ++j) { const float a_ = FA_EL(B0, B1, 4 * j), b_ = FA_EL(B0, B1, 4 * j + 1), c_ = FA_EL(B0, B1, 4 * j + 2), d_ = FA_EL(B0, B1, 4 * j + 3);
          sacc += (a_ + b_) + (c_ + d_); pk[j >> 1][2 * (j & 1)] = cvt_pk_bf16(a_, b_); pk[j >> 1][2 * (j & 1) + 1] = cvt_pk_bf16(c_, d_); }
      l += sacc;
#pragma unroll
      for (int i = 0; i < NPV; ++i) { const int ks = DA ? (i >> 2) : (i >> 1), d = DA ? (i & 3) : (i & 1);
          const bf16x8 v = *(const LAS bf16x8*)(vp[ks] + STG + VOFF + d * 4096);
          o[d] = __builtin_amdgcn_mfma_f32_32x32x16_bf16(v, __builtin_bit_cast(bf16x8, pk[ks]), o[d], 0, 0, 0); } }
    LDS_WAIT(); __builtin_amdgcn_s_barrier(); asm volatile("" ::: "memory");
    l += __shfl_xor(l, 32);
    if constexpr (DA) {
        const float il = 1.0f / l;
        LAS float* ex = (LAS float*)lds + (w & 3) * 4096;
        if (w >= 4) {
#pragma unroll
            for (int d = 0; d < 4; ++d)
#pragma unroll
                for (int r = 0; r < 16; ++r) ex[(d * 16 + r) * 64 + lane] = o[d][r] * il;
        }
        LDS_WAIT(); __builtin_amdgcn_s_barrier(); asm volatile("" ::: "memory");
        if (w < 4) {
            float ss = 0.f;
#pragma unroll
            for (int d = 0; d < 4; ++d)
#pragma unroll
                for (int r = 0; r < 16; ++r) { const float v = o[d][r] * il - lam * ex[(d * 16 + r) * 64 + lane]; o[d][r] = v; ss += v * v; }
            ss += __shfl_xor(ss, 32);
            const float rs = (1.0f - LAM_INIT) * __builtin_amdgcn_rsqf(ss * (1.0f / 128.0f) + EPS);
            bf16_t* op = Op + (size_t)(qw + r32) * 1024;
#pragma unroll
            for (int d = 0; d < 4; ++d)
#pragma unroll
                for (int gp = 0; gp < 2; ++gp) { u32x2 pw[2];
#pragma unroll
                    for (int gg = 0; gg < 2; ++gg) { const int g = 2 * gp + gg, dd = d * 32 + 8 * g + 4 * hi; const f32x4 sg = *(const f32x4*)(P.subln_g + dd);
                        pw[gg].x = cvt_pk_bf16(o[d][4 * g] * rs * sg[0], o[d][4 * g + 1] * rs * sg[1]); pw[gg].y = cvt_pk_bf16(o[d][4 * g + 2] * rs * sg[2], o[d][4 * g + 3] * rs * sg[3]); }
                    const unsigned sx = hi ? pw[0].x : pw[1].x, sy = hi ? pw[0].y : pw[1].y;
                    const unsigned rx = (unsigned)__shfl_xor((int)sx, 32), ry = (unsigned)__shfl_xor((int)sy, 32);
                    u32x4 wv; if (hi) { wv.x = rx; wv.y = ry; wv.z = pw[1].x; wv.w = pw[1].y; } else { wv.x = pw[0].x; wv.y = pw[0].y; wv.z = rx; wv.w = ry; }
                    *(u32x4*)(op + d * 32 + 16 * gp + 8 * hi) = wv; }
        }
    } else {
        const float sink2 = P.wa_sink[hd] * LOG2E;
        const float lt = l + __builtin_amdgcn_exp2f(sink2 - mref);
        const float il = 1.0f / lt;
        bf16_t* op = Op + (size_t)(qw + r32) * 1024;
#pragma unroll
        for (int d = 0; d < 2; ++d)
#pragma unroll
            for (int g = 0; g < 4; ++g) { const int dd = d * 32 + 8 * g + 4 * hi;
                u32x2 wv; wv.x = cvt_pk_bf16(o[d][4 * g] * il, o[d][4 * g + 1] * il); wv.y = cvt_pk_bf16(o[d][4 * g + 2] * il, o[d][4 * g + 3] * il);
                *(u32x2*)(op + dd) = wv; }
    }
    asm volatile("s_waitcnt vmcnt(0) lgkmcnt(0)" ::: "memory"); __builtin_amdgcn_s_barrier(); asm volatile("" ::: "memory");
#undef FA_DMAK
#undef FA_DMAV
#undef FA_TILE
#undef FA_EL
#undef FA_SETEL
#undef FA_NOFF
#undef FA_BIAS1
#undef FA_BIASC
#undef FA_T0
#undef FA_STEP
}
#undef FA_SB
__device__ __forceinline__ void wa_group(LAS unsigned char* lds, const Ptrs& P, int b, int kvh, int qblk) {
    constexpr int NDB = 2, NPV = 8, TSZ = 16384, VOFF = 8192;
    const int tid = threadIdx.x, lane = tid & 63, r32 = lane & 31, hi = lane >> 5, w = __builtin_amdgcn_readfirstlane(tid >> 6);
    const int q0 = qblk * 256, qw = q0 + w * 32;
    int tlo = 4 * qblk - 2; if (tlo < 0) tlo = 0; int thi = 4 * qblk + 5; if (thi > 31) thi = 31; const int NTW = thi - tlo + 1;
    { const bf16_t* Kp = WSP(const bf16_t, WS_WAK) + (size_t)(b * SEQ) * 256 + kvh * 64;
      const bf16_t* Vp = WSP(const bf16_t, WS_WAVT) + (size_t)(kvh * 64) * MTOK + (size_t)b * SEQ;
      const int Rk = w * 8 + (lane >> 3), slot = lane & 7;
      const bf16_t* srcK0 = Kp + (size_t)Rk * 256 + ((slot ^ ((Rk >> 1) & 7)) * 8);
      const bf16_t* srcV0 = Vp + (size_t)Rk * MTOK + ((slot ^ ((Rk >> 1) & 7)) * 8);
      for (int j = 0; j < NTW; ++j) { const int t = tlo + j; glds16(srcK0 + (size_t)t * 64 * 256, lds + j * TSZ + w * 1024); glds16(srcV0 + t * 64, lds + j * TSZ + VOFF + w * 1024); } }
    int tw0 = (qw - 128) >> 6; const int tw0r = tw0; if (tw0 > thi - 4) tw0 = thi - 4; if (tw0 < tlo) tw0 = tlo;
    const bool regular = __builtin_amdgcn_readfirstlane((int)(tw0 == tw0r)) != 0;
    const int krow = (r32 & 0x13) | ((r32 & 4) << 1) | ((r32 & 8) >> 1), ksw = (krow >> 1) & 7, vsw = (r32 >> 1) & 7;
    const LAS unsigned char* kp[4]; const LAS unsigned char* vp[4];
#pragma unroll
    for (int d = 0; d < 4; ++d) kp[d] = lds + krow * 128 + (((2 * d + hi) ^ ksw) * 16);
#pragma unroll
    for (int ks = 0; ks < 4; ++ks) vp[ks] = lds + r32 * 128 + (((4 * (ks >> 1) + 2 * (ks & 1) + hi) ^ vsw) * 16);
    const int qpos = qw + r32;
    asm volatile("s_waitcnt vmcnt(0)" ::: "memory"); __builtin_amdgcn_s_barrier(); asm volatile("" ::: "memory");
    float kmx;
    { float kn2 = 0.f;
      if (w < NTW) { const LAS unsigned char* kr = lds + w * TSZ + lane * 128;
#pragma unroll
          for (int c = 0; c < 8; ++c) { const bf16x8 v = *(const LAS bf16x8*)(kr + c * 16);
#pragma unroll
              for (int jj = 0; jj < 8; ++jj) { const float x = __uint_as_float(((unsigned)(unsigned short)v[jj]) << 16); kn2 += x * x; } } }
#pragma unroll
      for (int off = 1; off < 64; off <<= 1) kn2 = fmaxf(kn2, __shfl_xor(kn2, off));
      volatile LAS float* ksc = (volatile LAS float*)(lds + MISC_OFF + 64);
      if (lane == 0) ksc[w] = kn2;
      LDS_WAIT(); __builtin_amdgcn_s_barrier(); asm volatile("" ::: "memory");
      kmx = ksc[0];
#pragma unroll
      for (int i = 1; i < 8; ++i) kmx = fmaxf(kmx, ksc[i]); }
#define FA_SB() __builtin_amdgcn_sched_barrier(0)
#define FA_EL(X0, X1, e) (((e) < 16) ? X0[(e) & 15] : X1[(e) & 15])
#define FA_SETEL(X0, X1, e, v) do { if ((e) < 16) X0[(e) & 15] = (v); else X1[(e) & 15] = (v); } while (0)
#define FA_NOFF(e) (32 * ((e) >> 4) + 16 * (((e) & 15) >> 3) + ((e) & 7))
#define FA_BIAS1(X0, X1, e) do { const float _x = t0n - (float)FA_NOFF(e); float _c = __builtin_fmaf(nslope, __builtin_fabsf(_x), negm); \
        _c = (__builtin_fabsf(_x) > 128.0f) ? -1.0e30f : _c; asm volatile("" : "+v"(_c)); FA_SETEL(X0, X1, e, _c); } while (0)
#define FW_BIAS(BM, SG, X0, X1, e) do { if ((BM) != 4) { float _c; \
        if ((BM) == 0 || (BM) == 2) { const float _x = t0n - (float)FA_NOFF(e); _c = __builtin_fmaf(nslope, __builtin_fabsf(_x), negm); \
            if ((BM) == 0) _c = (__builtin_fabsf(_x) > 128.0f) ? -1.0e30f : _c; } \
        else { _c = __builtin_fmaf(bd1, (float)FA_NOFF(e), bbase); \
            if ((BM) == 3) _c = (((SG) > 0) ? ((float)FA_NOFF(e) < blim) : ((float)FA_NOFF(e) > blim)) ? -1.0e30f : _c; } \
        asm volatile("" : "+v"(_c)); FA_SETEL(X0, X1, e, _c); } } while (0)
#define FA_T0(dst, t) do { float _t = (float)(qpos - 64 * (t) - 8 * hi); asm volatile("" : "+v"(_t)); dst = _t; } while (0)
#define FW_STEP(Y0, Y1, X0, X1, KOFF, VBOFF, TN, PV, BM, SG) do { \
        const LAS unsigned char* kq[4]; const LAS unsigned char* vq[4]; \
        _Pragma("unroll") for (int _d = 0; _d < 4; ++_d) { kq[_d] = kp[_d] + (KOFF); vq[_d] = vp[_d] + (VBOFF); } \
        _Pragma("unroll") for (int _j = 0; _j < 4; ++_j) kf[_j] = *(const LAS bf16x8*)(kq[_j >> 1] + (_j & 1) * 4096); \
        if (PV) { _Pragma("unroll") for (int _f = 0; _f < 8; ++_f) vf[_f] = *(const LAS bf16x8*)(vq[_f >> 1] + (_f & 1) * 4096); } \
        float t0n; FA_T0(t0n, TN); \
        float sacc = 0.f; FA_SB(); \
        _Pragma("unroll") for (int _j = 0; _j < 8; ++_j) { \
            if (_j & 1) Y1 = __builtin_amdgcn_mfma_f32_32x32x16_bf16(kf[_j & 3], qf[_j >> 1], Y1, 0, 0, 0); \
            else        Y0 = __builtin_amdgcn_mfma_f32_32x32x16_bf16(kf[_j & 3], qf[_j >> 1], Y0, 0, 0, 0); \
            if (_j < 4) kf[_j] = *(const LAS bf16x8*)(kq[(_j + 4) >> 1] + (_j & 1) * 4096); \
            { const float _a = FA_EL(X0, X1, 4 * _j), _b = FA_EL(X0, X1, 4 * _j + 1), _c = FA_EL(X0, X1, 4 * _j + 2), _d = FA_EL(X0, X1, 4 * _j + 3); \
              sacc += (_a + _b) + (_c + _d); asm volatile("" : "+v"(sacc)); pk[_j >> 1][2 * (_j & 1)] = cvt_pk_bf16(_a, _b); pk[_j >> 1][2 * (_j & 1) + 1] = cvt_pk_bf16(_c, _d); } \
            FA_SB(); } \
        l += sacc; \
        if (trk) { float _m; FA_ROWMAX(_m, Y0, Y1); resc = false; \
          if (__builtin_expect(__any(_m > THR), 0)) { const float _dl = fmaxf(_m, 0.f); mref += _dl; negm = -mref; fsave = __builtin_amdgcn_exp2f(-_dl); l *= fsave; resc = true; \
              _Pragma("unroll") for (int _r = 0; _r < 16; ++_r) { Y0[_r] -= _dl; Y1[_r] -= _dl; } } } \
        float bbase = 0.f, bd1 = 0.f, blim = 0.f; if ((BM) == 1 || (BM) == 3) { const float _sn = ((SG) > 0) ? nslope : -nslope; bbase = __builtin_fmaf(_sn, t0n, negm); bd1 = -_sn; blim = ((SG) > 0) ? t0n - 128.0f : t0n + 128.0f; } \
        FA_SB(); \
        _Pragma("unroll") for (int _i = 0; _i < NPV; ++_i) { \
            if (PV) o[_i & 1] = __builtin_amdgcn_mfma_f32_32x32x16_bf16(vf[_i], __builtin_bit_cast(bf16x8, pk[_i >> 1]), o[_i & 1], 0, 0, 0); \
            _Pragma("unroll") for (int _e = 0; _e < 4; ++_e) { const int _q = 4 * _i + _e; \
                { float _ev = __builtin_amdgcn_exp2f(FA_EL(Y0, Y1, _q)); asm volatile("" : "+v"(_ev)); FA_SETEL(Y0, Y1, _q, _ev); } FW_BIAS(BM, SG, X0, X1, _q); } \
            FA_SB(); } \
        if (trk && __builtin_expect(resc, 0)) { _Pragma("unroll") for (int _d = 0; _d < NDB; ++_d) _Pragma("unroll") for (int _r = 0; _r < 16; ++_r) o[_d][_r] *= fsave; } \
    } while (0)
    for (int hq = 0; hq < 4; ++hq) {
        const int hd = kvh * 4 + hq;
        const float slope2 = LOG2E * __builtin_amdgcn_exp2f(-0.5f * (float)(hd + 1)), nslope = -slope2;
        bf16x8 qf[4];
        { const bf16_t* qp = WSP(const bf16_t, WS_WAQ) + (size_t)(b * SEQ + qw + r32) * 1024 + hd * 64 + hi * 8;
#pragma unroll
          for (int d = 0; d < 4; ++d) qf[d] = *(const bf16x8*)(qp + d * 16); }
        bool trk;
        { float qs = 0.f;
#pragma unroll
          for (int d = 0; d < 4; ++d)
#pragma unroll
              for (int jj = 0; jj < 8; ++jj) { const float x = __uint_as_float(((unsigned)(unsigned short)qf[d][jj]) << 16); qs += x * x; }
          qs += __shfl_xor(qs, 32);
#pragma unroll
          for (int off = 1; off < 32; off <<= 1) qs = fmaxf(qs, __shfl_xor(qs, off));
          trk = __builtin_amdgcn_readfirstlane((int)(sqrtf(qs * kmx) < 100.0f)) == 0; }
        f32x16 o[NDB];
#pragma unroll
        for (int d = 0; d < NDB; ++d) o[d] = (f32x16){0.f, 0.f, 0.f, 0.f, 0.f, 0.f, 0.f, 0.f, 0.f, 0.f, 0.f, 0.f, 0.f, 0.f, 0.f, 0.f};
        f32x16 A0, A1, B0, B1; B0 = o[0]; B1 = o[0];
        float mref = 0.f, negm = 0.f, l = 0.f, fsave = 1.f; bool resc = false;
        u32x4 pk[4]; bf16x8 kf[4], vf[8];
        const int kb0 = (tw0 - tlo) * TSZ;
        if (regular) {
            { float t0n; FA_T0(t0n, tw0); const float bbase = __builtin_fmaf(nslope, t0n, negm), bd1 = -nslope, blim = t0n - 128.0f;
#pragma unroll
              for (int e = 0; e < 32; ++e) FW_BIAS(3, 1, A0, A1, e); }
            FW_STEP(A0, A1, B0, B1, kb0, kb0, tw0 + 1, false, 1, 1);
            FW_STEP(B0, B1, A0, A1, kb0 + TSZ, kb0 + VOFF, tw0 + 2, true, 2, 0);
            FW_STEP(A0, A1, B0, B1, kb0 + 2 * TSZ, kb0 + TSZ + VOFF, tw0 + 3, true, 1, -1);
            FW_STEP(B0, B1, A0, A1, kb0 + 3 * TSZ, kb0 + 2 * TSZ + VOFF, tw0 + 4, true, 3, -1);
            FW_STEP(A0, A1, B0, B1, kb0 + 4 * TSZ, kb0 + 3 * TSZ + VOFF, tw0 + 4, true, 4, 0);
        } else {
            { float t0n; FA_T0(t0n, tw0); const float bbase = 0.f, bd1 = 0.f, blim = 0.f;
#pragma unroll
              for (int e = 0; e < 32; ++e) FW_BIAS(0, 0, A0, A1, e); }
            FW_STEP(A0, A1, B0, B1, kb0, kb0, tw0 + 1, false, 0, 0);
            FW_STEP(B0, B1, A0, A1, kb0 + TSZ, kb0 + VOFF, tw0 + 2, true, 0, 0);
            FW_STEP(A0, A1, B0, B1, kb0 + 2 * TSZ, kb0 + TSZ + VOFF, tw0 + 3, true, 0, 0);
            FW_STEP(B0, B1, A0, A1, kb0 + 3 * TSZ, kb0 + 2 * TSZ + VOFF, tw0 + 4, true, 0, 0);
            FW_STEP(A0, A1, B0, B1, kb0 + 4 * TSZ, kb0 + 3 * TSZ + VOFF, tw0 + 4, true, 4, 0);
        }
        { float sacc = 0.f;
#pragma unroll
          for (int j = 0; j < 8; ++j) { const float a_ = FA_EL(A0, A1, 4 * j), b_ = FA_EL(A0, A1, 4 * j + 1), c_ = FA_EL(A0, A1, 4 * j + 2), d_ = FA_EL(A0, A1, 4 * j + 3);
              sacc += (a_ + b_) + (c_ + d_); pk[j >> 1][2 * (j & 1)] = cvt_pk_bf16(a_, b_); pk[j >> 1][2 * (j & 1) + 1] = cvt_pk_bf16(c_, d_); }
          l += sacc;
#pragma unroll
          for (int i = 0; i < NPV; ++i) { const int ks = i >> 1, d = i & 1;
              const bf16x8 v = *(const LAS bf16x8*)(vp[ks] + kb0 + 4 * TSZ + VOFF + d * 4096);
              o[d] = __builtin_amdgcn_mfma_f32_32x32x16_bf16(v, __builtin_bit_cast(bf16x8, pk[ks]), o[d], 0, 0, 0); } }
        l += __shfl_xor(l, 32);
        { const float sink2 = P.wa_sink[hd] * LOG2E;
          const float il = 1.0f / (l + __builtin_amdgcn_exp2f(sink2 - mref));
          bf16_t* op = WSP(bf16_t, WS_WAQ) + (size_t)(b * SEQ + qw + r32) * 1024 + hd * 64;
#pragma unroll
          for (int d = 0; d < 2; ++d)
#pragma unroll
              for (int gp = 0; gp < 2; ++gp) { u32x2 pw[2];
#pragma unroll
                  for (int gg = 0; gg < 2; ++gg) { const int g = 2 * gp + gg; pw[gg].x = cvt_pk_bf16(o[d][4 * g] * il, o[d][4 * g + 1] * il); pw[gg].y = cvt_pk_bf16(o[d][4 * g + 2] * il, o[d][4 * g + 3] * il); }
                  const unsigned sx = hi ? pw[0].x : pw[1].x, sy = hi ? pw[0].y : pw[1].y;
                  const unsigned rx = (unsigned)__shfl_xor((int)sx, 32), ry = (unsigned)__shfl_xor((int)sy, 32);
                  u32x4 wv; if (hi) { wv.x = rx; wv.y = ry; wv.z = pw[1].x; wv.w = pw[1].y; } else { wv.x = pw[0].x; wv.y = pw[0].y; wv.z = rx; wv.w = ry; }
                  *(u32x4*)(op + d * 32 + 16 * gp + 8 * hi) = wv; } }
    }
    asm volatile("s_waitcnt vmcnt(0) lgkmcnt(0)" ::: "memory"); __builtin_amdgcn_s_barrier(); asm volatile("" ::: "memory");
#undef FW_STEP
#undef FW_BIAS
#undef FA_EL
#undef FA_SETEL
#undef FA_NOFF
#undef FA_BIAS1
#undef FA_T0
#undef FA_SB
}
}

struct Frame { LAS unsigned char* lds; int tid, lane, wave, vcu, G; };

__device__ __forceinline__ void transpose_item(const float* W, int K, int N, bf16_t* WT, int k0, int n0, int drow0, LAS float* scr, int lane) {
#pragma unroll 8
    for (int i = 0; i < 32; ++i) { const int kk = 2 * i + (lane >> 5); scr[kk * 33 + (lane & 31)] = W[(size_t)(k0 + kk) * N + n0 + (lane & 31)]; }
    LDS_WAIT(); asm volatile("" ::: "memory");
    const int c = lane & 7;
#pragma unroll
    for (int j = 0; j < 4; ++j) { const int n = (lane >> 3) + 8 * j; const LAS float* s = scr + (8 * c) * 33 + n;
        u32x4 o; o.x = cvt_pk_bf16(s[0 * 33], s[1 * 33]); o.y = cvt_pk_bf16(s[2 * 33], s[3 * 33]); o.z = cvt_pk_bf16(s[4 * 33], s[5 * 33]); o.w = cvt_pk_bf16(s[6 * 33], s[7 * 33]);
        *(u32x4*)(WT + (size_t)(drow0 + n) * K + k0 + 8 * c) = o; }
    LDS_WAIT(); asm volatile("" ::: "memory");
}
__device__ __forceinline__ void transpose_item_fp8(const float* W, int K, int N, unsigned char* WT, int k0, int n0, int drow0, float sc, LAS float* scr, int lane) {
    { float tv[32]; const float* wp = W + (size_t)(k0 + (lane >> 5)) * N + n0 + (lane & 31);
#pragma unroll
      for (int i = 0; i < 32; ++i) tv[i] = wp[(size_t)(2 * i) * N];
#pragma unroll
      for (int i = 0; i < 32; ++i) { const int kk = 2 * i + (lane >> 5); scr[kk * 33 + (lane & 31)] = tv[i]; } }
    LDS_WAIT(); asm volatile("" ::: "memory");
    const int c = lane & 7;
#pragma unroll
    for (int j = 0; j < 4; ++j) { const int n = (lane >> 3) + 8 * j; const LAS float* q = scr + (8 * c) * 33 + n;
        u32x2 o; o.x = pk4_fp8(q[0 * 33] * sc, q[1 * 33] * sc, q[2 * 33] * sc, q[3 * 33] * sc); o.y = pk4_fp8(q[4 * 33] * sc, q[5 * 33] * sc, q[6 * 33] * sc, q[7 * 33] * sc);
        *(u32x2*)(WT + (size_t)(drow0 + n) * K + k0 + 8 * c) = o; }
    LDS_WAIT(); asm volatile("" ::: "memory");
}
__device__ __forceinline__ int win_dst_row(int n) {
    if (n < 1024) return R_DAQ + n; if (n < 2048) return R_DAK + (n - 1024); if (n < 3072) return R_DAV + (n - 2048); if (n < 4096) return R_WAQ + (n - 3072);
    if (n < 4352) return R_WAK + (n - 4096); if (n < 4608) return R_WAV + (n - 4352); if (n < 5632) return R_XAQ + (n - 4608); return R_GATE + (n - 5632);
}
__device__ __forceinline__ void rms_row_to_bf16(const float* xrow, const float* g, bf16_t* orow, int lane, unsigned* orow8 = nullptr) {
    const f32x4* xr = (const f32x4*)xrow + lane; const f32x4* gr = (const f32x4*)g + lane;
    f32x4 v[4]; float s = 0.f;
#pragma unroll
    for (int j = 0; j < 4; ++j) { v[j] = xr[64 * j]; s += (v[j][0] * v[j][0] + v[j][1] * v[j][1]) + (v[j][2] * v[j][2] + v[j][3] * v[j][3]); }
    const float rstd = 1.0f / sqrtf(wave_sum(s) * (1.0f / 1024.0f) + EPS);
    u32x2* o8 = (u32x2*)orow + lane;
#pragma unroll
    for (int j = 0; j < 4; ++j) { const f32x4 gg = gr[64 * j]; u32x2 wv; wv.x = cvt_pk_bf16(v[j][0] * rstd * gg[0], v[j][1] * rstd * gg[1]); wv.y = cvt_pk_bf16(v[j][2] * rstd * gg[2], v[j][3] * rstd * gg[3]); if (orow) o8[64 * j] = wv;
        if (orow8) orow8[lane + 64 * j] = pk4_fp8(v[j][0] * rstd * gg[0], v[j][1] * rstd * gg[1], v[j][2] * rstd * gg[2], v[j][3] * rstd * gg[3]); }
}
template <int NR>
__device__ __forceinline__ void rms_rows(const float* x0, const float* g, bf16_t* o0, unsigned* o80, int lane) {
    const f32x4* gr = (const f32x4*)g + lane;
    f32x4 v[NR][4]; float rstd[NR];
#pragma unroll
    for (int r = 0; r < NR; ++r) { const f32x4* xr = (const f32x4*)(x0 + (size_t)r * 1024) + lane;
#pragma unroll
        for (int j = 0; j < 4; ++j) v[r][j] = xr[64 * j]; }
#pragma unroll
    for (int r = 0; r < NR; ++r) { float s = 0.f;
#pragma unroll
        for (int j = 0; j < 4; ++j) s += (v[r][j][0] * v[r][j][0] + v[r][j][1] * v[r][j][1]) + (v[r][j][2] * v[r][j][2] + v[r][j][3] * v[r][j][3]);
        rstd[r] = 1.0f / sqrtf(wave_sum(s) * (1.0f / 1024.0f) + EPS); }
#pragma unroll
    for (int j = 0; j < 4; ++j) { const f32x4 gg = gr[64 * j];
#pragma unroll
        for (int r = 0; r < NR; ++r) { const float a = v[r][j][0] * rstd[r] * gg[0], b = v[r][j][1] * rstd[r] * gg[1], c = v[r][j][2] * rstd[r] * gg[2], d = v[r][j][3] * rstd[r] * gg[3];
            if (o0) { u32x2 wv; wv.x = cvt_pk_bf16(a, b); wv.y = cvt_pk_bf16(c, d); ((u32x2*)(o0 + (size_t)r * 1024))[lane + 64 * j] = wv; }
            if (o80) o80[(size_t)r * 256 + lane + 64 * j] = pk4_fp8(a, b, c, d); } }
}
__device__ __forceinline__ void phase_prologue(Frame& F, const Ptrs& P) {
    LAS float* scr = (LAS float*)(F.lds + F.wave * 16384);
    const int gw = F.vcu * 8 + F.wave, NGW = F.G * 8;
    constexpr int I_IN = 16 * 272, I_KV = 16 * 64, I_SQ = 16 * 32;
    constexpr int NIT = I_IN + I_KV + 4 * I_SQ;
    for (int it = gw; it < NIT; it += NGW) {
        int r = it;
        if (r < I_IN) { const int kb = r / 272, nb = r % 272;
            if (WA_FP8 && 32 * nb >= 3072 && 32 * nb < 4608) transpose_item_fp8(P.w_in, 1024, INW, WSP(unsigned char, WS_WWA8), 64 * kb, 32 * nb, 32 * nb - 3072, W8_SCALE, scr, F.lane);
            else if (XA_FP8 && 32 * nb >= 4608 && 32 * nb < 5632) transpose_item_fp8(P.w_in, 1024, INW, WSP(unsigned char, WS_WXQ8), 64 * kb, 32 * nb, 32 * nb - 4608, W8_SCALE, scr, F.lane);
            else if (INPROJ_FP8) transpose_item_fp8(P.w_in, 1024, INW, WSP(unsigned char, WS_WIN), 64 * kb, 32 * nb, win_dst_row(32 * nb), W8_SCALE, scr, F.lane);
            else if (GATES_FP8 && 32 * nb >= 5632) transpose_item_fp8(P.w_in, 1024, INW, WSP(unsigned char, WS_WG8), 64 * kb, 32 * nb, 32 * nb - 5632, W8_SCALE, scr, F.lane);
            else transpose_item(P.w_in, 1024, INW, WSP(bf16_t, WS_WIN), 64 * kb, 32 * nb, win_dst_row(32 * nb), scr, F.lane);
            continue; } r -= I_IN;
        if (r < I_KV) { const int kb = r / 64, nb = r % 64;
            if (XA_FP8) transpose_item_fp8(P.w_mkv, 1024, 2048, WSP(unsigned char, WS_WMKV8), 64 * kb, 32 * nb, 32 * nb, W8_SCALE, scr, F.lane);
            else if (INPROJ_FP8) transpose_item_fp8(P.w_mkv, 1024, 2048, WSP(unsigned char, WS_WMKV), 64 * kb, 32 * nb, 32 * nb, W8_SCALE, scr, F.lane);
            else transpose_item(P.w_mkv, 1024, 2048, WSP(bf16_t, WS_WMKV), 64 * kb, 32 * nb, 32 * nb, scr, F.lane);
            continue; } r -= I_KV;
        const int which = r / I_SQ; r -= which * I_SQ; const int kb = r / 32, nb = r % 32;
        const float* src = which == 0 ? P.w_da_o : which == 1 ? P.w_wa_o : which == 2 ? P.w_xa_o : P.w_out;
        bf16_t* dst = which == 0 ? WSP(bf16_t, WS_WDAO) : which == 1 ? WSP(bf16_t, WS_WWAO) : which == 2 ? WSP(bf16_t, WS_WXAO) : WSP(bf16_t, WS_WOUT);
        if (XS_FP8 && which == 2) transpose_item_fp8(src, 1024, 1024, (unsigned char*)dst, 64 * kb, 32 * nb, 32 * nb, W8_SCALE, scr, F.lane);
        else transpose_item(src, 1024, 1024, dst, 64 * kb, 32 * nb, 32 * nb, scr, F.lane);
    }
    for (int m = 2 * gw; m < MTOK; m += 2 * NGW) rms_rows<2>(P.x + (size_t)m * 1024, P.attn_g, INPROJ_FP8 ? nullptr : WSP(bf16_t, WS_H) + (size_t)m * 1024, GATES_FP8 ? (unsigned*)((char*)P.out + 128 * MiB) + (size_t)m * 256 : nullptr, F.lane);
    for (int m = gw; m < MMEM; m += NGW) rms_row_to_bf16(P.mem + (size_t)m * 1024, P.mem_g, (INPROJ_FP8 || XA_FP8) ? nullptr : WSP(bf16_t, WS_MN) + (size_t)m * 1024, F.lane, XA_FP8 ? WSP(unsigned, WS_MN8) + (size_t)m * 256 : INPROJ_FP8 ? WSP(unsigned, WS_MN) + (size_t)m * 256 : nullptr);
    { u32x4* inv = WSP(u32x4, WS_INV); const int n16 = MTOK * 16 * 2 / 16;
      for (int i = F.vcu * 512 + F.tid; i < n16; i += F.G * 512) inv[i] = (u32x4){0xffffffffu, 0xffffffffu, 0xffffffffu, 0xffffffffu}; }
}

__device__ __forceinline__ void convert_expert_weights(Frame& F, const Ptrs& P, LAS float* scr);
__device__ __forceinline__ void phase_norm_router(Frame& F, const Ptrs& P) {
    LAS float* wl = (LAS float*)F.lds;
    LAS float* gl = wl + 64 * 260;
    for (int i = F.tid; i < 1024 * 16; i += 512) { const int k = i >> 4, e = i & 15; wl[(((k >> 4) & 3) * 16 + e) * 260 + (k >> 6) * 16 + (k & 15)] = P.w_router[i] * P.ffn_g[k]; }
    for (int i = F.tid; i < 1024; i += 512) gl[i] = P.ffn_g[i];
    __syncthreads();
    const int lane = F.lane, t = lane & 15, kq = lane >> 4;
    const LAS float* wrow = wl + (kq * 16 + t) * 260;
    const LAS float* grow = gl + kq * 16;
    LAS float* cscr = (LAS float*)(F.lds + 70656 + F.wave * 8448);
    static_assert(70656 + 8 * 8448 <= MISC_OFF, "conversion tiles overlap the barrier words");
    if (F.wave & 1) convert_expert_weights(F, P, cscr);
    for (int g = F.vcu * 8 + F.wave; g < MTOK / 16; g += F.G * 8) {
        const int m0 = 16 * g;
        const u32x4* xr = (const u32x4*)(WSP(const unsigned char, WS_X1) + (size_t)(m0 + t) * 2048 + kq * 32);
        u32x4 xp[32];
#pragma unroll
        for (int J = 0; J < 16; ++J) { xp[2 * J] = xr[8 * J]; xp[2 * J + 1] = xr[8 * J + 1]; }
        f32x4 a0 = (f32x4){0.f, 0.f, 0.f, 0.f}, a1 = a0; float ss = 0.f;
        f32x4 w0 = *(const LAS f32x4*)(wrow), w1 = *(const LAS f32x4*)(wrow + 4);
#pragma unroll
        for (int j = 0; j < 32; ++j) {
            asm volatile("" ::: "memory");
            const f32x4 w0n = *(const LAS f32x4*)(wrow + 8 * ((j + 1) & 31)), w1n = *(const LAS f32x4*)(wrow + 8 * ((j + 1) & 31) + 4);
            asm volatile("" : "+v"(xp[j]));
            const u32x4 d = xp[j];
            const float x0 = bf_lo(d.x), x1 = bf_hi(d.x), x2 = bf_lo(d.y), x3 = bf_hi(d.y), x4 = bf_lo(d.z), x5 = bf_hi(d.z), x6 = bf_lo(d.w), x7 = bf_hi(d.w);
            a0 = __builtin_amdgcn_mfma_f32_16x16x4f32(w0[0], x0, a0, 0, 0, 0); a1 = __builtin_amdgcn_mfma_f32_16x16x4f32(w0[1], x1, a1, 0, 0, 0);
            a0 = __builtin_amdgcn_mfma_f32_16x16x4f32(w0[2], x2, a0, 0, 0, 0); a1 = __builtin_amdgcn_mfma_f32_16x16x4f32(w0[3], x3, a1, 0, 0, 0);
            a0 = __builtin_amdgcn_mfma_f32_16x16x4f32(w1[0], x4, a0, 0, 0, 0); a1 = __builtin_amdgcn_mfma_f32_16x16x4f32(w1[1], x5, a1, 0, 0, 0);
            a0 = __builtin_amdgcn_mfma_f32_16x16x4f32(w1[2], x6, a0, 0, 0, 0); a1 = __builtin_amdgcn_mfma_f32_16x16x4f32(w1[3], x7, a1, 0, 0, 0);
            ss += ((x0 * x0 + x1 * x1) + (x2 * x2 + x3 * x3)) + ((x4 * x4 + x5 * x5) + (x6 * x6 + x7 * x7));
            w0 = w0n; w1 = w1n; __builtin_amdgcn_sched_barrier(0); }
        ss += __shfl_xor(ss, 16); ss += __shfl_xor(ss, 32);
        const float rstd = 1.0f / sqrtf(ss * (1.0f / 1024.0f) + EPS);
        const f32x4 lg = (a0 + a1) * rstd;
        float mx = fmaxf(fmaxf(lg[0], lg[1]), fmaxf(lg[2], lg[3])); mx = fmaxf(mx, __shfl_xor(mx, 16)); mx = fmaxf(mx, __shfl_xor(mx, 32));
        f32x4 ex; ex[0] = __expf(lg[0] - mx); ex[1] = __expf(lg[1] - mx); ex[2] = __expf(lg[2] - mx); ex[3] = __expf(lg[3] - mx);
        float den = (ex[0] + ex[1]) + (ex[2] + ex[3]); den += __shfl_xor(den, 16); den += __shfl_xor(den, 32);
        *(f32x4*)(WSP(float, WS_AFF) + (size_t)(m0 + t) * 16 + 4 * kq) = ex / den;
        unsigned char* hrow = WSP(unsigned char, WS_H2) + (size_t)(m0 + t) * 1024 + kq * 16;
#pragma unroll
        for (int J = 0; J < 16; ++J) { u32x4 o;
#pragma unroll
            for (int h = 0; h < 2; ++h) { asm volatile("" : "+v"(xp[2 * J + h]) :: "memory"); const u32x4 d = xp[2 * J + h];
                const f32x4 g0 = *(const LAS f32x4*)(grow + 64 * J + 8 * h), g1 = *(const LAS f32x4*)(grow + 64 * J + 8 * h + 4);
                const unsigned lo = pk4_fp8(bf_lo(d.x) * rstd * g0[0], bf_hi(d.x) * rstd * g0[1], bf_lo(d.y) * rstd * g0[2], bf_hi(d.y) * rstd * g0[3]);
                const unsigned hi = pk4_fp8(bf_lo(d.z) * rstd * g1[0], bf_hi(d.z) * rstd * g1[1], bf_lo(d.w) * rstd * g1[2], bf_hi(d.w) * rstd * g1[3]);
                if (h == 0) { o.x = lo; o.y = hi; } else { o.z = lo; o.w = hi; } }
            *(u32x4*)(hrow + 64 * J) = o; __builtin_amdgcn_sched_barrier(0); }
    }
    if (!(F.wave & 1)) convert_expert_weights(F, P, cscr);
}

__device__ __forceinline__ void convert_expert_weights(Frame& F, const Ptrs& P, LAS float* scr) {
    {
        const int gw = F.vcu * 8 + F.wave, NGW = F.G * 8;
        for (int it = gw; it < 3 * 16 * 1024; it += NGW) {
            const int mat = it >> 14, r = it & 16383, e = r >> 10, q = r & 1023;
            if (mat < 2) { const int kb = q >> 6, nb = q & 63, n0 = 32 * nb;
                transpose_item_fp8((mat == 0 ? P.w_eg : P.w_eu) + (size_t)e * 1024 * 2048, 1024, 2048, WSP(unsigned char, WS_WGU) + (size_t)e * 4096 * 1024, 64 * kb, n0, (n0 >> 7) * 256 + mat * 128 + (n0 & 127), W8_SCALE, scr, F.lane); }
            else { const int kb = q >> 5, nb = q & 31;
                transpose_item_fp8(P.w_ed + (size_t)e * 2048 * 1024, 2048, 1024, WSP(unsigned char, WS_WD) + (size_t)e * 1024 * 2048, 64 * kb, 32 * nb, 32 * nb, W8_SCALE, scr, F.lane); }
        }
    }
}
__device__ __forceinline__ void phase_topk_convert(Frame& F, const Ptrs& P) {
    LAS float* vals = (LAS float*)F.lds;
    LAS unsigned* hist = (LAS unsigned*)(F.lds + 8192);
    LAS unsigned* ctl = hist + 256;
    for (int task = F.vcu; task < NB * NEXP; task += F.G) {
        const int b = task >> 4, e = task & 15;
        __syncthreads();
        float v[4]; unsigned u[4];
#pragma unroll
        for (int j = 0; j < 4; ++j) { const int t = F.tid + 512 * j; v[j] = WSP(const float, WS_AFF)[(size_t)(b * SEQ + t) * 16 + e]; vals[t] = v[j]; u[j] = __float_as_uint(v[j]); }
        unsigned prefix = 0u, need = (unsigned)CAP;
        for (int pass = 0; pass < 4; ++pass) {
            const int shift = 24 - 8 * pass;
            if (F.tid < 256) hist[F.tid] = 0u;
            if (F.tid == 0) { ctl[2] = 0u; ctl[4] = 0u; }
            __syncthreads();
#pragma unroll
            for (int j = 0; j < 4; ++j) if (pass == 0 || (u[j] >> (shift + 8)) == prefix) __hip_atomic_fetch_add(&hist[(u[j] >> shift) & 255u], 1u, __ATOMIC_RELAXED, __HIP_MEMORY_SCOPE_WORKGROUP);
            __syncthreads();
            if (F.wave == 0) {
                const u32x4 h4 = *(const LAS u32x4*)(hist + 4 * F.lane);
                const unsigned sl = (h4.x + h4.y) + (h4.z + h4.w);
                unsigned S = sl;
#pragma unroll
                for (int off = 1; off < 64; off <<= 1) { const unsigned t = __shfl_down(S, off); S += (F.lane + off < 64) ? t : 0u; }
                const unsigned long long mk = __ballot(S >= need);
                const int L = 63 - __builtin_clzll(mk);
                if (F.lane == L) { unsigned c = S - sl; int d = 4 * L; unsigned bc = 0u;
                    if (c + h4.w >= need) { d = 4 * L + 3; bc = h4.w; } else { c += h4.w;
                    if (c + h4.z >= need) { d = 4 * L + 2; bc = h4.z; } else { c += h4.z;
                    if (c + h4.y >= need) { d = 4 * L + 1; bc = h4.y; } else { c += h4.y; d = 4 * L; bc = h4.x; } } }
                    ctl[0] = (prefix << 8) | (unsigned)d; ctl[1] = need - c; ctl[3] = bc; }
            }
            __syncthreads();
            prefix = ctl[0]; need = ctl[1];
        }
        const unsigned T = prefix, cnt_eq = ctl[3], ngt = (unsigned)CAP - need;
#pragma unroll
        for (int j = 0; j < 4; ++j) { const int t = F.tid + 512 * j; int slot = -1;
            if (u[j] > T) slot = (int)__hip_atomic_fetch_add(&ctl[2], 1u, __ATOMIC_RELAXED, __HIP_MEMORY_SCOPE_WORKGROUP);
            else if (u[j] == T) {
                if (cnt_eq == need) slot = (int)(ngt + __hip_atomic_fetch_add(&ctl[4], 1u, __ATOMIC_RELAXED, __HIP_MEMORY_SCOPE_WORKGROUP));
                else { unsigned eq = 0u; for (int i = 0; i < t; ++i) eq += (vals[i] == v[j]) ? 1u : 0u; if (eq < need) slot = (int)(ngt + eq); } }
            if (slot >= 0) {
                WSP(int, WS_IDX)[(b * 16 + e) * 256 + slot] = b * SEQ + t;
                WSP(float, WS_GL)[(b * 16 + e) * 256 + slot] = v[j];
                WSP(short, WS_INV)[(size_t)(b * SEQ + t) * 16 + e] = (short)slot; } }
    }
}

__device__ __forceinline__ void phase_final(Frame& F, const Ptrs& P) {
    constexpr int FR = 4;
    const int gw = F.vcu * 8 + F.wave, NGW = F.G * 8, lane = F.lane;
    const short* INV = WSP(const short, WS_INV); const float* GLp = WSP(const float, WS_GL); const unsigned* YEp = WSP(const unsigned, WS_YE);
    f32x4 gg[4];
#pragma unroll
    for (int j = 0; j < 4; ++j) gg[j] = ((const f32x4*)P.final_g)[lane + 64 * j];
    for (int m0 = gw; m0 < MTOK; m0 += FR * NGW) {
        int sl[FR]; u32x2 xq[FR][4]; unsigned yq[FR][4][4]; float glv[FR]; int ek[FR][4]; unsigned rest[FR];
#pragma unroll
        for (int r = 0; r < FR; ++r) { const int m = m0 + r * NGW; sl[r] = (m < MTOK && lane < 16) ? (int)INV[(size_t)m * 16 + lane] : -1; }
#pragma unroll
        for (int r = 0; r < FR; ++r) { const int m = m0 + r * NGW; if (m < MTOK) { const u32x2* xr = WSP(const u32x2, WS_X1) + (size_t)m * 256 + lane;
#pragma unroll
            for (int j = 0; j < 4; ++j) xq[r][j] = xr[64 * j]; } }
#pragma unroll
        for (int r = 0; r < FR; ++r) { const int m = m0 + r * NGW, b = m >> 11;
            unsigned mk = (unsigned)__ballot(sl[r] >= 0) & 0xffffu;
            glv[r] = (sl[r] >= 0) ? GLp[(b * 16 + lane) * 256 + sl[r]] : 0.f;
#pragma unroll
            for (int k = 0; k < 4; ++k) { ek[r][k] = mk ? (int)__builtin_ctz(mk) : -1; mk &= mk - 1u;
                if (ek[r][k] >= 0) { const int s_ = __builtin_amdgcn_readlane(sl[r], ek[r][k]); const unsigned* yr = YEp + (size_t)((ek[r][k] * 32 + b) * 256 + s_) * 256 + lane;
#pragma unroll
                    for (int j = 0; j < 4; ++j) yq[r][k][j] = yr[64 * j]; } }
            rest[r] = mk; }
#pragma unroll
        for (int r = 0; r < FR; ++r) { const int m = m0 + r * NGW, b = m >> 11; if (m >= MTOK) break;
            f32x4 v[4];
#pragma unroll
            for (int j = 0; j < 4; ++j) v[j] = (f32x4){bf_lo(xq[r][j].x), bf_hi(xq[r][j].x), bf_lo(xq[r][j].y), bf_hi(xq[r][j].y)};
#pragma unroll
            for (int k = 0; k < 4; ++k) if (ek[r][k] >= 0) { const float g = __uint_as_float((unsigned)__builtin_amdgcn_readlane((int)__float_as_uint(glv[r]), ek[r][k])) * (1.0f / YE8_SCALE);
#pragma unroll
                for (int j = 0; j < 4; ++j) { const int y = (int)yq[r][k][j]; const f32x2 lo = __builtin_amdgcn_cvt_pk_f32_fp8(y, false), hi2 = __builtin_amdgcn_cvt_pk_f32_fp8(y, true);
                    v[j][0] += g * lo[0]; v[j][1] += g * lo[1]; v[j][2] += g * hi2[0]; v[j][3] += g * hi2[1]; } }
            unsigned rs_ = rest[r];
            while (rs_) { const int e = (int)__builtin_ctz(rs_); rs_ &= rs_ - 1u;
                const int s2 = __builtin_amdgcn_readlane(sl[r], e); const float g = __uint_as_float((unsigned)__builtin_amdgcn_readlane((int)__float_as_uint(glv[r]), e)) * (1.0f / YE8_SCALE);
                const unsigned* yr = YEp + (size_t)((e * 32 + b) * 256 + s2) * 256 + lane;
#pragma unroll
                for (int j = 0; j < 4; ++j) { const int y = (int)yr[64 * j]; const f32x2 lo = __builtin_amdgcn_cvt_pk_f32_fp8(y, false), hi2 = __builtin_amdgcn_cvt_pk_f32_fp8(y, true);
                    v[j][0] += g * lo[0]; v[j][1] += g * lo[1]; v[j][2] += g * hi2[0]; v[j][3] += g * hi2[1]; } }
            float s = 0.f;
#pragma unroll
            for (int j = 0; j < 4; ++j) s += (v[j][0] * v[j][0] + v[j][1] * v[j][1]) + (v[j][2] * v[j][2] + v[j][3] * v[j][3]);
            const float rstd = 1.0f / sqrtf(wave_sum(s) * (1.0f / 1024.0f) + EPS);
            f32x4* orow = (f32x4*)(P.out + (size_t)m * 1024) + lane;
#pragma unroll
            for (int j = 0; j < 4; ++j) { f32x4 o; o[0] = v[j][0] * rstd * gg[j][0]; o[1] = v[j][1] * rstd * gg[j][1]; o[2] = v[j][2] * rstd * gg[j][2]; o[3] = v[j][3] * rstd * gg[j][3]; orow[64 * j] = o; } }
    }
}

constexpr int N_PHASES = 10;
struct Args { Ptrs P; int ph_lo, ph_hi; };
__global__ void __launch_bounds__(512, 2) fwd(Args args) {
    extern __shared__ __attribute__((aligned(16))) unsigned char lds_raw[];
    LAS unsigned char* lds = (LAS unsigned char*)lds_raw;
    const Ptrs& P = args.P;
    Frame F; F.lds = lds; F.tid = threadIdx.x; F.lane = F.tid & 63; F.wave = __builtin_amdgcn_readfirstlane(F.tid >> 6);
    F.G = gridDim.x; { const int bx = blockIdx.x; F.vcu = (F.G % 8 == 0) ? (bx % 8) * (F.G / 8) + bx / 8 : bx; }
    volatile LAS unsigned* MISC = (volatile LAS unsigned*)(lds + MISC_OFF);
    if (F.tid < 64) MISC[F.tid] = 0u;
    __syncthreads();
    XcdBarrier bar; bar.bar = WSP(unsigned, WS_CTL) + 1024; bar.x = 0; bar.st = nullptr;
    if (MK_N_LAUNCHES == 1) bar = xcd_barrier_post(WSP(unsigned, WS_CTL) + 1024, MISC + 8);
    const int lo = args.ph_lo, hi = args.ph_hi;
#ifndef PHMASK
#define PHMASK 0x3ff
#endif
#define IN(k) (((PHMASK >> (k)) & 1) && lo <= (k) && (k) < hi)
#define SEAM(k) do { if (IN(k) && IN((k) + 1)) xcd_barrier(bar); } while (0)

    if (IN(0)) { phase_prologue(F, P); } SEAM(0);
    if (IN(1)) { JobP1 J{P, F.G, (int)blockIdx.x, INPROJ_FP8 ? 512 : 1024, INPROJ_FP8 ? 512 : 1024, INPROJ_FP8 ? 512 : 1024, (LAS float*)(lds + EPI_OFF)}; pg::gemm_phase<JobP1, true, false, INPROJ_FP8 != 0>(lds, J);
        if (XA_FP8) { JobP1x Jx{P, F.G, (int)blockIdx.x, 512, 512, 512}; pg::gemm_phase<JobP1x, true, false, true>(lds, Jx); } } SEAM(1);
    if (IN(2)) {
        for (int i = 0; i < 4; ++i) { const int u_ = i * F.G + F.vcu; fa::wa_group(lds, P, u_ >> 5, (u_ >> 3) & 3, u_ & 7); }
        { JobXA J{P, F.G, (int)blockIdx.x, XS_FP8 ? 128 : 256, XS_FP8 ? 512 : 1024, XS_FP8 ? 512 : 1024, (LAS float*)(lds + EPI_OFF)}; pg::gemm_phase<JobXA, true, false, XS_FP8 != 0>(lds, J); }
        { JobMVW J{P, F.G, (int)blockIdx.x, XS_FP8 ? 128 : 256, XS_FP8 ? 512 : 1024, XS_FP8 ? 512 : 1024}; pg::gemm_phase<JobMVW, true, false, XS_FP8 != 0>(lds, J); }
        { float lam;
          { const float a = P.lq1[F.lane] * P.lk1[F.lane], b2 = P.lq2[F.lane] * P.lk2[F.lane];
            lam = __expf(wave_sum(a)) - __expf(wave_sum(b2)) + LAM_INIT; }
          const int g_ = F.vcu >> 4, qb0 = F.vcu & 15;
          for (int i = 0; i < 16; ++i) { const int ih = i & 7, ib = i >> 3; fa::flash_unit<0>(lds, P, 2 * g_ + ib, (ih + g_) & 7, (qb0 + 3 * ih + 8 * ib) & 15, lam); } }
    } SEAM(2);
    if (IN(3)) {
        { JobMergeG J{P, F.G, (int)blockIdx.x, GATES_FP8 ? 512 : 1024, GATES_FP8 ? 512 : 1024, GATES_FP8 ? 512 : 1024}; pg::gemm_phase<JobMergeG, true, false, GATES_FP8 != 0>(lds, J); }
        if (YC_FP8) { { JobMergeY J{P, F.G, (int)blockIdx.x, 1024, 1024, 1024, 1}; pg::gemm_phase<JobMergeY, true, false>(lds, J); }
                      { JobMergeY J{P, F.G, (int)blockIdx.x, 512, 512, 512, 2}; pg::gemm_phase<JobMergeY, true, false, true>(lds, J); } }
        else { JobMergeY J{P, F.G, (int)blockIdx.x, 1024, 1024, 1024, 0}; pg::gemm_phase<JobMergeY, true, false>(lds, J); }
    } SEAM(3);
    if (IN(4)) { JobOut J{P, F.G, (int)blockIdx.x, 1024, 1024, 1024}; pg::gemm_phase<JobOut, true, false>(lds, J); } SEAM(4);
    if (IN(5)) { phase_norm_router(F, P); } SEAM(5);
    if (IN(6)) { phase_topk_convert(F, P); } SEAM(6);
    if (IN(7)) { JobGU J{P, F.G, (int)blockIdx.x, 512, 512, 512}; pg::gemm_phase<JobGU, true, true, true>(lds, J); } SEAM(7);
    if (IN(8)) { JobDown J{P, F.G, (int)blockIdx.x, 1024, 1024, 1024}; pg::gemm_phase<JobDown, true, false, true>(lds, J); } SEAM(8);
    if (IN(9)) { phase_final(F, P); }
#undef IN
#undef SEAM
}

extern "C" void kernel_launch(void* const* d_in, const int* in_sizes, int n_in, void* d_out, int out_size, void* d_ws, size_t ws_size, hipStream_t stream) {
    static int grid = 0;
    if (grid == 0) {
        if (n_in != 22 || in_sizes[0] != MTOK * DM || out_size != MTOK * DM || ws_size < WS_END) {
            fprintf(stderr, "kernel_launch: unexpected shapes (n_in %d, in0 %d, out %d, ws %zu)\n", n_in, n_in > 0 ? in_sizes[0] : -1, out_size, ws_size); grid = -1; return; }
        int dev = 0, cus = 0;
        if (hipGetDevice(&dev) != hipSuccess || hipDeviceGetAttribute(&cus, hipDeviceAttributeMultiprocessorCount, dev) != hipSuccess) { grid = -1; return; }
        if (hipFuncSetAttribute((const void*)fwd, hipFuncAttributeMaxDynamicSharedMemorySize, LDS_BYTES) != hipSuccess) { fprintf(stderr, "kernel_launch: hipFuncSetAttribute failed\n"); grid = -1; return; }
        int per_cu = 0;
        if (hipOccupancyMaxActiveBlocksPerMultiprocessor(&per_cu, (const void*)fwd, 512, LDS_BYTES) != hipSuccess || per_cu < 1) fprintf(stderr, "kernel_launch: occupancy query says %d\n", per_cu);
        (void)hipGetLastError();
        grid = cus;
        if (grid != 256) fprintf(stderr, "kernel_launch: %d CUs (built for 256)\n", grid);
    }
    if (grid < 0) return;
    (void)hipMemsetAsync((char*)d_ws + WS_CTL, 0, CTL_ZERO_BYTES, stream);
    Args a{};
    Ptrs& P = a.P;
    P.x = (const float*)d_in[0]; P.mem = (const float*)d_in[1]; P.attn_g = (const float*)d_in[2]; P.mem_g = (const float*)d_in[3]; P.w_in = (const float*)d_in[4]; P.w_mkv = (const float*)d_in[5];
    P.lq1 = (const float*)d_in[6]; P.lk1 = (const float*)d_in[7]; P.lq2 = (const float*)d_in[8]; P.lk2 = (const float*)d_in[9]; P.subln_g = (const float*)d_in[10]; P.wa_sink = (const float*)d_in[11];
    P.w_da_o = (const float*)d_in[12]; P.w_wa_o = (const float*)d_in[13]; P.w_xa_o = (const float*)d_in[14]; P.w_out = (const float*)d_in[15]; P.ffn_g = (const float*)d_in[16]; P.w_router = (const float*)d_in[17];
    P.w_eg = (const float*)d_in[18]; P.w_eu = (const float*)d_in[19]; P.w_ed = (const float*)d_in[20]; P.final_g = (const float*)d_in[21];
    P.out = (float*)d_out; P.ws = (unsigned char*)d_ws;
    if (MK_N_LAUNCHES == 1) { a.ph_lo = 0; a.ph_hi = N_PHASES; hipLaunchKernelGGL(fwd, dim3(grid), dim3(512), LDS_BYTES, stream, a); }
    else { for (int p = 0; p < N_PHASES; ++p) { a.ph_lo = p; a.ph_hi = p + 1; hipLaunchKernelGGL(fwd, dim3(grid), dim3(512), LDS_BYTES, stream, a); } }
}
```

```cpp
#include <hip/hip_runtime.h>
#include <cstdio>
#include <cstdint>

#define GATES_FP8 1
#define INPROJ_FP8 0
#define XA_FP8 1
#define YC_FP8 1
#define WA_FP8 1
#define XS_FP8 1
constexpr float XQ8_SCALE = 16.0f;
constexpr float P8_SCALE = 256.0f, MVW8_SCALE = 8.0f;
#ifndef MK_N_LAUNCHES
#define MK_N_LAUNCHES 1
#endif

#define LAS __attribute__((address_space(3)))
#define GAS __attribute__((address_space(1)))
typedef unsigned short bf16_t;
typedef short bf16x8 __attribute__((ext_vector_type(8)));
typedef float f32x4 __attribute__((ext_vector_type(4)));
typedef float f32x2 __attribute__((ext_vector_type(2)));
typedef float f32x16 __attribute__((ext_vector_type(16)));
typedef unsigned u32x4 __attribute__((ext_vector_type(4)));
typedef unsigned u32x2 __attribute__((ext_vector_type(2)));

constexpr int DM = 1024, NB = 32, SEQ = 2048, MTOK = NB * SEQ;
constexpr int MEML = 256, MMEM = NB * MEML;
constexpr int NEXP = 16, CAP = 256, DEXP = 2048;
constexpr int INW = 8704;
constexpr float EPS = 1e-6f;
constexpr float LOG2E = 1.4426950408889634f;
constexpr float LAM_INIT = 0.2f;

constexpr size_t MiB = 1u << 20;
constexpr size_t WS_CTL = 0, CTL_ZERO_BYTES = 64 * 1024;
constexpr size_t WS_KMAX = 32 * 1024;
constexpr size_t WS_GL = 1 * MiB;
constexpr size_t WS_IDX = 1 * MiB + 512 * 1024;
constexpr size_t WS_INV = 2 * MiB;
constexpr size_t WS_WIN = 4 * MiB;
constexpr size_t WS_WMKV = 21 * MiB;
constexpr size_t WS_WDAO = 25 * MiB, WS_WWAO = 27 * MiB, WS_WXAO = 29 * MiB, WS_WOUT = 31 * MiB;
constexpr size_t WS_MN = 33 * MiB;
constexpr size_t WS_MK = 49 * MiB, WS_MV = 65 * MiB;
constexpr size_t WS_MVW = 81 * MiB;
constexpr size_t WS_AFF = 145 * MiB;
constexpr size_t WS_SG0 = 448 * MiB, WS_SG1 = 768 * MiB;
constexpr size_t WS_WXQ8 = 152 * MiB, WS_WMKV8 = 153 * MiB, WS_MN8 = 155 * MiB;
constexpr size_t WS_WWA8 = 163 * MiB;
constexpr size_t WS_WG8 = 149 * MiB;
constexpr size_t WS_ACT0 = 192 * MiB;
constexpr size_t WS_DAQ = 192 * MiB, WS_DAK = 320 * MiB, WS_DAVT = 448 * MiB, WS_WAQ = 576 * MiB, WS_WAK = 704 * MiB, WS_WAVT = 736 * MiB,
                 WS_XAQ = 768 * MiB, WS_H = 896 * MiB, WS_END = 1024 * MiB;
constexpr size_t WS_MERGED = WS_DAK;
constexpr size_t WS_X1 = 192 * MiB;
constexpr size_t WS_H2 = 320 * MiB;
constexpr size_t WS_WGU = 384 * MiB;
constexpr size_t WS_WD = 448 * MiB;
constexpr size_t WS_ACTB = 480 * MiB;
constexpr size_t WS_YE = 736 * MiB;

constexpr int R_DAQ = 0, R_DAK = 1024, R_WAQ = 2048, R_XAQ = 3072, R_WAK = 4096, R_DAV = 4352, R_WAV = 5376, R_GATE = 5632;

constexpr int RING_BYTES = 131072;
constexpr int EPI_OFF = RING_BYTES;
constexpr int MISC_OFF = RING_BYTES + 8192;
constexpr int LDS_BYTES = 147456;

#define LDS_WAIT() asm volatile("s_waitcnt lgkmcnt(0)" ::: "memory")
#define VM_WAIT() asm volatile("s_waitcnt vmcnt(0)" ::: "memory")
__device__ __forceinline__ unsigned cvt_pk_bf16(float lo, float hi) { unsigned r; asm volatile("v_cvt_pk_bf16_f32 %0, %1, %2" : "=v"(r) : "v"(lo), "v"(hi)); return r; }
typedef __bf16 bf16x2_t __attribute__((ext_vector_type(2)));
__device__ __forceinline__ unsigned cvt_pk_bf16_c(float lo, float hi) { f32x2 v; v.x = lo; v.y = hi; return __builtin_bit_cast(unsigned, __builtin_convertvector(v, bf16x2_t)); }
__device__ __forceinline__ float bf_lo(unsigned w) { return __uint_as_float(w << 16); }
__device__ __forceinline__ float bf_hi(unsigned w) { return __uint_as_float(w & 0xffff0000u); }
__device__ __forceinline__ float wave_sum(float v) {
#pragma unroll
    for (int o = 1; o < 64; o <<= 1) v += __shfl_xor(v, o);
    return v;
}
typedef int v8i __attribute__((ext_vector_type(8)));
typedef int v4i __attribute__((ext_vector_type(4)));
constexpr float W8_SCALE = 64.0f, ACT8_SCALE = 8.0f, YE8_SCALE = 8.0f;
__device__ __forceinline__ float clamp8(float v) { return fminf(fmaxf(v, -448.0f), 448.0f); }
__device__ __forceinline__ unsigned pk4_fp8(float a, float b, float c, float d) {
    int w = 0; w = __builtin_amdgcn_cvt_pk_fp8_f32(clamp8(a), clamp8(b), w, false); w = __builtin_amdgcn_cvt_pk_fp8_f32(clamp8(c), clamp8(d), w, true); return (unsigned)w; }
__device__ __forceinline__ float fast_sigmoid(float v) { return __builtin_amdgcn_rcpf(1.0f + __builtin_amdgcn_exp2f(-LOG2E * v)); }

#define XB_TMO      128
#define XB_XCNT(j)  (256  + 64 * (j))
#define XB_XSUB(j)  (1280 + 64 * (j))
#define XB_XGEN(j)  (2304 + 64 * (j))
#define XB_TOP      3328
#define XB_TOPGEN   3392
#define XCD_BAR_WORDS 3456
#define XB_SPIN_CAP (1u << 18)
__device__ __forceinline__ unsigned xb_ld(unsigned* p)              { return __hip_atomic_load(p, __ATOMIC_RELAXED, __HIP_MEMORY_SCOPE_AGENT); }
__device__ __forceinline__ unsigned xb_add(unsigned* p, unsigned v) { return __hip_atomic_fetch_add(p, v, __ATOMIC_RELAXED, __HIP_MEMORY_SCOPE_AGENT); }
__device__ __forceinline__ unsigned xb_xcc_id() { return (unsigned)__builtin_amdgcn_s_getreg((3 << 11) | 20) & 0xFu; }
#define XB_SPIN(cond, bar) do { unsigned _sp = 0; while (cond) { __builtin_amdgcn_s_sleep(1); \
    if ((++_sp & 255u) == 0u) { if (xb_ld(&(bar)[XB_TMO])) break; if (_sp > XB_SPIN_CAP) { atomicAdd(&(bar)[XB_TMO], 1u); break; } } } } while (0)
struct XcdBarrier { unsigned* bar; unsigned x; volatile LAS unsigned* st; };
__device__ __forceinline__ XcdBarrier xcd_barrier_post(unsigned* bar, volatile LAS unsigned* st) {
    XcdBarrier b; b.bar = bar; b.x = xb_xcc_id(); b.st = st;
    if (threadIdx.x == 0) (void)xb_add(&bar[XB_XCNT(b.x)], 1u);
    return b;
}
__device__ __forceinline__ void xcd_barrier_complete(unsigned* bar, unsigned x, unsigned& nloc, unsigned& nx) {
    const unsigned G = gridDim.x * gridDim.y * gridDim.z;
    unsigned sum, cnt, mine, sp = 0u;
    for (;;) {
        sum = 0u; cnt = 0u; mine = 0u;
#pragma unroll
        for (unsigned j = 0; j < 16; ++j) { const unsigned c = xb_ld(&bar[XB_XCNT(j)]); sum += c; cnt += (c > 0u) ? 1u : 0u; mine = (j == x) ? c : mine; }
        if (sum == G) break;
        __builtin_amdgcn_s_sleep(1);
        if ((++sp & 255u) == 0u) { if (xb_ld(&bar[XB_TMO])) break; if (sp > XB_SPIN_CAP) { atomicAdd(&bar[XB_TMO], 1u); break; } }
    }
    nloc = mine > 0u ? mine : 1u; nx = cnt > 0u ? cnt : 1u;
}
__device__ __forceinline__ void xcd_barrier(const XcdBarrier& b) {
    asm volatile("s_waitcnt vmcnt(0)" ::: "memory");
    __syncthreads();
    if (threadIdx.x == 0) {
        unsigned* bar = b.bar;
        __builtin_amdgcn_s_waitcnt(0);
        unsigned nloc = b.st[0], nx = b.st[1];
        if (nloc == 0u) { xcd_barrier_complete(bar, b.x, nloc, nx); b.st[0] = nloc; b.st[1] = nx; }
        const unsigned old = xb_add(&bar[XB_XSUB(b.x)], 1u);
        const unsigned gen = old / nloc;
        if (old + 1u == (gen + 1u) * nloc) {
            __builtin_amdgcn_fence(__ATOMIC_RELEASE, "agent");
            asm volatile("s_waitcnt vmcnt(0)" ::: "memory");
            const unsigned og = xb_add(&bar[XB_TOP], 1u);
            const unsigned tg = og / nx;
            if (og + 1u == (tg + 1u) * nx) xb_add(&bar[XB_TOPGEN], 1u);
            else XB_SPIN(xb_ld(&bar[XB_TOPGEN]) == tg, bar);
            __builtin_amdgcn_fence(__ATOMIC_ACQUIRE, "agent");
            xb_add(&bar[XB_XGEN(b.x)], 1u);
            asm volatile("s_waitcnt vmcnt(0)" ::: "memory");
        } else {
            XB_SPIN(xb_ld(&bar[XB_XGEN(b.x)]) == gen, bar);
            __builtin_amdgcn_fence(__ATOMIC_ACQUIRE, "agent");
            asm volatile("s_waitcnt vmcnt(0)" ::: "memory");
        }
    }
    __syncthreads();
}

namespace pg {
constexpr int BM = 256, BK = 64, HALF = 128, HTB = HALF * BK * 2, STAGE_BYTES = 8 * HTB, NXCD = 8, WGM = 8;
__host__ __device__ __forceinline__ int lds_byte(int r, int c) { const int st = (r >> 4) * 2 + (c >> 5), rr = r & 15, cc = c & 31, ob = rr * 64 + cc * 2; return st * 1024 + (ob ^ (((ob >> 9) & 1) << 5)); }
__host__ __device__ __forceinline__ void stage_rc(int b, int& R, int& C) { const int st = b / 1024, sb = b % 1024, swz = sb ^ (((sb >> 9) & 1) << 5); R = (st >> 1) * 16 + swz / 64; C = (st & 1) * 32 + (swz % 64) / 2; }
__host__ __device__ __forceinline__ int perm32(int rho) { const int n = rho >> 4, i = rho & 15; return 8 * (i >> 2) + 4 * n + (i & 3); }
__device__ __forceinline__ void xcd_map(int L, int nM, int nN, int& pm, int& pn) {
    const int nwg = nM * nN; int wgid = L;
    { const int q = nwg / NXCD, r = nwg % NXCD, xcd = wgid % NXCD, off = wgid / NXCD; wgid = (xcd < r ? xcd * (q + 1) : r * (q + 1) + (xcd - r) * q) + off; }
    const int nig = WGM * nN, gid = wgid / nig, fm = gid * WGM, gsz = (nM - fm) < WGM ? (nM - fm) : WGM;
    pm = fm + ((wgid % nig) % gsz); pn = (wgid % nig) / gsz;
}
struct GUnit { const char* A; const char* B; int pm, pn, job; };

#ifndef PG_SP2
#define PG_SP2 1
#endif
template <class Job, bool PERM, bool GATHER, bool FP8 = false>
__device__ __forceinline__ void gemm_phase(LAS unsigned char* lds, const Job& J) {
    const int tid = threadIdx.x, wid = __builtin_amdgcn_readfirstlane(tid >> 6), lane = tid & 63, wr = wid >> 2, wc = wid & 3, fr = lane & 15, fq = lane >> 4;
    const int K = J.K, nt = K / BK, lda = J.lda, ldb = J.ldb;
    int R0, C0, R1, C1; stage_rc(tid * 16, R0, C0); stage_rc(tid * 16 + 8192, R1, C1);
    unsigned vA[2][2], vAn[2][2], vB[2];
    { const int Rb0 = PERM ? ((R0 & ~31) + perm32(R0 & 31)) : R0, Rb1 = PERM ? ((R1 & ~31) + perm32(R1 & 31)) : R1;
      vB[0] = (unsigned)(Rb0 * ldb + C0) * 2u; vB[1] = (unsigned)(Rb1 * ldb + C1) * 2u; }
    const size_t kstep = (size_t)(BK * 2);
    const size_t hstepB = (size_t)HALF * ldb * 2;
    const unsigned ldsw = (unsigned)wid * 1024u;
    const unsigned ldsb = (unsigned)__builtin_amdgcn_readfirstlane((int)((unsigned)(uintptr_t)lds + ldsw));
    const int aoff = lds_byte(wr * 64 + fr, fq * 8), boff = lds_byte(wc * 32 + fr, fq * 8);
#define PG_SA(b, h) (((b) * 2 + (h)) * HTB)
#define PG_SB(b, h) ((4 + (b) * 2 + (h)) * HTB)
#define PG_STAGE(bufoff, gbase, voff) do { _Pragma("unroll") for (int _i = 0; _i < 2; ++_i) { unsigned _keep; \
        asm volatile("s_mov_b32 %0, m0\n\ts_mov_b32 m0, %3\n\ts_nop 0\n\tglobal_load_lds_dwordx4 %1, %2\n\ts_mov_b32 m0, %0" \
            : "=&s"(_keep) : "v"((voff)[_i]), "s"((const char*)(gbase)), "s"(ldsb + (unsigned)((bufoff) + _i * 8192)) : "memory"); } } while (0)
#define PG_LDA(dst, b, h) do { _Pragma("unroll") for (int m = 0; m < 4; ++m) _Pragma("unroll") for (int k = 0; k < 2; ++k) dst[m][k] = *(const LAS bf16x8*)(lds + PG_SA(b, h) + aoff + m * 2048 + k * 1024); } while (0)
#define PG_LDB(dst, b, h) do { _Pragma("unroll") for (int n = 0; n < 2; ++n) _Pragma("unroll") for (int k = 0; k < 2; ++k) dst[n][k] = *(const LAS bf16x8*)(lds + PG_SB(b, h) + boff + n * 2048 + k * 1024); } while (0)
#define PG_CAT8(x) __builtin_shufflevector(__builtin_bit_cast(v4i, (x)[0]), __builtin_bit_cast(v4i, (x)[1]), 0, 1, 2, 3, 4, 5, 6, 7)
#define PG_MMA(ai, bj, At, Bt) do { __builtin_amdgcn_s_setprio(1); _Pragma("unroll") for (int m = 0; m < 4; ++m) _Pragma("unroll") for (int n = 0; n < 2; ++n) { \
        if constexpr (FP8) { asm volatile("v_mfma_scale_f32_16x16x128_f8f6f4 %0, %1, %2, %0, %3, %3 op_sel_hi:[0,0,0]" : "+v"(acc[ai][bj][m][n]) : "v"(PG_CAT8(Bt[n])), "v"(PG_CAT8(At[m])), "v"(sc8)); } \
        else { _Pragma("unroll") for (int k = 0; k < 2; ++k) acc[ai][bj][m][n] = __builtin_amdgcn_mfma_f32_16x16x32_bf16(Bt[n][k], At[m][k], acc[ai][bj][m][n], 0, 0, 0); } } \
        __builtin_amdgcn_s_setprio(0); } while (0)
#define PG_WAIT_V(n) asm volatile("s_waitcnt vmcnt(" #n ")" ::: "memory")
#define PG_WAIT_L(n) asm volatile("s_waitcnt lgkmcnt(" #n ")" ::: "memory")
#define PG_BAR __builtin_amdgcn_s_barrier()
#define PG_SCHED __builtin_amdgcn_sched_barrier(0)
#define PG_SETV(dst, u) do { if constexpr (GATHER) { const int* _rw = J.rows(u); \
        dst[0][0] = (unsigned)(_rw[R0] * lda + C0) * 2u; dst[0][1] = (unsigned)(_rw[R1] * lda + C1) * 2u; \
        dst[1][0] = (unsigned)(_rw[HALF + R0] * lda + C0) * 2u; dst[1][1] = (unsigned)(_rw[HALF + R1] * lda + C1) * 2u; } \
      else { dst[0][0] = (unsigned)(R0 * lda + C0) * 2u; dst[0][1] = (unsigned)(R1 * lda + C1) * 2u; \
        dst[1][0] = (unsigned)((HALF + R0) * lda + C0) * 2u; dst[1][1] = (unsigned)((HALF + R1) * lda + C1) * 2u; } } while (0)
    const int sc8 = 0x7f7f7f7f;
    GUnit cur, nxt; int ui = 0;
    if (!J.next(0, cur)) return;
    f32x4 acc[2][2][4][2];
#pragma unroll
    for (int a = 0; a < 2; ++a)
#pragma unroll
        for (int b = 0; b < 2; ++b)
#pragma unroll
            for (int m = 0; m < 4; ++m)
#pragma unroll
                for (int n = 0; n < 2; ++n) acc[a][b][m][n] = (f32x4){0.f, 0.f, 0.f, 0.f};
    bf16x8 At[4][2], B0[2][2], B1[2][2];
    const char* cA = cur.A; const char* cB = cur.B;
    PG_SETV(vA, cur);
    if (PG_SP2) {
    PG_STAGE(PG_SB(0, 0), cB, vB); PG_STAGE(PG_SB(0, 1), cB + hstepB, vB); PG_STAGE(PG_SA(0, 0), cA, vA[0]); PG_STAGE(PG_SA(0, 1), cA, vA[1]);
    if (wr == 1) PG_BAR;
    PG_WAIT_V(2); PG_BAR;
    PG_STAGE(PG_SB(1, 0), cB + kstep, vB); PG_STAGE(PG_SA(1, 0), cA + kstep, vA[0]); PG_STAGE(PG_SB(1, 1), cB + hstepB + kstep, vB);
    PG_WAIT_V(6); PG_BAR;
    } else {
    PG_STAGE(PG_SB(0, 0), cB, vB); PG_STAGE(PG_SA(0, 0), cA, vA[0]); PG_STAGE(PG_SB(0, 1), cB + hstepB, vB); PG_STAGE(PG_SA(0, 1), cA, vA[1]);
    if (wr == 1) PG_BAR;
    PG_WAIT_V(4); PG_BAR;
    PG_STAGE(PG_SB(1, 0), cB + kstep, vB); PG_STAGE(PG_SA(1, 0), cA + kstep, vA[0]); PG_STAGE(PG_SB(1, 1), cB + hstepB + kstep, vB);
    PG_WAIT_V(6); PG_BAR;
    }
    for (;;) {
        const bool has_next = J.next(ui + 1, nxt);
        const char* nA = has_next ? nxt.A : cA; const char* nB = has_next ? nxt.B : cB;
        if constexpr (GATHER) { if (has_next) { PG_SETV(vAn, nxt); } else {
#pragma unroll
            for (int h = 0; h < 2; ++h) { vAn[h][0] = vA[h][0]; vAn[h][1] = vA[h][1]; } } }
        for (int t = 0; t < nt; t += 2) {
            const bool last = (t == nt - 2);
            const char* a1 = cA + (size_t)(t + 1) * kstep;
            const char* a2 = last ? nA : cA + (size_t)(t + 2) * kstep; const char* b2 = last ? nB : cB + (size_t)(t + 2) * kstep;
            const char* a3 = a2 + kstep; const char* b3 = b2 + kstep;
            unsigned vq[2][2];
#pragma unroll
            for (int h = 0; h < 2; ++h)
#pragma unroll
                for (int i = 0; i < 2; ++i) vq[h][i] = (GATHER && last) ? vAn[h][i] : vA[h][i];
            if (PG_SP2) {
            PG_LDB(B0, 0, 0); PG_LDB(B1, 0, 1); PG_SCHED; PG_LDA(At, 0, 0); PG_STAGE(PG_SA(1, 1), a1, vA[1]);
            PG_WAIT_V(8); PG_WAIT_L(0); PG_BAR; PG_MMA(0, 0, At, B0); PG_MMA(0, 1, At, B1); PG_BAR; PG_SCHED;
            PG_LDA(At, 0, 1); PG_STAGE(PG_SB(0, 0), b2, vB); PG_STAGE(PG_SB(0, 1), b2 + hstepB, vB); PG_STAGE(PG_SA(0, 0), a2, vq[0]);
            PG_WAIT_V(8); PG_WAIT_L(0); PG_BAR; PG_MMA(1, 0, At, B0); PG_MMA(1, 1, At, B1); PG_BAR; PG_SCHED;
            PG_LDB(B0, 1, 0); PG_LDB(B1, 1, 1); PG_SCHED; PG_LDA(At, 1, 0); PG_STAGE(PG_SA(0, 1), a2, vq[1]);
            PG_WAIT_V(8); PG_WAIT_L(0); PG_BAR; PG_MMA(0, 0, At, B0); PG_MMA(0, 1, At, B1); PG_BAR; PG_SCHED;
            PG_LDA(At, 1, 1); PG_STAGE(PG_SB(1, 0), b3, vB); PG_STAGE(PG_SB(1, 1), b3 + hstepB, vB); PG_STAGE(PG_SA(1, 0), a3, vq[0]);
            PG_WAIT_V(8); PG_WAIT_L(0); PG_BAR; PG_MMA(1, 0, At, B0); PG_MMA(1, 1, At, B1); PG_BAR; PG_SCHED;
            } else {
            PG_LDB(B0, 0, 0); PG_SCHED; PG_LDA(At, 0, 0); PG_STAGE(PG_SA(1, 1), a1, vA[1]);
            PG_WAIT_L(8); PG_BAR; PG_WAIT_L(0); PG_MMA(0, 0, At, B0); PG_BAR; PG_SCHED;
            PG_LDB(B1, 0, 1); PG_STAGE(PG_SB(0, 0), b2, vB);
            PG_BAR; PG_WAIT_L(0); PG_MMA(0, 1, At, B1); PG_BAR;
            PG_LDA(At, 0, 1); PG_STAGE(PG_SA(0, 0), a2, vq[0]);
            PG_BAR; PG_WAIT_L(0); PG_MMA(1, 0, At, B0); PG_BAR; PG_SCHED;
            PG_STAGE(PG_SB(0, 1), b2 + hstepB, vB);
            PG_WAIT_V(6); PG_BAR; PG_MMA(1, 1, At, B1); PG_BAR;
            PG_LDB(B0, 1, 0); PG_SCHED; PG_LDA(At, 1, 0); PG_STAGE(PG_SA(0, 1), a2, vq[1]);
            PG_WAIT_L(8); PG_BAR; PG_WAIT_L(0); PG_MMA(0, 0, At, B0); PG_BAR; PG_SCHED;
            PG_LDB(B1, 1, 1); PG_STAGE(PG_SB(1, 0), b3, vB);
            PG_BAR; PG_WAIT_L(0); PG_MMA(0, 1, At, B1); PG_BAR;
            PG_LDA(At, 1, 1); PG_STAGE(PG_SA(1, 0), a3, vq[0]);
            PG_BAR; PG_WAIT_L(0); PG_MMA(1, 0, At, B0); PG_BAR; PG_SCHED;
            PG_STAGE(PG_SB(1, 1), b3 + hstepB, vB);
            PG_WAIT_V(6); PG_BAR; PG_MMA(1, 1, At, B1); PG_BAR;
            }
        }
        if constexpr (FP8) asm volatile("s_nop 15\n\ts_nop 7" ::: "memory");
        if (wr == 0) PG_BAR;
        J.epi(acc, cur, wr, wc, fr, fq);
        if (!has_next) break;
#pragma unroll
        for (int a = 0; a < 2; ++a)
#pragma unroll
            for (int b = 0; b < 2; ++b)
#pragma unroll
                for (int m = 0; m < 4; ++m)
#pragma unroll
                    for (int n = 0; n < 2; ++n) acc[a][b][m][n] = (f32x4){0.f, 0.f, 0.f, 0.f};
        cur = nxt; cA = nA; cB = nB; ++ui;
        if constexpr (GATHER) {
#pragma unroll
            for (int h = 0; h < 2; ++h) { vA[h][0] = vAn[h][0]; vA[h][1] = vAn[h][1]; } }
        if (wr == 1) PG_BAR;
    }
    PG_WAIT_V(0);
    PG_BAR;
#undef PG_SA
#undef PG_SB
#undef PG_STAGE
#undef PG_LDA
#undef PG_LDB
#undef PG_MMA
#undef PG_CAT8
#undef PG_WAIT_V
#undef PG_WAIT_L
#undef PG_BAR
#undef PG_SCHED
#undef PG_SETV
}

__device__ __forceinline__ void store_tile_bf16(const f32x4 (&acc)[2][2][4][2], bf16_t* O, int ldo, float sc, int wr, int wc, int fr, int fq) {
    const unsigned loff = (unsigned)((wr * 64 + fr) * ldo + wc * 32 + 8 * fq) * 2u;
#pragma unroll
    for (int ai = 0; ai < 2; ++ai)
#pragma unroll
        for (int m = 0; m < 4; ++m) { char* rowb = (char*)O + (size_t)(ai * HALF + m * 16) * ldo * 2;
#pragma unroll
            for (int bj = 0; bj < 2; ++bj) { const f32x4 v0 = acc[ai][bj][m][0] * sc, v1 = acc[ai][bj][m][1] * sc;
                u32x4 w; w.x = cvt_pk_bf16(v0[0], v0[1]); w.y = cvt_pk_bf16(v0[2], v0[3]); w.z = cvt_pk_bf16(v1[0], v1[1]); w.w = cvt_pk_bf16(v1[2], v1[3]);
                *(u32x4*)(rowb + bj * HALF * 2 + loff) = w; } }
}
}

struct Ptrs {
    const float* x; const float* mem; const float* attn_g; const float* mem_g; const float* w_in; const float* w_mkv;
    const float* lq1; const float* lk1; const float* lq2; const float* lk2; const float* subln_g; const float* wa_sink;
    const float* w_da_o; const float* w_wa_o; const float* w_xa_o; const float* w_out; const float* ffn_g; const float* w_router;
    const float* w_eg; const float* w_eu; const float* w_ed; const float* final_g;
    float* out; unsigned char* ws;
};
#define WSP(T, off) ((T*)(P.ws + (off)))

struct JobP1 {
    Ptrs P; int G, c; int K, lda, ldb; LAS float* scr;
    __device__ __forceinline__ bool next(int i, pg::GUnit& u) const {
        int L = i * G + c;
        constexpr size_t RB = INPROJ_FP8 ? 1024 : 2048;
        const char* h = INPROJ_FP8 ? (const char*)P.out + 128 * MiB : (const char*)(P.ws + WS_H); const char* w = (const char*)(P.ws + WS_WIN);
        if (XA_FP8 && WA_FP8) {
            if (L < 2048) { pg::xcd_map(L, 256, 8, u.pm, u.pn); u.job = 0; u.A = h + (size_t)u.pm * (256 * RB); u.B = w + (size_t)u.pn * (256 * RB); return true; }
            L -= 2048;
            if (L < 1024) { pg::xcd_map(L, 4, 256, u.pm, u.pn); u.job = 1; u.A = w + (size_t)(R_DAV + u.pm * 256) * RB; u.B = h + (size_t)u.pn * (256 * RB); return true; }
            return false;
        }
        if (XA_FP8) {
            if (L < 3328) { pg::xcd_map(L, 256, 13, u.pm, u.pn); if (u.pn == 12) u.pn = 16; u.job = 0; u.A = h + (size_t)u.pm * (256 * RB); u.B = w + (size_t)u.pn * (256 * RB); return true; }
            L -= 3328;
            if (L < 1280) { pg::xcd_map(L, 5, 256, u.pm, u.pn); u.job = 1; u.A = w + (size_t)(R_DAV + u.pm * 256) * RB; u.B = h + (size_t)u.pn * (256 * RB); return true; }
            return false;
        }
        if (L < 4352) { pg::xcd_map(L, 256, 17, u.pm, u.pn); u.job = 0; u.A = h + (size_t)u.pm * (256 * RB); u.B = w + (size_t)u.pn * (256 * RB); return true; }
        L -= 4352;
        if (L < 1280) { pg::xcd_map(L, 5, 256, u.pm, u.pn); u.job = 1; u.A = w + (size_t)(R_DAV + u.pm * 256) * RB; u.B = h + (size_t)u.pn * (256 * RB); return true; }
        L -= 1280;
        if (L < 256) { pg::xcd_map(L, 32, 8, u.pm, u.pn); u.job = 2; u.A = (const char*)(P.ws + WS_MN) + (size_t)u.pm * (256 * RB); u.B = (const char*)(P.ws + WS_WMKV) + (size_t)u.pn * (256 * RB); return true; }
        return false;
    }
    __device__ __forceinline__ const int* rows(const pg::GUnit&) const { return nullptr; }
    __device__ __forceinline__ void epi(const f32x4 (&acc)[2][2][4][2], const pg::GUnit& u, int wr, int wc, int fr, int fq) const {
        bf16_t* O; int ldo = 1024; float sc = INPROJ_FP8 ? (1.0f / W8_SCALE) : 1.f;
        if (u.job == 0) {
            const int s = u.pn >> 2, q = u.pn & 3;
            if (s == 0) { O = WSP(bf16_t, WS_DAQ) + (size_t)u.pm * 256 * 1024 + q * 256; sc *= 0.125f * LOG2E; }
            else if (s == 1) { O = WSP(bf16_t, WS_DAK) + (size_t)u.pm * 256 * 1024 + q * 256; }
            else if (s == 2) { O = WSP(bf16_t, WS_WAQ) + (size_t)u.pm * 256 * 1024 + q * 256; sc *= 0.125f * LOG2E; }
            else if (s == 3) { O = WSP(bf16_t, WS_XAQ) + (size_t)u.pm * 256 * 1024 + q * 256; sc *= 0.0625f * LOG2E; }
            else { O = WSP(bf16_t, WS_WAK) + (size_t)u.pm * 256 * 256; ldo = 256; }
        } else if (u.job == 1) {
            ldo = MTOK;
            if (u.pm < 4) O = WSP(bf16_t, WS_DAVT) + (size_t)u.pm * 256 * MTOK + (size_t)u.pn * 256;
            else O = WSP(bf16_t, WS_WAVT) + (size_t)u.pn * 256;
        } else {
            if (u.pn < 4) O = WSP(bf16_t, WS_MK) + (size_t)u.pm * 256 * 1024 + u.pn * 256;
            else O = WSP(bf16_t, WS_MV) + (size_t)u.pm * 256 * 1024 + (u.pn - 4) * 256;
        }
        pg::store_tile_bf16(acc, O, ldo, sc, wr, wc, fr, fq);
        if (u.job == 0 && (u.pn >> 2) == 1) {
            LAS float* X = scr;
#pragma unroll
            for (int ai = 0; ai < 2; ++ai)
#pragma unroll
                for (int m = 0; m < 4; ++m)
#pragma unroll
                    for (int bj = 0; bj < 2; ++bj) { const f32x4 a = acc[ai][bj][m][0] * sc, b2 = acc[ai][bj][m][1] * sc;
                        float q = (a[0] * a[0] + a[1] * a[1]) + (a[2] * a[2] + a[3] * a[3]) + (b2[0] * b2[0] + b2[1] * b2[1]) + (b2[2] * b2[2] + b2[3] * b2[3]);
                        q += __shfl_xor(q, 16); q += __shfl_xor(q, 32);
                        if (fq == 0) X[((ai * 128 + wr * 64 + m * 16 + fr) * 2 + bj) * 4 + wc] = q; }
            LDS_WAIT(); __builtin_amdgcn_s_barrier(); asm volatile("" ::: "memory");
            { const int t = threadIdx.x, row = t & 255, bj = t >> 8; const f32x4 q = *(const LAS f32x4*)(X + (row * 2 + bj) * 4);
              float v = fmaxf(q[0] + q[1], q[2] + q[3]) * 1.01f;
#pragma unroll
              for (int off = 1; off < 64; off <<= 1) v = fmaxf(v, __shfl_xor(v, off));
              if ((t & 63) == 0) __hip_atomic_fetch_max(WSP(unsigned, WS_KMAX) + (u.pm >> 3) * 8 + 2 * (u.pn - 4) + bj, __float_as_uint(v), __ATOMIC_RELAXED, __HIP_MEMORY_SCOPE_AGENT); }
            LDS_WAIT(); __builtin_amdgcn_s_barrier(); asm volatile("" ::: "memory");
        }
    }
};

struct JobP1x {
    Ptrs P; int G, c; int K, lda, ldb;
    __device__ __forceinline__ bool next(int i, pg::GUnit& u) const {
        int L = i * G + c;
        if (L < 1024) { pg::xcd_map(L, 256, 4, u.pm, u.pn); u.job = 0; u.A = (const char*)P.out + 128 * MiB + (size_t)u.pm * (256 * 1024); u.B = (const char*)(P.ws + WS_WXQ8) + (size_t)u.pn * (256 * 1024); return true; }
        L -= 1024;
        if (L < 256) { pg::xcd_map(L, 32, 8, u.pm, u.pn); u.job = 2; u.A = (const char*)(P.ws + WS_MN8) + (size_t)u.pm * (256 * 1024); u.B = (const char*)(P.ws + WS_WMKV8) + (size_t)u.pn * (256 * 1024); return true; }
        if (!WA_FP8) return false;
        L -= 256;
        const char* h8 = (const char*)P.out + 128 * MiB; const char* w8 = (const char*)(P.ws + WS_WWA8);
        if (L < 1280) { pg::xcd_map(L, 256, 5, u.pm, u.pn); u.job = 3; u.A = h8 + (size_t)u.pm * (256 * 1024); u.B = w8 + (size_t)u.pn * (256 * 1024); return true; }
        L -= 1280;
        if (L < 256) { u.pm = 0; u.pn = L; u.job = 4; u.A = w8 + (size_t)1280 * 1024; u.B = h8 + (size_t)u.pn * (256 * 1024); return true; }
        return false;
    }
    __device__ __forceinline__ const int* rows(const pg::GUnit&) const { return nullptr; }
    __device__ __forceinline__ void epi(const f32x4 (&acc)[2][2][4][2], const pg::GUnit& u, int wr, int wc, int fr, int fq) const {
        bf16_t* O; float sc = 1.0f / W8_SCALE;
        if (u.job >= 3) {
            int ldo = 1024;
            if (u.job == 4) { O = WSP(bf16_t, WS_WAVT) + (size_t)u.pn * 256; ldo = MTOK; }
            else if (u.pn < 4) { O = WSP(bf16_t, WS_WAQ) + (size_t)u.pm * 256 * 1024 + u.pn * 256; sc *= 0.125f * LOG2E; }
            else { O = WSP(bf16_t, WS_WAK) + (size_t)u.pm * 256 * 256; ldo = 256; }
            pg::store_tile_bf16(acc, O, ldo, sc, wr, wc, fr, fq);
            return; }
        if (u.job == 0) { O = WSP(bf16_t, WS_XAQ) + (size_t)u.pm * 256 * 1024 + u.pn * 256; sc *= 0.0625f * LOG2E; }
        else if (u.pn < 4) O = WSP(bf16_t, WS_MK) + (size_t)u.pm * 256 * 1024 + u.pn * 256;
        else O = WSP(bf16_t, WS_MV) + (size_t)u.pm * 256 * 1024 + (u.pn - 4) * 256;
        if (XS_FP8) {
            if (u.job == 0) sc *= XQ8_SCALE;
            char* O8 = (char*)(P.ws + (u.job == 0 ? WS_XAQ : (u.pn < 4 ? WS_MK : WS_MV))) + (size_t)u.pm * 256 * 1024 + (u.pn & 3) * 256;
            const unsigned loff = (unsigned)((wr * 64 + fr) * 1024 + wc * 32 + 8 * fq);
#pragma unroll
            for (int ai = 0; ai < 2; ++ai)
#pragma unroll
                for (int m = 0; m < 4; ++m)
#pragma unroll
                    for (int bj = 0; bj < 2; ++bj) { const f32x4 a = acc[ai][bj][m][0] * sc, b2 = acc[ai][bj][m][1] * sc;
                        u32x2 w; w.x = pk4_fp8(a[0], a[1], a[2], a[3]); w.y = pk4_fp8(b2[0], b2[1], b2[2], b2[3]);
                        *(u32x2*)(O8 + (size_t)(ai * 128 + m * 16) * 1024 + bj * 128 + loff) = w; }
            return; }
        pg::store_tile_bf16(acc, O, 1024, sc, wr, wc, fr, fq);
    }
};

struct JobXA {
    Ptrs P; int G, c; int K, lda, ldb; LAS float* scr;
    __device__ __forceinline__ bool next(int i, pg::GUnit& u) const {
        const int L = i * G + c; if (L >= 1024) return false;
        u.job = 0; u.pm = L >> 2; u.pn = L & 3;
        if (XS_FP8) { u.A = (const char*)(P.ws + WS_XAQ) + (size_t)u.pm * (256 * 1024) + u.pn * 256;
                      u.B = (const char*)(P.ws + WS_MK) + (size_t)(u.pm >> 3) * (256 * 1024) + u.pn * 256; return true; }
        u.A = (const char*)(P.ws + WS_XAQ) + (size_t)u.pm * (256 * 1024 * 2) + u.pn * 512;
        u.B = (const char*)(P.ws + WS_MK) + (size_t)(u.pm >> 3) * (256 * 1024 * 2) + u.pn * 512; return true;
    }
    __device__ __forceinline__ const int* rows(const pg::GUnit&) const { return nullptr; }
    __device__ __forceinline__ void epi(f32x4 (&acc)[2][2][4][2], const pg::GUnit& u, int wr, int wc, int fr, int fq) const {
        LAS f32x2* X = (LAS f32x2*)scr;
        if (XS_FP8) {
#pragma unroll
            for (int ai = 0; ai < 2; ++ai)
#pragma unroll
                for (int bj = 0; bj < 2; ++bj)
#pragma unroll
                    for (int m = 0; m < 4; ++m)
#pragma unroll
                        for (int n = 0; n < 2; ++n) acc[ai][bj][m][n] = acc[ai][bj][m][n] * (1.0f / XQ8_SCALE); }
        float lm[2][4];
#pragma unroll
        for (int ai = 0; ai < 2; ++ai)
#pragma unroll
            for (int m = 0; m < 4; ++m) { float v = -3.0e38f;
#pragma unroll
                for (int bj = 0; bj < 2; ++bj)
#pragma unroll
                    for (int n = 0; n < 2; ++n) { const f32x4 a = acc[ai][bj][m][n]; v = fmaxf(v, fmaxf(fmaxf(a[0], a[1]), fmaxf(a[2], a[3]))); }
                v = fmaxf(v, __shfl_xor(v, 16)); v = fmaxf(v, __shfl_xor(v, 32));
                float sm = 0.f;
#pragma unroll
                for (int bj = 0; bj < 2; ++bj)
#pragma unroll
                    for (int n = 0; n < 2; ++n) { f32x4 a = acc[ai][bj][m][n];
#pragma unroll
                        for (int j = 0; j < 4; ++j) { a[j] = __builtin_amdgcn_exp2f(a[j] - v); sm += a[j]; }
                        acc[ai][bj][m][n] = a; }
                sm += __shfl_xor(sm, 16); sm += __shfl_xor(sm, 32);
                lm[ai][m] = v; if (fq == 0) X[(ai * 128 + wr * 64 + m * 16 + fr) * 4 + wc] = (f32x2){v, sm}; }
        LDS_WAIT(); __builtin_amdgcn_s_barrier(); asm volatile("" ::: "memory");
#pragma unroll
        for (int ai = 0; ai < 2; ++ai)
#pragma unroll
            for (int m = 0; m < 4; ++m) { const LAS f32x2* xp = X + (ai * 128 + wr * 64 + m * 16 + fr) * 4;
                const f32x2 p0 = xp[0], p1 = xp[1], p2 = xp[2], p3 = xp[3];
                const float M = fmaxf(fmaxf(p0[0], p1[0]), fmaxf(p2[0], p3[0]));
                const float tot = (p0[1] * __builtin_amdgcn_exp2f(p0[0] - M) + p1[1] * __builtin_amdgcn_exp2f(p1[0] - M)) + (p2[1] * __builtin_amdgcn_exp2f(p2[0] - M) + p3[1] * __builtin_amdgcn_exp2f(p3[0] - M));
                const float f = __builtin_amdgcn_exp2f(lm[ai][m] - M) / tot;
#pragma unroll
                for (int bj = 0; bj < 2; ++bj)
#pragma unroll
                    for (int n = 0; n < 2; ++n) acc[ai][bj][m][n] = acc[ai][bj][m][n] * f; }
        if (YC_FP8) { char* O8 = (char*)P.out + (size_t)u.pm * 256 * 1024 + u.pn * 256; const unsigned loff = (unsigned)((wr * 64 + fr) * 1024 + wc * 32 + 8 * fq);
#pragma unroll
            for (int ai = 0; ai < 2; ++ai)
#pragma unroll
                for (int m = 0; m < 4; ++m)
#pragma unroll
                    for (int bj = 0; bj < 2; ++bj) { const f32x4 a = acc[ai][bj][m][0] * P8_SCALE, b2 = acc[ai][bj][m][1] * P8_SCALE;
                        u32x2 w; w.x = pk4_fp8(a[0], a[1], a[2], a[3]); w.y = pk4_fp8(b2[0], b2[1], b2[2], b2[3]);
                        *(u32x2*)(O8 + (size_t)(ai * 128 + m * 16) * 1024 + bj * 128 + loff) = w; } }
        else { bf16_t* O = (bf16_t*)P.out + (size_t)u.pm * 256 * 1024 + u.pn * 256;
            pg::store_tile_bf16(acc, O, 1024, 1.f, wr, wc, fr, fq); }
        LDS_WAIT(); __builtin_amdgcn_s_barrier(); asm volatile("" ::: "memory");
    }
};
struct JobMVW {
    Ptrs P; int G, c; int K, lda, ldb;
    __device__ __forceinline__ bool next(int i, pg::GUnit& u) const {
        const int L = i * G + c; if (L >= 512) return false;
        u.job = 0; u.pm = L & 3; u.pn = L >> 2;
        if (XS_FP8) { u.A = (const char*)(P.ws + WS_WXAO) + (size_t)u.pm * (256 * 1024) + (u.pn & 3) * 256;
                      u.B = (const char*)(P.ws + WS_MV) + (size_t)(u.pn >> 2) * (256 * 1024) + (u.pn & 3) * 256; return true; }
        u.A = (const char*)(P.ws + WS_WXAO) + (size_t)u.pm * (256 * 1024 * 2) + (u.pn & 3) * 512;
        u.B = (const char*)(P.ws + WS_MV) + (size_t)(u.pn >> 2) * (256 * 1024 * 2) + (u.pn & 3) * 512; return true;
    }
    __device__ __forceinline__ const int* rows(const pg::GUnit&) const { return nullptr; }
    __device__ __forceinline__ void epi(const f32x4 (&acc)[2][2][4][2], const pg::GUnit& u, int wr, int wc, int fr, int fq) const {
        if (YC_FP8) { char* O8 = (char*)(P.ws + WS_MVW) + (size_t)(u.pn >> 2) * (1024 * 1024) + (size_t)u.pm * 256 * 1024 + (u.pn & 3) * 256;
            const unsigned loff = (unsigned)((wr * 64 + fr) * 1024 + wc * 32 + 8 * fq);
#pragma unroll
            for (int ai = 0; ai < 2; ++ai)
#pragma unroll
                for (int m = 0; m < 4; ++m)
#pragma unroll
                    for (int bj = 0; bj < 2; ++bj) { const float ms = XS_FP8 ? MVW8_SCALE / W8_SCALE : MVW8_SCALE; const f32x4 a = acc[ai][bj][m][0] * ms, b2 = acc[ai][bj][m][1] * ms;
                        u32x2 w; w.x = pk4_fp8(a[0], a[1], a[2], a[3]); w.y = pk4_fp8(b2[0], b2[1], b2[2], b2[3]);
                        *(u32x2*)(O8 + (size_t)(ai * 128 + m * 16) * 1024 + bj * 128 + loff) = w; } }
        else { bf16_t* O = WSP(bf16_t, WS_MVW) + (size_t)(u.pn >> 2) * (1024 * 1024) + (size_t)u.pm * 256 * 1024 + (u.pn & 3) * 256;
            pg::store_tile_bf16(acc, O, 1024, 1.f, wr, wc, fr, fq); }
    }
};

__device__ __forceinline__ char* sg_base(const Ptrs& P, int br) {
    return br == 0 ? (char*)(P.ws + WS_SG0) : br == 1 ? (char*)(P.ws + WS_SG1) : (GATES_FP8 ? (char*)(P.ws + WS_H) : (char*)P.out + 128 * MiB);
}
struct JobMergeG {
    Ptrs P; int G, c; int K, lda, ldb;
    __device__ __forceinline__ bool next(int i, pg::GUnit& u) const {
        if (i >= 12) return false;
        const int ti = i / 3, br = i - ti * 3;
        pg::xcd_map(ti * G + c, 256, 4, u.pm, u.pn); u.job = br;
        if (GATES_FP8) { u.A = (const char*)P.out + 128 * MiB + (size_t)u.pm * (256 * 1024); u.B = (const char*)(P.ws + (INPROJ_FP8 ? WS_WIN + (size_t)R_GATE * 1024 : WS_WG8)) + (size_t)(br * 1024 + u.pn * 256) * 1024; }
        else { u.A = (const char*)(P.ws + WS_H) + (size_t)u.pm * (256 * 1024 * 2); u.B = (const char*)(P.ws + WS_WIN) + (size_t)(R_GATE + br * 1024 + u.pn * 256) * 2048; }
        return true;
    }
    __device__ __forceinline__ const int* rows(const pg::GUnit&) const { return nullptr; }
    __device__ __forceinline__ void epi(const f32x4 (&acc)[2][2][4][2], const pg::GUnit& u, int wr, int wc, int fr, int fq) const {
        char* OB = sg_base(P, u.job) + ((size_t)u.pm * 256 * 1024 + u.pn * 256) * 2;
        const unsigned loff = (unsigned)((wr * 64 + fr) * 1024 + wc * 32 + 8 * fq) * 2u;
        constexpr float sc = GATES_FP8 ? (1.0f / W8_SCALE) : 1.0f;
#pragma unroll
        for (int ai = 0; ai < 2; ++ai)
#pragma unroll
            for (int m = 0; m < 4; ++m)
#pragma unroll
                for (int bj = 0; bj < 2; ++bj) { const unsigned uo = (unsigned)((ai * 128 + m * 16) * 1024 + bj * 128) * 2u;
                    const f32x4 a = acc[ai][bj][m][0] * (-LOG2E * sc), b = acc[ai][bj][m][1] * (-LOG2E * sc);
#define MG_SIG(v) __builtin_amdgcn_rcpf(1.0f + __builtin_amdgcn_exp2f(v))
                    u32x4 w; w.x = cvt_pk_bf16_c(MG_SIG(a[0]), MG_SIG(a[1])); w.y = cvt_pk_bf16_c(MG_SIG(a[2]), MG_SIG(a[3]));
                    w.z = cvt_pk_bf16_c(MG_SIG(b[0]), MG_SIG(b[1])); w.w = cvt_pk_bf16_c(MG_SIG(b[2]), MG_SIG(b[3]));
#undef MG_SIG
                    *(u32x4*)(OB + uo + loff) = w; }
    }
};
struct JobMergeY {
    Ptrs P; int G, c; int K, lda, ldb; int mode;
    __device__ __forceinline__ bool next(int i, pg::GUnit& u) const {
        int ti, br;
        if (mode == 0) { if (i >= 12) return false; ti = i / 3; br = i - ti * 3; }
        else if (mode == 1) { if (i >= 8) return false; ti = i >> 1; br = i & 1; }
        else { if (i >= 4) return false; ti = i; br = 2; }
        pg::xcd_map(ti * G + c, 256, 4, u.pm, u.pn); u.job = br;
        if (mode == 2) { u.A = (const char*)P.out + (size_t)u.pm * (256 * 1024); u.B = (const char*)(P.ws + WS_MVW) + (size_t)(u.pm >> 3) * (1024 * 1024) + (size_t)u.pn * (256 * 1024); return true; }
        if (br == 0) { u.A = (const char*)(P.ws + WS_DAQ) + (size_t)u.pm * (256 * 1024 * 2); u.B = (const char*)(P.ws + WS_WDAO) + (size_t)u.pn * (256 * 1024 * 2); }
        else if (br == 1) { u.A = (const char*)(P.ws + WS_WAQ) + (size_t)u.pm * (256 * 1024 * 2); u.B = (const char*)(P.ws + WS_WWAO) + (size_t)u.pn * (256 * 1024 * 2); }
        else { u.A = (const char*)P.out + (size_t)u.pm * (256 * 1024 * 2); u.B = (const char*)(P.ws + WS_MVW) + (size_t)(u.pm >> 3) * (1024 * 1024 * 2) + (size_t)u.pn * (256 * 1024 * 2); }
        return true;
    }
    __device__ __forceinline__ const int* rows(const pg::GUnit&) const { return nullptr; }
    __device__ __forceinline__ void epi(const f32x4 (&acc)[2][2][4][2], const pg::GUnit& u, int wr, int wc, int fr, int fq) const {
        const size_t tileoff = ((size_t)u.pm * 256 * 1024 + u.pn * 256) * 2;
        const char* SGb = sg_base(P, u.job) + tileoff; char* MGb = (char*)(P.ws + WS_MERGED) + tileoff;
        const unsigned loff = (unsigned)((wr * 64 + fr) * 1024 + wc * 32 + 8 * fq) * 2u;
        const bool hasPrev = u.job != 0;
        const float ysc = (mode == 2) ? 1.0f / (P8_SCALE * MVW8_SCALE) : 1.0f;
#pragma unroll
        for (int ai = 0; ai < 2; ++ai) {
            u32x4 g[4][2], pv[4][2];
#pragma unroll
            for (int m = 0; m < 4; ++m)
#pragma unroll
                for (int bj = 0; bj < 2; ++bj) { const unsigned uo = (unsigned)((ai * 128 + m * 16) * 1024 + bj * 128) * 2u;
                    g[m][bj] = __builtin_nontemporal_load((const u32x4*)(SGb + uo + loff));
                    pv[m][bj] = (u32x4){0u, 0u, 0u, 0u};
                    if (hasPrev) pv[m][bj] = __builtin_nontemporal_load((const u32x4*)(MGb + uo + loff)); }
#pragma unroll
            for (int m = 0; m < 4; ++m)
#pragma unroll
                for (int bj = 0; bj < 2; ++bj) { const unsigned uo = (unsigned)((ai * 128 + m * 16) * 1024 + bj * 128) * 2u;
                    const f32x4 a = acc[ai][bj][m][0] * ysc, b = acc[ai][bj][m][1] * ysc;
                    const u32x4 gq = g[m][bj], pq = pv[m][bj];
                    u32x4 w;
                    w.x = cvt_pk_bf16(bf_lo(pq.x) + bf_lo(gq.x) * a[0], bf_hi(pq.x) + bf_hi(gq.x) * a[1]);
                    w.y = cvt_pk_bf16(bf_lo(pq.y) + bf_lo(gq.y) * a[2], bf_hi(pq.y) + bf_hi(gq.y) * a[3]);
                    w.z = cvt_pk_bf16(bf_lo(pq.z) + bf_lo(gq.z) * b[0], bf_hi(pq.z) + bf_hi(gq.z) * b[1]);
                    w.w = cvt_pk_bf16(bf_lo(pq.w) + bf_lo(gq.w) * b[2], bf_hi(pq.w) + bf_hi(gq.w) * b[3]);
                    *(u32x4*)(MGb + uo + loff) = w; }
            asm volatile("" ::: "memory"); }
    }
};

struct JobOut {
    Ptrs P; int G, c; int K, lda, ldb;
    __device__ __forceinline__ bool next(int i, pg::GUnit& u) const {
        const int L = i * G + c; if (L >= 1024) return false;
        pg::xcd_map(L, 256, 4, u.pm, u.pn); u.job = 0;
        u.A = (const char*)(P.ws + WS_MERGED) + (size_t)u.pm * (256 * 1024 * 2); u.B = (const char*)(P.ws + WS_WOUT) + (size_t)u.pn * (256 * 1024 * 2); return true;
    }
    __device__ __forceinline__ const int* rows(const pg::GUnit&) const { return nullptr; }
    __device__ __forceinline__ void epi(const f32x4 (&acc)[2][2][4][2], const pg::GUnit& u, int wr, int wc, int fr, int fq) const {
        const int row0 = u.pm * 256 + wr * 64 + fr, col0 = u.pn * 256 + wc * 32 + 8 * fq;
#pragma unroll
        for (int ai = 0; ai < 2; ++ai)
#pragma unroll
            for (int m = 0; m < 4; ++m) { const size_t off = (size_t)(row0 + ai * 128 + m * 16) * 1024 + col0;
#pragma unroll
                for (int bj = 0; bj < 2; ++bj) { const f32x4 x0 = *(const f32x4*)(P.x + off + bj * 128), x1 = *(const f32x4*)(P.x + off + bj * 128 + 4);
                    const f32x4 v0 = x0 + acc[ai][bj][m][0], v1 = x1 + acc[ai][bj][m][1];
                    u32x4 w; w.x = cvt_pk_bf16(v0[0], v0[1]); w.y = cvt_pk_bf16(v0[2], v0[3]); w.z = cvt_pk_bf16(v1[0], v1[1]); w.w = cvt_pk_bf16(v1[2], v1[3]);
                    *(u32x4*)(WSP(bf16_t, WS_X1) + off + bj * 128) = w; } }
    }
};
struct JobGU {
    Ptrs P; int G, c; int K, lda, ldb;
    __device__ __forceinline__ bool next(int i, pg::GUnit& u) const {
        const int L = i * G + c; if (L >= 8192) return false;
        pg::xcd_map(L, 512, 16, u.pm, u.pn); u.job = 0;
        u.A = (const char*)(P.ws + WS_H2);
        u.B = (const char*)(P.ws + WS_WGU) + (size_t)(u.pm >> 5) * (4096 * 1024) + (size_t)u.pn * (256 * 1024); return true;
    }
    __device__ __forceinline__ const int* rows(const pg::GUnit& u) const { const int e = u.pm >> 5, b = u.pm & 31; return WSP(const int, WS_IDX) + (b * 16 + e) * 256; }
    __device__ __forceinline__ void epi(const f32x4 (&acc)[2][2][4][2], const pg::GUnit& u, int wr, int wc, int fr, int fq) const {
        char* O = (char*)(P.ws + WS_ACTB) + (size_t)u.pm * 256 * 2048 + u.pn * 128;
        const unsigned loff = (unsigned)((wr * 64 + fr) * 2048 + wc * 32 + 8 * fq);
        constexpr float IS = 1.0f / W8_SCALE, KX = -LOG2E * IS, IC = 1.0f / (IS * IS * ACT8_SCALE);
#pragma unroll
        for (int ai = 0; ai < 2; ++ai)
#pragma unroll
            for (int m = 0; m < 4; ++m) {
                f32x2 o[2][2];
#pragma unroll
                for (int n = 0; n < 2; ++n)
#pragma unroll
                    for (int p = 0; p < 2; ++p) {
                        const f32x2 g = p ? __builtin_shufflevector(acc[ai][0][m][n], acc[ai][0][m][n], 2, 3) : __builtin_shufflevector(acc[ai][0][m][n], acc[ai][0][m][n], 0, 1);
                        const f32x2 up = p ? __builtin_shufflevector(acc[ai][1][m][n], acc[ai][1][m][n], 2, 3) : __builtin_shufflevector(acc[ai][1][m][n], acc[ai][1][m][n], 0, 1);
                        const f32x2 t = g * up, x = g * KX;
                        f32x2 e; e.x = __builtin_amdgcn_exp2f(x.x); e.y = __builtin_amdgcn_exp2f(x.y);
                        const f32x2 d = e * IC + IC;
                        f32x2 r; r.x = __builtin_amdgcn_rcpf(d.x); r.y = __builtin_amdgcn_rcpf(d.y);
                        o[n][p] = t * r; }
                u32x2 w; w.x = pk4_fp8(o[0][0].x, o[0][0].y, o[0][1].x, o[0][1].y); w.y = pk4_fp8(o[1][0].x, o[1][0].y, o[1][1].x, o[1][1].y);
                *(u32x2*)(O + (size_t)(ai * 128 + m * 16) * 2048 + loff) = w; }
    }
};
struct JobDown {
    Ptrs P; int G, c; int K, lda, ldb;
    __device__ __forceinline__ bool next(int i, pg::GUnit& u) const {
        const int L = i * G + c; if (L >= 2048) return false;
        pg::xcd_map(L, 512, 4, u.pm, u.pn); u.job = 0;
        u.A = (const char*)(P.ws + WS_ACTB) + (size_t)u.pm * (256 * 2048);
        u.B = (const char*)(P.ws + WS_WD) + (size_t)(u.pm >> 5) * (1024 * 2048) + (size_t)u.pn * (256 * 2048); return true;
    }
    __device__ __forceinline__ const int* rows(const pg::GUnit&) const { return nullptr; }
    __device__ __forceinline__ void epi(const f32x4 (&acc)[2][2][4][2], const pg::GUnit& u, int wr, int wc, int fr, int fq) const {
        char* O = (char*)(P.ws + WS_YE) + (size_t)u.pm * 256 * 1024 + u.pn * 256;
        const unsigned loff = (unsigned)((wr * 64 + fr) * 1024 + wc * 32 + 8 * fq);
        constexpr float sc = YE8_SCALE / (W8_SCALE * ACT8_SCALE);
#pragma unroll
        for (int ai = 0; ai < 2; ++ai)
#pragma unroll
            for (int m = 0; m < 4; ++m)
#pragma unroll
                for (int bj = 0; bj < 2; ++bj) { const f32x4 a = acc[ai][bj][m][0] * sc, b2 = acc[ai][bj][m][1] * sc;
                    u32x2 w; w.x = pk4_fp8(a[0], a[1], a[2], a[3]); w.y = pk4_fp8(b2[0], b2[1], b2[2], b2[3]);
                    *(u32x2*)(O + (size_t)(ai * 128 + m * 16) * 1024 + bj * 128 + loff) = w; }
    }
};

namespace fa {
__device__ __forceinline__ void glds16(const void* g, LAS unsigned char* l) { __builtin_amdgcn_global_load_lds((const unsigned*)g, (LAS unsigned*)l, 16, 0, 0); }
__device__ __forceinline__ void glds16_s(const char* sbase, unsigned voff, unsigned ldsaddr) { unsigned keep;
    asm volatile("s_mov_b32 %0, m0\n\ts_mov_b32 m0, %3\n\ts_nop 0\n\tglobal_load_lds_dwordx4 %1, %2\n\ts_mov_b32 m0, %0" : "=&s"(keep) : "v"(voff), "s"(sbase), "s"(ldsaddr) : "memory"); }
__device__ __forceinline__ float max3f(float a, float b, float c) { float r; asm volatile("v_max3_f32 %0, %1, %2, %3" : "=v"(r) : "v"(a), "v"(b), "v"(c)); return r; }
#define FA_ROWMAX(_m, Y0, Y1) do { \
        float _g0 = __builtin_amdgcn_fmed3f(Y0[0], Y0[1], Y0[2]); asm volatile("" : "+v"(_g0)); \
        float _g1 = __builtin_amdgcn_fmed3f(Y1[0], Y1[1], Y1[2]); asm volatile("" : "+v"(_g1)); \
        _m = max3f(Y0[0], Y0[1], Y0[2]); float _m2 = max3f(Y1[0], Y1[1], Y1[2]); \
        _Pragma("unroll") for (int _r = 3; _r < 15; _r += 2) { _m = max3f(_m, Y0[_r], Y0[_r + 1]); _m2 = max3f(_m2, Y1[_r], Y1[_r + 1]); } \
        _m = max3f(_m, Y0[15], Y1[15]); _m = max3f(_m, _m2, _m2); { float _o = __shfl_xor(_m, 32); _m = max3f(_m, _o, _o); } } while (0)
constexpr float THR = 16.0f;
#define FA_SB() __builtin_amdgcn_sched_barrier(0)

template <int MODE>
__device__ __forceinline__ void flash_unit(LAS unsigned char* lds, const Ptrs& P, int b, int hd, int qblk, float lam) {
    constexpr bool DA = (MODE == 0);
    constexpr int NDB = DA ? 4 : 2;
    constexpr int NPV = 4 * NDB;
    constexpr int STG = DA ? 32768 : 16384, VOFF = DA ? 16384 : 8192;
    const int tid = threadIdx.x, lane = tid & 63, r32 = lane & 31, hi = lane >> 5, w = __builtin_amdgcn_readfirstlane(tid >> 6);
    int q0, qw, NT, tlo, ts, thi; bool notrack = false;
    const bf16_t *Qp, *Kp, *Vp; bf16_t* Op; int kld; float slope2;
    if constexpr (DA) {
        q0 = qblk * 128; const int map = w >> 2; qw = q0 + (w & 3) * 32;
        Qp = WSP(const bf16_t, WS_DAQ) + (size_t)(b * SEQ) * 1024 + hd * 128 + map * 64;
        Kp = WSP(const bf16_t, WS_DAK) + (size_t)(b * SEQ) * 1024 + hd * 128;
        Vp = WSP(const bf16_t, WS_DAVT) + (size_t)(hd * 128) * MTOK + (size_t)b * SEQ;
        Op = WSP(bf16_t, WS_DAQ) + (size_t)(b * SEQ) * 1024 + hd * 128;
        kld = 1024; NT = 32; tlo = 0; thi = 31; ts = q0 >> 6;
        slope2 = LOG2E * __builtin_amdgcn_exp2f(-(float)(hd + 1));
    } else {
        q0 = qblk * 256; qw = q0 + w * 32; const int kvh = hd >> 2;
        Qp = WSP(const bf16_t, WS_WAQ) + (size_t)(b * SEQ) * 1024 + hd * 64;
        Kp = WSP(const bf16_t, WS_WAK) + (size_t)(b * SEQ) * 256 + kvh * 64;
        Vp = WSP(const bf16_t, WS_WAVT) + (size_t)(kvh * 64) * MTOK + (size_t)b * SEQ;
        Op = WSP(bf16_t, WS_WAQ) + (size_t)(b * SEQ) * 1024 + hd * 64;
        kld = 256; tlo = 4 * qblk - 2; if (tlo < 0) tlo = 0; thi = 4 * qblk + 5; if (thi > 31) thi = 31; ts = 4 * qblk; NT = thi - tlo + 1;
        slope2 = LOG2E * __builtin_amdgcn_exp2f(-0.5f * (float)(hd + 1));
    }
    const int Rk = w * 8 + (lane >> 3), slot = lane & 7;
    const bf16_t* srcK0 = Kp + (size_t)Rk * kld + ((slot ^ ((Rk >> 1) & 7)) * 8);
    const bf16_t* srcV0 = Vp + (size_t)Rk * MTOK + ((slot ^ ((Rk >> 1) & 7)) * 8);
    const bf16_t* srcV1 = Vp + (size_t)(Rk + 64) * MTOK + ((slot ^ (((Rk + 64) >> 1) & 7)) * 8);
    const unsigned koffb = (unsigned)(Rk * kld + ((slot ^ ((Rk >> 1) & 7)) * 8)) * 2u;
    const unsigned voffb0 = (unsigned)(Rk * MTOK + ((slot ^ ((Rk >> 1) & 7)) * 8)) * 2u, voffb1 = (unsigned)((Rk + 64) * MTOK + ((slot ^ (((Rk + 64) >> 1) & 7)) * 8)) * 2u;
    const unsigned ldsw0 = (unsigned)__builtin_amdgcn_readfirstlane((int)((unsigned)(uintptr_t)lds + (unsigned)w * 1024u));
#define FA_DMAK(t, stg) do { LAS unsigned char* _s = lds + (stg) * STG; \
        if constexpr (DA) { const char* _kb = (const char*)Kp + (size_t)(t) * (64 * 1024 * 2); const unsigned _la = ldsw0 + (unsigned)((stg) * STG); \
            glds16_s(_kb, koffb, _la); glds16_s(_kb, koffb + 128u, _la + 8192u); } \
        else { glds16(srcK0 + (size_t)(t) * 64 * 256, _s + w * 1024); } } while (0)
#define FA_DMAV(t, stg) do { LAS unsigned char* _s = lds + (stg) * STG; \
        if constexpr (DA) { const char* _vb = (const char*)Vp + (size_t)(t) * 128; const unsigned _la = ldsw0 + (unsigned)((stg) * STG + VOFF); \
            glds16_s(_vb, voffb0, _la); glds16_s(_vb, voffb1, _la + 8192u); } \
        else { glds16(srcV0 + (t) * 64, _s + VOFF + w * 1024); } } while (0)
#define FA_TILE(i) ((ts + (i) <= thi) ? ts + (i) : tlo + ((i) - (thi - ts + 1)))
    FA_DMAK(FA_TILE(0), 0);
    bf16x8 qf[4];
    { const bf16_t* qp = Qp + (size_t)(qw + r32) * 1024 + hi * 8;
#pragma unroll
      for (int d = 0; d < 4; ++d) qf[d] = *(const bf16x8*)(qp + d * 16); }
    if constexpr (DA) {
        float qs = 0.f;
#pragma unroll
        for (int d = 0; d < 4; ++d)
#pragma unroll
            for (int jj = 0; jj < 8; ++jj) { const float x = __uint_as_float(((unsigned)(unsigned short)qf[d][jj]) << 16); qs += x * x; }
        qs += __shfl_xor(qs, 32);
#pragma unroll
        for (int off = 1; off < 32; off <<= 1) qs = fmaxf(qs, __shfl_xor(qs, off));
        volatile LAS float* qsc = (volatile LAS float*)(lds + MISC_OFF + 64);
        if (lane == 0) qsc[w] = qs;
        LDS_WAIT(); __builtin_amdgcn_s_barrier(); asm volatile("" ::: "memory");
        float qn2 = qsc[0];
#pragma unroll
        for (int i = 1; i < 8; ++i) qn2 = fmaxf(qn2, qsc[i]);
        const float kn2 = __uint_as_float(WSP(const unsigned, WS_KMAX)[b * 8 + hd]);
        const float qk = sqrtf(qn2 * kn2);
        notrack = __builtin_amdgcn_readfirstlane((int)(qk < 100.0f)) != 0;
        float wf = (46.0f + 2.0f * qk) / slope2; wf = fminf(wf, 4096.0f);
        const int W = __builtin_amdgcn_readfirstlane((int)wf + 1);
        tlo = (q0 - W) < 0 ? 0 : ((q0 - W) >> 6); thi = (q0 + 127 + W) >> 6; if (thi > 31) thi = 31;
        if (((thi - tlo) & 1) == 0) { if (thi < 31) ++thi; else --tlo; }
        NT = thi - tlo + 1;
    }
    const int krow = (r32 & 0x13) | ((r32 & 4) << 1) | ((r32 & 8) >> 1), ksw = (krow >> 1) & 7, vsw = (r32 >> 1) & 7;
    const LAS unsigned char* kp[4]; const LAS unsigned char* vp[4];
#pragma unroll
    for (int d = 0; d < 4; ++d) kp[d] = lds + (DA ? (w >> 2) * 8192 : 0) + krow * 128 + (((2 * d + hi) ^ ksw) * 16);
#pragma unroll
    for (int ks = 0; ks < 4; ++ks) vp[ks] = lds + r32 * 128 + (((4 * (ks >> 1) + 2 * (ks & 1) + hi) ^ vsw) * 16);
    f32x16 o[NDB];
#pragma unroll
    for (int d = 0; d < NDB; ++d) o[d] = (f32x16){0.f, 0.f, 0.f, 0.f, 0.f, 0.f, 0.f, 0.f, 0.f, 0.f, 0.f, 0.f, 0.f, 0.f, 0.f, 0.f};
    f32x16 A0, A1, B0, B1;
    B0 = o[0]; B1 = o[0];
    float mref = 0.f, negm = 0.f, l = 0.f, fsave = 1.f; bool resc = false;
    const int qpos = qw + r32; const float nslope = -slope2;
    u32x4 pk[4]; bf16x8 kf[4], vf[8];
#define FA_EL(X0, X1, e) (((e) < 16) ? X0[(e) & 15] : X1[(e) & 15])
#define FA_SETEL(X0, X1, e, v) do { if ((e) < 16) X0[(e) & 15] = (v); else X1[(e) & 15] = (v); } while (0)
#define FA_NOFF(e) (32 * ((e) >> 4) + 16 * (((e) & 15) >> 3) + ((e) & 7))
#define FA_BIAS1(X0, X1, e) do { const float _x = t0n - (float)FA_NOFF(e); float _c = __builtin_fmaf(nslope, __builtin_fabsf(_x), negm); \
        if constexpr (!DA) _c = (__builtin_fabsf(_x) > 128.0f) ? -1.0e30f : _c; asm volatile("" : "+v"(_c)); FA_SETEL(X0, X1, e, _c); } while (0)
#define FA_BIASC(X0, X1, e) do { float _c = __builtin_fmaf(bd1, (float)FA_NOFF(e), bbase); asm volatile("" : "+v"(_c)); FA_SETEL(X0, X1, e, _c); } while (0)
#define FA_T0(dst, t) do { float _t = (float)(qpos - 64 * (t) - 8 * hi); asm volatile("" : "+v"(_t)); dst = _t; } while (0)
#define FA_STEP(Y0, Y1, X0, X1, KS, VB, T, TN, HASN, TRK, PV, CH) do { \
        if (HASN) FA_DMAK(TN, (KS) ^ 1); \
        FA_DMAV(T, KS); \
        _Pragma("unroll") for (int _j = 0; _j < 4; ++_j) kf[_j] = *(const LAS bf16x8*)(kp[_j >> 1] + (KS) * STG + (_j & 1) * 4096); \
        if (PV) { _Pragma("unroll") for (int _f = 0; _f < 8; ++_f) vf[_f] = *(const LAS bf16x8*)(vp[DA ? (_f >> 2) : (_f >> 1)] + (VB) + (DA ? (_f & 3) : (_f & 1)) * 4096); } \
        float t0n; FA_T0(t0n, TN); \
        float sacc = 0.f; FA_SB(); \
        _Pragma("unroll") for (int _j = 0; _j < 8; ++_j) { \
            if (_j & 1) Y1 = __builtin_amdgcn_mfma_f32_32x32x16_bf16(kf[_j & 3], qf[_j >> 1], Y1, 0, 0, 0); \
            else        Y0 = __builtin_amdgcn_mfma_f32_32x32x16_bf16(kf[_j & 3], qf[_j >> 1], Y0, 0, 0, 0); \
            if (_j < 4) kf[_j] = *(const LAS bf16x8*)(kp[(_j + 4) >> 1] + (KS) * STG + (_j & 1) * 4096); \
            { const float _a = FA_EL(X0, X1, 4 * _j), _b = FA_EL(X0, X1, 4 * _j + 1), _c = FA_EL(X0, X1, 4 * _j + 2), _d = FA_EL(X0, X1, 4 * _j + 3); \
              sacc += (_a + _b) + (_c + _d); asm volatile("" : "+v"(sacc)); pk[_j >> 1][2 * (_j & 1)] = cvt_pk_bf16(_a, _b); pk[_j >> 1][2 * (_j & 1) + 1] = cvt_pk_bf16(_c, _d); } \
            FA_SB(); } \
        l += sacc; \
        if (TRK) { float _m; FA_ROWMAX(_m, Y0, Y1); resc = false; \
          if (__builtin_expect(__any(_m > THR), 0)) { const float _dl = fmaxf(_m, 0.f); mref += _dl; negm = -mref; fsave = __builtin_amdgcn_exp2f(-_dl); l *= fsave; resc = true; \
              _Pragma("unroll") for (int _r = 0; _r < 16; ++_r) { Y0[_r] -= _dl; Y1[_r] -= _dl; } } } \
        float bbase = 0.f, bd1 = 0.f; if (CH) { const float _sn = ((TN) > ts) ? -nslope : nslope; bbase = __builtin_fmaf(_sn, t0n, negm); bd1 = -_sn; } \
        FA_SB(); \
        _Pragma("unroll") for (int _i = 0; _i < NPV; ++_i) { \
            if (PV) { o[DA ? (_i & 3) : (_i & 1)] = __builtin_amdgcn_mfma_f32_32x32x16_bf16(vf[_i & 7], __builtin_bit_cast(bf16x8, pk[DA ? (_i >> 2) : (_i >> 1)]), o[DA ? (_i & 3) : (_i & 1)], 0, 0, 0); \
              if (DA && _i < 8) vf[_i] = *(const LAS bf16x8*)(vp[(_i + 8) >> 2] + (VB) + ((_i + 8) & 3) * 4096); } \
            _Pragma("unroll") for (int _e = 0; _e < 32 / NPV; ++_e) { const int _q = (32 / NPV) * _i + _e; \
                { float _ev = __builtin_amdgcn_exp2f(FA_EL(Y0, Y1, _q)); asm volatile("" : "+v"(_ev)); FA_SETEL(Y0, Y1, _q, _ev); } if (CH) FA_BIASC(X0, X1, _q); else FA_BIAS1(X0, X1, _q); } \
            FA_SB(); } \
        asm volatile("s_waitcnt vmcnt(0) lgkmcnt(0)" ::: "memory"); __builtin_amdgcn_s_barrier(); asm volatile("" ::: "memory"); \
        if (TRK && __builtin_expect(resc, 0)) { _Pragma("unroll") for (int _d = 0; _d < NDB; ++_d) _Pragma("unroll") for (int _r = 0; _r < 16; ++_r) o[_d][_r] *= fsave; } \
    } while (0)
    { float t0n; FA_T0(t0n, FA_TILE(0));
#pragma unroll
      for (int e = 0; e < 32; ++e) FA_BIAS1(A0, A1, e); }
    asm volatile("s_waitcnt vmcnt(0)" ::: "memory"); __builtin_amdgcn_s_barrier(); asm volatile("" ::: "memory");
    const bool trk = !(DA && notrack);
    { const int t0_ = FA_TILE(0), t1_ = FA_TILE(1), t2_ = FA_TILE(2);
      FA_STEP(A0, A1, B0, B1, 0, 0, t0_, t1_, true, trk, false, false);
      FA_STEP(B0, B1, A0, A1, 1, VOFF, t1_, t2_, true, trk, true, DA); }
    for (int i = 2; i < NT; i += 2) {
        const int ta = FA_TILE(i), tb = FA_TILE(i + 1), tc = (i + 2 < NT) ? FA_TILE(i + 2) : FA_TILE(i + 1);
        FA_STEP(A0, A1, B0, B1, 0, STG + VOFF, ta, tb, true, trk, true, DA);
        FA_STEP(B0, B1, A0, A1, 1, VOFF, tb, tc, (i + 2 < NT), trk, true, DA); }
    { float sacc = 0.f;
#pragma unroll
      for (int j = 0; j < 8; ++j) { const float a_ = FA_EL(B0, B1, 4 * j), b_ = FA_EL(B0, B1, 4 * j + 1), c_ = FA_EL(B0, B1, 4 * j + 2), d_ = FA_EL(B0, B1, 4 * j + 3);
          sacc += (a_ + b_) + (c_ + d_); pk[j >> 1][2 * (j & 1)] = cvt_pk_bf16(a_, b_); pk[j >> 1][2 * (j & 1) + 1] = cvt_pk_bf16(c_, d_); }
      l += sacc;
#pragma unroll
      for (int i = 0; i < NPV; ++i) { const int ks = DA ? (i >> 2) : (i >> 1), d = DA ? (i & 3) : (i & 1);
          const bf16x8 v = *(const LAS bf16x8*)(vp[ks] + STG + VOFF + d * 4096);
          o[d] = __builtin_amdgcn_mfma_f32_32x32x16_bf16(v, __builtin_bit_cast(bf16x8, pk[ks]), o[d], 0, 0, 0); } }
    LDS_WAIT(); __builtin_amdgcn_s_barrier(); asm volatile("" ::: "memory");
    l += __shfl_xor(l, 32);
    if constexpr (DA) {
        const float il = 1.0f / l;
        LAS float* ex = (LAS float*)lds + (w & 3) * 4096;
        if (w >= 4) {
#pragma unroll
            for (int d = 0; d < 4; ++d)
#pragma unroll
                for (int r = 0; r < 16; ++r) ex[(d * 16 + r) * 64 + lane] = o[d][r] * il;
        }
        LDS_WAIT(); __builtin_amdgcn_s_barrier(); asm volatile("" ::: "memory");
        if (w < 4) {
            float ss = 0.f;
#pragma unroll
            for (int d = 0; d < 4; ++d)
#pragma unroll
                for (int r = 0; r < 16; ++r) { const float v = o[d][r] * il - lam * ex[(d * 16 + r) * 64 + lane]; o[d][r] = v; ss += v * v; }
            ss += __shfl_xor(ss, 32);
            const float rs = (1.0f - LAM_INIT) * __builtin_amdgcn_rsqf(ss * (1.0f / 128.0f) + EPS);
            bf16_t* op = Op + (size_t)(qw + r32) * 1024;
#pragma unroll
            for (int d = 0; d < 4; ++d)
#pragma unroll
                for (int gp = 0; gp < 2; ++gp) { u32x2 pw[2];
#pragma unroll
                    for (int gg = 0; gg < 2; ++gg) { const int g = 2 * gp + gg, dd = d * 32 + 8 * g + 4 * hi; const f32x4 sg = *(const f32x4*)(P.subln_g + dd);
                        pw[gg].x = cvt_pk_bf16(o[d][4 * g] * rs * sg[0], o[d][4 * g + 1] * rs * sg[1]); pw[gg].y = cvt_pk_bf16(o[d][4 * g + 2] * rs * sg[2], o[d][4 * g + 3] * rs * sg[3]); }
                    const unsigned sx = hi ? pw[0].x : pw[1].x, sy = hi ? pw[0].y : pw[1].y;
                    const unsigned rx = (unsigned)__shfl_xor((int)sx, 32), ry = (unsigned)__shfl_xor((int)sy, 32);
                    u32x4 wv; if (hi) { wv.x = rx; wv.y = ry; wv.z = pw[1].x; wv.w = pw[1].y; } else { wv.x = pw[0].x; wv.y = pw[0].y; wv.z = rx; wv.w = ry; }
                    *(u32x4*)(op + d * 32 + 16 * gp + 8 * hi) = wv; }
        }
    } else {
        const float sink2 = P.wa_sink[hd] * LOG2E;
        const float lt = l + __builtin_amdgcn_exp2f(sink2 - mref);
        const float il = 1.0f / lt;
        bf16_t* op = Op + (size_t)(qw + r32) * 1024;
#pragma unroll
        for (int d = 0; d < 2; ++d)
#pragma unroll
            for (int g = 0; g < 4; ++g) { const int dd = d * 32 + 8 * g + 4 * hi;
                u32x2 wv; wv.x = cvt_pk_bf16(o[d][4 * g] * il, o[d][4 * g + 1] * il); wv.y = cvt_pk_bf16(o[d][4 * g + 2] * il, o[d][4 * g + 3] * il);
                *(u32x2*)(op + dd) = wv; }
    }
    asm volatile("s_waitcnt vmcnt(0) lgkmcnt(0)" ::: "memory"); __builtin_amdgcn_s_barrier(); asm volatile("" ::: "memory");
#undef FA_DMAK
#undef FA_DMAV
#undef FA_TILE
#undef FA_EL
#undef FA_SETEL
#undef FA_NOFF
#undef FA_BIAS1
#undef FA_BIASC
#undef FA_T0
#undef FA_STEP
}
#undef FA_SB
__device__ __forceinline__ void wa_group(LAS unsigned char* lds, const Ptrs& P, int b, int kvh, int qblk) {
    constexpr int NDB = 2, NPV = 8, TSZ = 16384, VOFF = 8192;
    const int tid = threadIdx.x, lane = tid & 63, r32 = lane & 31, hi = lane >> 5, w = __builtin_amdgcn_readfirstlane(tid >> 6);
    const int q0 = qblk * 256, qw = q0 + w * 32;
    int tlo = 4 * qblk - 2; if (tlo < 0) tlo = 0; int thi = 4 * qblk + 5; if (thi > 31) thi = 31; const int NTW = thi - tlo + 1;
    { const bf16_t* Kp = WSP(const bf16_t, WS_WAK) + (size_t)(b * SEQ) * 256 + kvh * 64;
      const bf16_t* Vp = WSP(const bf16_t, WS_WAVT) + (size_t)(kvh * 64) * MTOK + (size_t)b * SEQ;
      const int Rk = w * 8 + (lane >> 3), slot = lane & 7;
      const bf16_t* srcK0 = Kp + (size_t)Rk * 256 + ((slot ^ ((Rk >> 1) & 7)) * 8);
      const bf16_t* srcV0 = Vp + (size_t)Rk * MTOK + ((slot ^ ((Rk >> 1) & 7)) * 8);
      for (int j = 0; j < NTW; ++j) { const int t = tlo + j; glds16(srcK0 + (size_t)t * 64 * 256, lds + j * TSZ + w * 1024); glds16(srcV0 + t * 64, lds + j * TSZ + VOFF + w * 1024); } }
    int tw0 = (qw - 128) >> 6; const int tw0r = tw0; if (tw0 > thi - 4) tw0 = thi - 4; if (tw0 < tlo) tw0 = tlo;
    const bool regular = __builtin_amdgcn_readfirstlane((int)(tw0 == tw0r)) != 0;
    const int krow = (r32 & 0x13) | ((r32 & 4) << 1) | ((r32 & 8) >> 1), ksw = (krow >> 1) & 7, vsw = (r32 >> 1) & 7;
    const LAS unsigned char* kp[4]; const LAS unsigned char* vp[4];
#pragma unroll
    for (int d = 0; d < 4; ++d) kp[d] = lds + krow * 128 + (((2 * d + hi) ^ ksw) * 16);
#pragma unroll
    for (int ks = 0; ks < 4; ++ks) vp[ks] = lds + r32 * 128 + (((4 * (ks >> 1) + 2 * (ks & 1) + hi) ^ vsw) * 16);
    const int qpos = qw + r32;
    asm volatile("s_waitcnt vmcnt(0)" ::: "memory"); __builtin_amdgcn_s_barrier(); asm volatile("" ::: "memory");
    float kmx;
    { float kn2 = 0.f;
      if (w < NTW) { const LAS unsigned char* kr = lds + w * TSZ + lane * 128;
#pragma unroll
          for (int c = 0; c < 8; ++c) { const bf16x8 v = *(const LAS bf16x8*)(kr + c * 16);
#pragma unroll
              for (int jj = 0; jj < 8; ++jj) { const float x = __uint_as_float(((unsigned)(unsigned short)v[jj]) << 16); kn2 += x * x; } } }
#pragma unroll
      for (int off = 1; off < 64; off <<= 1) kn2 = fmaxf(kn2, __shfl_xor(kn2, off));
      volatile LAS float* ksc = (volatile LAS float*)(lds + MISC_OFF + 64);
      if (lane == 0) ksc[w] = kn2;
      LDS_WAIT(); __builtin_amdgcn_s_barrier(); asm volatile("" ::: "memory");
      kmx = ksc[0];
#pragma unroll
      for (int i = 1; i < 8; ++i) kmx = fmaxf(kmx, ksc[i]); }
#define FA_SB() __builtin_amdgcn_sched_barrier(0)
#define FA_EL(X0, X1, e) (((e) < 16) ? X0[(e) & 15] : X1[(e) & 15])
#define FA_SETEL(X0, X1, e, v) do { if ((e) < 16) X0[(e) & 15] = (v); else X1[(e) & 15] = (v); } while (0)
#define FA_NOFF(e) (32 * ((e) >> 4) + 16 * (((e) & 15) >> 3) + ((e) & 7))
#define FA_BIAS1(X0, X1, e) do { const float _x = t0n - (float)FA_NOFF(e); float _c = __builtin_fmaf(nslope, __builtin_fabsf(_x), negm); \
        _c = (__builtin_fabsf(_x) > 128.0f) ? -1.0e30f : _c; asm volatile("" : "+v"(_c)); FA_SETEL(X0, X1, e, _c); } while (0)
#define FW_BIAS(BM, SG, X0, X1, e) do { if ((BM) != 4) { float _c; \
        if ((BM) == 0 || (BM) == 2) { const float _x = t0n - (float)FA_NOFF(e); _c = __builtin_fmaf(nslope, __builtin_fabsf(_x), negm); \
            if ((BM) == 0) _c = (__builtin_fabsf(_x) > 128.0f) ? -1.0e30f : _c; } \
        else { _c = __builtin_fmaf(bd1, (float)FA_NOFF(e), bbase); \
            if ((BM) == 3) _c = (((SG) > 0) ? ((float)FA_NOFF(e) < blim) : ((float)FA_NOFF(e) > blim)) ? -1.0e30f : _c; } \
        asm volatile("" : "+v"(_c)); FA_SETEL(X0, X1, e, _c); } } while (0)
#define FA_T0(dst, t) do { float _t = (float)(qpos - 64 * (t) - 8 * hi); asm volatile("" : "+v"(_t)); dst = _t; } while (0)
#define FW_STEP(Y0, Y1, X0, X1, KOFF, VBOFF, TN, PV, BM, SG) do { \
        const LAS unsigned char* kq[4]; const LAS unsigned char* vq[4]; \
        _Pragma("unroll") for (int _d = 0; _d < 4; ++_d) { kq[_d] = kp[_d] + (KOFF); vq[_d] = vp[_d] + (VBOFF); } \
        _Pragma("unroll") for (int _j = 0; _j < 4; ++_j) kf[_j] = *(const LAS bf16x8*)(kq[_j >> 1] + (_j & 1) * 4096); \
        if (PV) { _Pragma("unroll") for (int _f = 0; _f < 8; ++_f) vf[_f] = *(const LAS bf16x8*)(vq[_f >> 1] + (_f & 1) * 4096); } \
        float t0n; FA_T0(t0n, TN); \
        float sacc = 0.f; FA_SB(); \
        _Pragma("unroll") for (int _j = 0; _j < 8; ++_j) { \
            if (_j & 1) Y1 = __builtin_amdgcn_mfma_f32_32x32x16_bf16(kf[_j & 3], qf[_j >> 1], Y1, 0, 0, 0); \
            else        Y0 = __builtin_amdgcn_mfma_f32_32x32x16_bf16(kf[_j & 3], qf[_j >> 1], Y0, 0, 0, 0); \
            if (_j < 4) kf[_j] = *(const LAS bf16x8*)(kq[(_j + 4) >> 1] + (_j & 1) * 4096); \
            { const float _a = FA_EL(X0, X1, 4 * _j), _b = FA_EL(X0, X1, 4 * _j + 1), _c = FA_EL(X0, X1, 4 * _j + 2), _d = FA_EL(X0, X1, 4 * _j + 3); \
              sacc += (_a + _b) + (_c + _d); asm volatile("" : "+v"(sacc)); pk[_j >> 1][2 * (_j & 1)] = cvt_pk_bf16(_a, _b); pk[_j >> 1][2 * (_j & 1) + 1] = cvt_pk_bf16(_c, _d); } \
            FA_SB(); } \
        l += sacc; \
        if (trk) { float _m; FA_ROWMAX(_m, Y0, Y1); resc = false; \
          if (__builtin_expect(__any(_m > THR), 0)) { const float _dl = fmaxf(_m, 0.f); mref += _dl; negm = -mref; fsave = __builtin_amdgcn_exp2f(-_dl); l *= fsave; resc = true; \
              _Pragma("unroll") for (int _r = 0; _r < 16; ++_r) { Y0[_r] -= _dl; Y1[_r] -= _dl; } } } \
        float bbase = 0.f, bd1 = 0.f, blim = 0.f; if ((BM) == 1 || (BM) == 3) { const float _sn = ((SG) > 0) ? nslope : -nslope; bbase = __builtin_fmaf(_sn, t0n, negm); bd1 = -_sn; blim = ((SG) > 0) ? t0n - 128.0f : t0n + 128.0f; } \
        FA_SB(); \
        _Pragma("unroll") for (int _i = 0; _i < NPV; ++_i) { \
            if (PV) o[_i & 1] = __builtin_amdgcn_mfma_f32_32x32x16_bf16(vf[_i], __builtin_bit_cast(bf16x8, pk[_i >> 1]), o[_i & 1], 0, 0, 0); \
            _Pragma("unroll") for (int _e = 0; _e < 4; ++_e) { const int _q = 4 * _i + _e; \
                { float _ev = __builtin_amdgcn_exp2f(FA_EL(Y0, Y1, _q)); asm volatile("" : "+v"(_ev)); FA_SETEL(Y0, Y1, _q, _ev); } FW_BIAS(BM, SG, X0, X1, _q); } \
            FA_SB(); } \
        if (trk && __builtin_expect(resc, 0)) { _Pragma("unroll") for (int _d = 0; _d < NDB; ++_d) _Pragma("unroll") for (int _r = 0; _r < 16; ++_r) o[_d][_r] *= fsave; } \
    } while (0)
    for (int hq = 0; hq < 4; ++hq) {
        const int hd = kvh * 4 + hq;
        const float slope2 = LOG2E * __builtin_amdgcn_exp2f(-0.5f * (float)(hd + 1)), nslope = -slope2;
        bf16x8 qf[4];
        { const bf16_t* qp = WSP(const bf16_t, WS_WAQ) + (size_t)(b * SEQ + qw + r32) * 1024 + hd * 64 + hi * 8;
#pragma unroll
          for (int d = 0; d < 4; ++d) qf[d] = *(const bf16x8*)(qp + d * 16); }
        bool trk;
        { float qs = 0.f;
#pragma unroll
          for (int d = 0; d < 4; ++d)
#pragma unroll
              for (int jj = 0; jj < 8; ++jj) { const float x = __uint_as_float(((unsigned)(unsigned short)qf[d][jj]) << 16); qs += x * x; }
          qs += __shfl_xor(qs, 32);
#pragma unroll
          for (int off = 1; off < 32; off <<= 1) qs = fmaxf(qs, __shfl_xor(qs, off));
          trk = __builtin_amdgcn_readfirstlane((int)(sqrtf(qs * kmx) < 100.0f)) == 0; }
        f32x16 o[NDB];
#pragma unroll
        for (int d = 0; d < NDB; ++d) o[d] = (f32x16){0.f, 0.f, 0.f, 0.f, 0.f, 0.f, 0.f, 0.f, 0.f, 0.f, 0.f, 0.f, 0.f, 0.f, 0.f, 0.f};
        f32x16 A0, A1, B0, B1; B0 = o[0]; B1 = o[0];
        float mref = 0.f, negm = 0.f, l = 0.f, fsave = 1.f; bool resc = false;
        u32x4 pk[4]; bf16x8 kf[4], vf[8];
        const int kb0 = (tw0 - tlo) * TSZ;
        if (regular) {
            { float t0n; FA_T0(t0n, tw0); const float bbase = __builtin_fmaf(nslope, t0n, negm), bd1 = -nslope, blim = t0n - 128.0f;
#pragma unroll
              for (int e = 0; e < 32; ++e) FW_BIAS(3, 1, A0, A1, e); }
            FW_STEP(A0, A1, B0, B1, kb0, kb0, tw0 + 1, false, 1, 1);
            FW_STEP(B0, B1, A0, A1, kb0 + TSZ, kb0 + VOFF, tw0 + 2, true, 2, 0);
            FW_STEP(A0, A1, B0, B1, kb0 + 2 * TSZ, kb0 + TSZ + VOFF, tw0 + 3, true, 1, -1);
            FW_STEP(B0, B1, A0, A1, kb0 + 3 * TSZ, kb0 + 2 * TSZ + VOFF, tw0 + 4, true, 3, -1);
            FW_STEP(A0, A1, B0, B1, kb0 + 4 * TSZ, kb0 + 3 * TSZ + VOFF, tw0 + 4, true, 4, 0);
        } else {
            { float t0n; FA_T0(t0n, tw0); const float bbase = 0.f, bd1 = 0.f, blim = 0.f;
#pragma unroll
              for (int e = 0; e < 32; ++e) FW_BIAS(0, 0, A0, A1, e); }
            FW_STEP(A0, A1, B0, B1, kb0, kb0, tw0 + 1, false, 0, 0);
            FW_STEP(B0, B1, A0, A1, kb0 + TSZ, kb0 + VOFF, tw0 + 2, true, 0, 0);
            FW_STEP(A0, A1, B0, B1, kb0 + 2 * TSZ, kb0 + TSZ + VOFF, tw0 + 3, true, 0, 0);
            FW_STEP(B0, B1, A0, A1, kb0 + 3 * TSZ, kb0 + 2 * TSZ + VOFF, tw0 + 4, true, 0, 0);
            FW_STEP(A0, A1, B0, B1, kb0 + 4 * TSZ, kb0 + 3 * TSZ + VOFF, tw0 + 4, true, 4, 0);
        }
        { float sacc = 0.f;
#pragma unroll
          for (int j = 0; j < 8; ++j) { const float a_ = FA_EL(A0, A1, 4 * j), b_ = FA_EL(A0, A1, 4 * j + 1), c_ = FA_EL(A0, A1, 4 * j + 2), d_ = FA_EL(A0, A1, 4 * j + 3);
              sacc += (a_ + b_) + (c_ + d_); pk[j >> 1][2 * (j & 1)] = cvt_pk_bf16(a_, b_); pk[j >> 1][2 * (j & 1) + 1] = cvt_pk_bf16(c_, d_); }
          l += sacc;
#pragma unroll
          for (int i = 0; i < NPV; ++i) { const int ks = i >> 1, d = i & 1;
              const bf16x8 v = *(const LAS bf16x8*)(vp[ks] + kb0 + 4 * TSZ + VOFF + d * 4096);
              o[d] = __builtin_amdgcn_mfma_f32_32x32x16_bf16(v, __builtin_bit_cast(bf16x8, pk[ks]), o[d], 0, 0, 0); } }
        l += __shfl_xor(l, 32);
        { const float sink2 = P.wa_sink[hd] * LOG2E;
          const float il = 1.0f / (l + __builtin_amdgcn_exp2f(sink2 - mref));
          bf16_t* op = WSP(bf16_t, WS_WAQ) + (size_t)(b * SEQ + qw + r32) * 1024 + hd * 64;
#pragma unroll
          for (int d = 0; d < 2; ++d)
#pragma unroll
              for (int gp = 0; gp < 2; ++gp) { u32x2 pw[2];
#pragma unroll
                  for (int gg = 0; gg < 2; ++gg) { const int g = 2 * gp + gg; pw[gg].x = cvt_pk_bf16(o[d][4 * g] * il, o[d][4 * g + 1] * il); pw[gg].y = cvt_pk_bf16(o[d][4 * g + 2] * il, o[d][4 * g + 3] * il); }
                  const unsigned sx = hi ? pw[0].x : pw[1].x, sy = hi ? pw[0].y : pw[1].y;
                  const unsigned rx = (unsigned)__shfl_xor((int)sx, 32), ry = (unsigned)__shfl_xor((int)sy, 32);
                  u32x4 wv; if (hi) { wv.x = rx; wv.y = ry; wv.z = pw[1].x; wv.w = pw[1].y; } else { wv.x = pw[0].x; wv.y = pw[0].y; wv.z = rx; wv.w = ry; }
                  *(u32x4*)(op + d * 32 + 16 * gp + 8 * hi) = wv; } }
    }
    asm volatile("s_waitcnt vmcnt(0) lgkmcnt(0)" ::: "memory"); __builtin_amdgcn_s_barrier(); asm volatile("" ::: "memory");
#undef FW_STEP
#undef FW_BIAS
#undef FA_EL
#undef FA_SETEL
#undef FA_NOFF
#undef FA_BIAS1
#undef FA_T0
#undef FA_SB
}
}

struct Frame { LAS unsigned char* lds; int tid, lane, wave, vcu, G; };

__device__ __forceinline__ void transpose_item(const float* W, int K, int N, bf16_t* WT, int k0, int n0, int drow0, LAS float* scr, int lane) {
    { float tv[32]; const float* wp = W + (size_t)(k0 + (lane >> 5)) * N + n0 + (lane & 31);
#pragma unroll
      for (int i = 0; i < 32; ++i) tv[i] = wp[(size_t)(2 * i) * N];
#pragma unroll
      for (int i = 0; i < 32; ++i) { const int kk = 2 * i + (lane >> 5); scr[kk * 33 + (lane & 31)] = tv[i]; } }
    LDS_WAIT(); asm volatile("" ::: "memory");
    const int c = lane & 7;
#pragma unroll
    for (int j = 0; j < 4; ++j) { const int n = (lane >> 3) + 8 * j; const LAS float* s = scr + (8 * c) * 33 + n;
        u32x4 o; o.x = cvt_pk_bf16(s[0 * 33], s[1 * 33]); o.y = cvt_pk_bf16(s[2 * 33], s[3 * 33]); o.z = cvt_pk_bf16(s[4 * 33], s[5 * 33]); o.w = cvt_pk_bf16(s[6 * 33], s[7 * 33]);
        *(u32x4*)(WT + (size_t)(drow0 + n) * K + k0 + 8 * c) = o; }
    LDS_WAIT(); asm volatile("" ::: "memory");
}
__device__ __forceinline__ void transpose_item_fp8(const float* W, int K, int N, unsigned char* WT, int k0, int n0, int drow0, float sc, LAS float* scr, int lane) {
    { float tv[32]; const float* wp = W + (size_t)(k0 + (lane >> 5)) * N + n0 + (lane & 31);
#pragma unroll
      for (int i = 0; i < 32; ++i) tv[i] = wp[(size_t)(2 * i) * N];
#pragma unroll
      for (int i = 0; i < 32; ++i) { const int kk = 2 * i + (lane >> 5); scr[kk * 33 + (lane & 31)] = tv[i]; } }
    LDS_WAIT(); asm volatile("" ::: "memory");
    const int c = lane & 7;
#pragma unroll
    for (int j = 0; j < 4; ++j) { const int n = (lane >> 3) + 8 * j; const LAS float* q = scr + (8 * c) * 33 + n;
        u32x2 o; o.x = pk4_fp8(q[0 * 33] * sc, q[1 * 33] * sc, q[2 * 33] * sc, q[3 * 33] * sc); o.y = pk4_fp8(q[4 * 33] * sc, q[5 * 33] * sc, q[6 * 33] * sc, q[7 * 33] * sc);
        *(u32x2*)(WT + (size_t)(drow0 + n) * K + k0 + 8 * c) = o; }
    LDS_WAIT(); asm volatile("" ::: "memory");
}
__device__ __forceinline__ int win_dst_row(int n) {
    if (n < 1024) return R_DAQ + n; if (n < 2048) return R_DAK + (n - 1024); if (n < 3072) return R_DAV + (n - 2048); if (n < 4096) return R_WAQ + (n - 3072);
    if (n < 4352) return R_WAK + (n - 4096); if (n < 4608) return R_WAV + (n - 4352); if (n < 5632) return R_XAQ + (n - 4608); return R_GATE + (n - 5632);
}
__device__ __forceinline__ void rms_row_to_bf16(const float* xrow, const float* g, bf16_t* orow, int lane, unsigned* orow8 = nullptr) {
    const f32x4* xr = (const f32x4*)xrow + lane; const f32x4* gr = (const f32x4*)g + lane;
    f32x4 v[4]; float s = 0.f;
#pragma unroll
    for (int j = 0; j < 4; ++j) { v[j] = xr[64 * j]; s += (v[j][0] * v[j][0] + v[j][1] * v[j][1]) + (v[j][2] * v[j][2] + v[j][3] * v[j][3]); }
    const float rstd = 1.0f / sqrtf(wave_sum(s) * (1.0f / 1024.0f) + EPS);
    u32x2* o8 = (u32x2*)orow + lane;
#pragma unroll
    for (int j = 0; j < 4; ++j) { const f32x4 gg = gr[64 * j]; u32x2 wv; wv.x = cvt_pk_bf16(v[j][0] * rstd * gg[0], v[j][1] * rstd * gg[1]); wv.y = cvt_pk_bf16(v[j][2] * rstd * gg[2], v[j][3] * rstd * gg[3]); if (orow) o8[64 * j] = wv;
        if (orow8) orow8[lane + 64 * j] = pk4_fp8(v[j][0] * rstd * gg[0], v[j][1] * rstd * gg[1], v[j][2] * rstd * gg[2], v[j][3] * rstd * gg[3]); }
}
template <int NR>
__device__ __forceinline__ void rms_rows(const float* x0, const float* g, bf16_t* o0, unsigned* o80, int lane) {
    const f32x4* gr = (const f32x4*)g + lane;
    f32x4 v[NR][4]; float rstd[NR];
#pragma unroll
    for (int r = 0; r < NR; ++r) { const f32x4* xr = (const f32x4*)(x0 + (size_t)r * 1024) + lane;
#pragma unroll
        for (int j = 0; j < 4; ++j) v[r][j] = xr[64 * j]; }
#pragma unroll
    for (int r = 0; r < NR; ++r) { float s = 0.f;
#pragma unroll
        for (int j = 0; j < 4; ++j) s += (v[r][j][0] * v[r][j][0] + v[r][j][1] * v[r][j][1]) + (v[r][j][2] * v[r][j][2] + v[r][j][3] * v[r][j][3]);
        rstd[r] = 1.0f / sqrtf(wave_sum(s) * (1.0f / 1024.0f) + EPS); }
#pragma unroll
    for (int j = 0; j < 4; ++j) { const f32x4 gg = gr[64 * j];
#pragma unroll
        for (int r = 0; r < NR; ++r) { const float a = v[r][j][0] * rstd[r] * gg[0], b = v[r][j][1] * rstd[r] * gg[1], c = v[r][j][2] * rstd[r] * gg[2], d = v[r][j][3] * rstd[r] * gg[3];
            if (o0) { u32x2 wv; wv.x = cvt_pk_bf16(a, b); wv.y = cvt_pk_bf16(c, d); ((u32x2*)(o0 + (size_t)r * 1024))[lane + 64 * j] = wv; }
            if (o80) o80[(size_t)r * 256 + lane + 64 * j] = pk4_fp8(a, b, c, d); } }
}
__device__ __forceinline__ void phase_prologue(Frame& F, const Ptrs& P) {
    LAS float* scr = (LAS float*)(F.lds + F.wave * 16384);
    const int gw = F.vcu * 8 + F.wave, NGW = F.G * 8;
    constexpr int I_IN = 16 * 272, I_KV = 16 * 64, I_SQ = 16 * 32;
    constexpr int NIT = I_IN + I_KV + 4 * I_SQ;
    for (int it = gw; it < NIT; it += NGW) {
        int r = it;
        if (r < I_IN) { const int kb = r / 272, nb = r % 272;
            if (WA_FP8 && 32 * nb >= 3072 && 32 * nb < 4608) transpose_item_fp8(P.w_in, 1024, INW, WSP(unsigned char, WS_WWA8), 64 * kb, 32 * nb, 32 * nb - 3072, W8_SCALE, scr, F.lane);
            else if (XA_FP8 && 32 * nb >= 4608 && 32 * nb < 5632) transpose_item_fp8(P.w_in, 1024, INW, WSP(unsigned char, WS_WXQ8), 64 * kb, 32 * nb, 32 * nb - 4608, W8_SCALE, scr, F.lane);
            else if (INPROJ_FP8) transpose_item_fp8(P.w_in, 1024, INW, WSP(unsigned char, WS_WIN), 64 * kb, 32 * nb, win_dst_row(32 * nb), W8_SCALE, scr, F.lane);
            else if (GATES_FP8 && 32 * nb >= 5632) transpose_item_fp8(P.w_in, 1024, INW, WSP(unsigned char, WS_WG8), 64 * kb, 32 * nb, 32 * nb - 5632, W8_SCALE, scr, F.lane);
            else transpose_item(P.w_in, 1024, INW, WSP(bf16_t, WS_WIN), 64 * kb, 32 * nb, win_dst_row(32 * nb), scr, F.lane);
            continue; } r -= I_IN;
        if (r < I_KV) { const int kb = r / 64, nb = r % 64;
            if (XA_FP8) transpose_item_fp8(P.w_mkv, 1024, 2048, WSP(unsigned char, WS_WMKV8), 64 * kb, 32 * nb, 32 * nb, W8_SCALE, scr, F.lane);
            else if (INPROJ_FP8) transpose_item_fp8(P.w_mkv, 1024, 2048, WSP(unsigned char, WS_WMKV), 64 * kb, 32 * nb, 32 * nb, W8_SCALE, scr, F.lane);
            else transpose_item(P.w_mkv, 1024, 2048, WSP(bf16_t, WS_WMKV), 64 * kb, 32 * nb, 32 * nb, scr, F.lane);
            continue; } r -= I_KV;
        const int which = r / I_SQ; r -= which * I_SQ; const int kb = r / 32, nb = r % 32;
        const float* src = which == 0 ? P.w_da_o : which == 1 ? P.w_wa_o : which == 2 ? P.w_xa_o : P.w_out;
        bf16_t* dst = which == 0 ? WSP(bf16_t, WS_WDAO) : which == 1 ? WSP(bf16_t, WS_WWAO) : which == 2 ? WSP(bf16_t, WS_WXAO) : WSP(bf16_t, WS_WOUT);
        if (XS_FP8 && which == 2) transpose_item_fp8(src, 1024, 1024, (unsigned char*)dst, 64 * kb, 32 * nb, 32 * nb, W8_SCALE, scr, F.lane);
        else transpose_item(src, 1024, 1024, dst, 64 * kb, 32 * nb, 32 * nb, scr, F.lane);
    }
    for (int m = 4 * gw; m < MTOK; m += 4 * NGW) rms_rows<4>(P.x + (size_t)m * 1024, P.attn_g, INPROJ_FP8 ? nullptr : WSP(bf16_t, WS_H) + (size_t)m * 1024, GATES_FP8 ? (unsigned*)((char*)P.out + 128 * MiB) + (size_t)m * 256 : nullptr, F.lane);
    for (int m = gw; m < MMEM; m += NGW) rms_row_to_bf16(P.mem + (size_t)m * 1024, P.mem_g, (INPROJ_FP8 || XA_FP8) ? nullptr : WSP(bf16_t, WS_MN) + (size_t)m * 1024, F.lane, XA_FP8 ? WSP(unsigned, WS_MN8) + (size_t)m * 256 : INPROJ_FP8 ? WSP(unsigned, WS_MN) + (size_t)m * 256 : nullptr);
    { u32x4* inv = WSP(u32x4, WS_INV); const int n16 = MTOK * 16 * 2 / 16;
      for (int i = F.vcu * 512 + F.tid; i < n16; i += F.G * 512) inv[i] = (u32x4){0xffffffffu, 0xffffffffu, 0xffffffffu, 0xffffffffu}; }
}

__device__ __forceinline__ void convert_expert_weights(Frame& F, const Ptrs& P, LAS float* scr);
__device__ __forceinline__ void phase_norm_router(Frame& F, const Ptrs& P) {
    LAS float* wl = (LAS float*)F.lds;
    LAS float* gl = wl + 64 * 260;
    for (int i = F.tid; i < 1024 * 16; i += 512) { const int k = i >> 4, e = i & 15; wl[(((k >> 4) & 3) * 16 + e) * 260 + (k >> 6) * 16 + (k & 15)] = P.w_router[i] * P.ffn_g[k]; }
    for (int i = F.tid; i < 1024; i += 512) gl[i] = P.ffn_g[i];
    __syncthreads();
    const int lane = F.lane, t = lane & 15, kq = lane >> 4;
    const LAS float* wrow = wl + (kq * 16 + t) * 260;
    const LAS float* grow = gl + kq * 16;
    LAS float* cscr = (LAS float*)(F.lds + 70656 + F.wave * 8448);
    static_assert(70656 + 8 * 8448 <= MISC_OFF, "conversion tiles overlap the barrier words");
    if (F.wave & 1) convert_expert_weights(F, P, cscr);
    for (int g = F.vcu * 8 + F.wave; g < MTOK / 16; g += F.G * 8) {
        const int m0 = 16 * g;
        const u32x4* xr = (const u32x4*)(WSP(const unsigned char, WS_X1) + (size_t)(m0 + t) * 2048 + kq * 32);
        u32x4 xp[32];
#pragma unroll
        for (int J = 0; J < 16; ++J) { xp[2 * J] = xr[8 * J]; xp[2 * J + 1] = xr[8 * J + 1]; }
        f32x4 a0 = (f32x4){0.f, 0.f, 0.f, 0.f}, a1 = a0; float ss = 0.f;
        f32x4 w0 = *(const LAS f32x4*)(wrow), w1 = *(const LAS f32x4*)(wrow + 4);
#pragma unroll
        for (int j = 0; j < 32; ++j) {
            asm volatile("" ::: "memory");
            const f32x4 w0n = *(const LAS f32x4*)(wrow + 8 * ((j + 1) & 31)), w1n = *(const LAS f32x4*)(wrow + 8 * ((j + 1) & 31) + 4);
            asm volatile("" : "+v"(xp[j]));
            const u32x4 d = xp[j];
            const float x0 = bf_lo(d.x), x1 = bf_hi(d.x), x2 = bf_lo(d.y), x3 = bf_hi(d.y), x4 = bf_lo(d.z), x5 = bf_hi(d.z), x6 = bf_lo(d.w), x7 = bf_hi(d.w);
            a0 = __builtin_amdgcn_mfma_f32_16x16x4f32(w0[0], x0, a0, 0, 0, 0); a1 = __builtin_amdgcn_mfma_f32_16x16x4f32(w0[1], x1, a1, 0, 0, 0);
            a0 = __builtin_amdgcn_mfma_f32_16x16x4f32(w0[2], x2, a0, 0, 0, 0); a1 = __builtin_amdgcn_mfma_f32_16x16x4f32(w0[3], x3, a1, 0, 0, 0);
            a0 = __builtin_amdgcn_mfma_f32_16x16x4f32(w1[0], x4, a0, 0, 0, 0); a1 = __builtin_amdgcn_mfma_f32_16x16x4f32(w1[1], x5, a1, 0, 0, 0);
            a0 = __builtin_amdgcn_mfma_f32_16x16x4f32(w1[2], x6, a0, 0, 0, 0); a1 = __builtin_amdgcn_mfma_f32_16x16x4f32(w1[3], x7, a1, 0, 0, 0);
            ss += ((x0 * x0 + x1 * x1) + (x2 * x2 + x3 * x3)) + ((x4 * x4 + x5 * x5) + (x6 * x6 + x7 * x7));
            w0 = w0n; w1 = w1n; __builtin_amdgcn_sched_barrier(0); }
        ss += __shfl_xor(ss, 16); ss += __shfl_xor(ss, 32);
        const float rstd = 1.0f / sqrtf(ss * (1.0f / 1024.0f) + EPS);
        const f32x4 lg = (a0 + a1) * rstd;
        float mx = fmaxf(fmaxf(lg[0], lg[1]), fmaxf(lg[2], lg[3])); mx = fmaxf(mx, __shfl_xor(mx, 16)); mx = fmaxf(mx, __shfl_xor(mx, 32));
        f32x4 ex; ex[0] = __expf(lg[0] - mx); ex[1] = __expf(lg[1] - mx); ex[2] = __expf(lg[2] - mx); ex[3] = __expf(lg[3] - mx);
        float den = (ex[0] + ex[1]) + (ex[2] + ex[3]); den += __shfl_xor(den, 16); den += __shfl_xor(den, 32);
        *(f32x4*)(WSP(float, WS_AFF) + (size_t)(m0 + t) * 16 + 4 * kq) = ex / den;
        unsigned char* hrow = WSP(unsigned char, WS_H2) + (size_t)(m0 + t) * 1024 + kq * 16;
#pragma unroll
        for (int J = 0; J < 16; ++J) { u32x4 o;
#pragma unroll
            for (int h = 0; h < 2; ++h) { asm volatile("" : "+v"(xp[2 * J + h]) :: "memory"); const u32x4 d = xp[2 * J + h];
                const f32x4 g0 = *(const LAS f32x4*)(grow + 64 * J + 8 * h), g1 = *(const LAS f32x4*)(grow + 64 * J + 8 * h + 4);
                const unsigned lo = pk4_fp8(bf_lo(d.x) * rstd * g0[0], bf_hi(d.x) * rstd * g0[1], bf_lo(d.y) * rstd * g0[2], bf_hi(d.y) * rstd * g0[3]);
                const unsigned hi = pk4_fp8(bf_lo(d.z) * rstd * g1[0], bf_hi(d.z) * rstd * g1[1], bf_lo(d.w) * rstd * g1[2], bf_hi(d.w) * rstd * g1[3]);
                if (h == 0) { o.x = lo; o.y = hi; } else { o.z = lo; o.w = hi; } }
            *(u32x4*)(hrow + 64 * J) = o; __builtin_amdgcn_sched_barrier(0); }
    }
    if (!(F.wave & 1)) convert_expert_weights(F, P, cscr);
}

__device__ __forceinline__ void convert_expert_weights(Frame& F, const Ptrs& P, LAS float* scr) {
    {
        const int gw = F.vcu * 8 + F.wave, NGW = F.G * 8;
        for (int it = gw; it < 3 * 16 * 1024; it += NGW) {
            const int mat = it >> 14, r = it & 16383, e = r >> 10, q = r & 1023;
            if (mat < 2) { const int kb = q >> 6, nb = q & 63, n0 = 32 * nb;
                transpose_item_fp8((mat == 0 ? P.w_eg : P.w_eu) + (size_t)e * 1024 * 2048, 1024, 2048, WSP(unsigned char, WS_WGU) + (size_t)e * 4096 * 1024, 64 * kb, n0, (n0 >> 7) * 256 + mat * 128 + (n0 & 127), W8_SCALE, scr, F.lane); }
            else { const int kb = q >> 5, nb = q & 31;
                transpose_item_fp8(P.w_ed + (size_t)e * 2048 * 1024, 2048, 1024, WSP(unsigned char, WS_WD) + (size_t)e * 1024 * 2048, 64 * kb, 32 * nb, 32 * nb, W8_SCALE, scr, F.lane); }
        }
    }
}
__device__ __forceinline__ void phase_topk_convert(Frame& F, const Ptrs& P) {
    LAS float* vals = (LAS float*)F.lds;
    LAS unsigned* hist = (LAS unsigned*)(F.lds + 8192);
    LAS unsigned* ctl = hist + 256;
    for (int task = F.vcu; task < NB * NEXP; task += F.G) {
        const int b = task >> 4, e = task & 15;
        __syncthreads();
        float v[4]; unsigned u[4];
#pragma unroll
        for (int j = 0; j < 4; ++j) { const int t = F.tid + 512 * j; v[j] = WSP(const float, WS_AFF)[(size_t)(b * SEQ + t) * 16 + e]; vals[t] = v[j]; u[j] = __float_as_uint(v[j]); }
        unsigned prefix = 0u, need = (unsigned)CAP;
        for (int pass = 0; pass < 4; ++pass) {
            const int shift = 24 - 8 * pass;
            if (F.tid < 256) hist[F.tid] = 0u;
            if (F.tid == 0) { ctl[2] = 0u; ctl[4] = 0u; }
            __syncthreads();
#pragma unroll
            for (int j = 0; j < 4; ++j) if (pass == 0 || (u[j] >> (shift + 8)) == prefix) __hip_atomic_fetch_add(&hist[(u[j] >> shift) & 255u], 1u, __ATOMIC_RELAXED, __HIP_MEMORY_SCOPE_WORKGROUP);
            __syncthreads();
            if (F.wave == 0) {
                const u32x4 h4 = *(const LAS u32x4*)(hist + 4 * F.lane);
                const unsigned sl = (h4.x + h4.y) + (h4.z + h4.w);
                unsigned S = sl;
#pragma unroll
                for (int off = 1; off < 64; off <<= 1) { const unsigned t = __shfl_down(S, off); S += (F.lane + off < 64) ? t : 0u; }
                const unsigned long long mk = __ballot(S >= need);
                const int L = 63 - __builtin_clzll(mk);
                if (F.lane == L) { unsigned c = S - sl; int d = 4 * L; unsigned bc = 0u;
                    if (c + h4.w >= need) { d = 4 * L + 3; bc = h4.w; } else { c += h4.w;
                    if (c + h4.z >= need) { d = 4 * L + 2; bc = h4.z; } else { c += h4.z;
                    if (c + h4.y >= need) { d = 4 * L + 1; bc = h4.y; } else { c += h4.y; d = 4 * L; bc = h4.x; } } }
                    ctl[0] = (prefix << 8) | (unsigned)d; ctl[1] = need - c; ctl[3] = bc; }
            }
            __syncthreads();
            prefix = ctl[0]; need = ctl[1];
        }
        const unsigned T = prefix, cnt_eq = ctl[3], ngt = (unsigned)CAP - need;
#pragma unroll
        for (int j = 0; j < 4; ++j) { const int t = F.tid + 512 * j; int slot = -1;
            if (u[j] > T) slot = (int)__hip_atomic_fetch_add(&ctl[2], 1u, __ATOMIC_RELAXED, __HIP_MEMORY_SCOPE_WORKGROUP);
            else if (u[j] == T) {
                if (cnt_eq == need) slot = (int)(ngt + __hip_atomic_fetch_add(&ctl[4], 1u, __ATOMIC_RELAXED, __HIP_MEMORY_SCOPE_WORKGROUP));
                else { unsigned eq = 0u; for (int i = 0; i < t; ++i) eq += (vals[i] == v[j]) ? 1u : 0u; if (eq < need) slot = (int)(ngt + eq); } }
            if (slot >= 0) {
                WSP(int, WS_IDX)[(b * 16 + e) * 256 + slot] = b * SEQ + t;
                WSP(float, WS_GL)[(b * 16 + e) * 256 + slot] = v[j];
                WSP(short, WS_INV)[(size_t)(b * SEQ + t) * 16 + e] = (short)slot; } }
    }
}

__device__ __forceinline__ void phase_final(Frame& F, const Ptrs& P) {
    constexpr int FR = 4;
    const int gw = F.vcu * 8 + F.wave, NGW = F.G * 8, lane = F.lane;
    const short* INV = WSP(const short, WS_INV); const float* GLp = WSP(const float, WS_GL); const unsigned* YEp = WSP(const unsigned, WS_YE);
    f32x4 gg[4];
#pragma unroll
    for (int j = 0; j < 4; ++j) gg[j] = ((const f32x4*)P.final_g)[lane + 64 * j];
    for (int m0 = gw; m0 < MTOK; m0 += FR * NGW) {
        int sl[FR]; u32x2 xq[FR][4]; unsigned yq[FR][4][4]; float glv[FR]; int ek[FR][4]; unsigned rest[FR];
#pragma unroll
        for (int r = 0; r < FR; ++r) { const int m = m0 + r * NGW; sl[r] = (m < MTOK && lane < 16) ? (int)INV[(size_t)m * 16 + lane] : -1; }
#pragma unroll
        for (int r = 0; r < FR; ++r) { const int m = m0 + r * NGW; if (m < MTOK) { const u32x2* xr = WSP(const u32x2, WS_X1) + (size_t)m * 256 + lane;
#pragma unroll
            for (int j = 0; j < 4; ++j) xq[r][j] = xr[64 * j]; } }
#pragma unroll
        for (int r = 0; r < FR; ++r) { const int m = m0 + r * NGW, b = m >> 11;
            unsigned mk = (unsigned)__ballot(sl[r] >= 0) & 0xffffu;
            glv[r] = (sl[r] >= 0) ? GLp[(b * 16 + lane) * 256 + sl[r]] : 0.f;
#pragma unroll
            for (int k = 0; k < 4; ++k) { ek[r][k] = mk ? (int)__builtin_ctz(mk) : -1; mk &= mk - 1u;
                if (ek[r][k] >= 0) { const int s_ = __builtin_amdgcn_readlane(sl[r], ek[r][k]); const unsigned* yr = YEp + (size_t)((ek[r][k] * 32 + b) * 256 + s_) * 256 + lane;
#pragma unroll
                    for (int j = 0; j < 4; ++j) yq[r][k][j] = yr[64 * j]; } }
            rest[r] = mk; }
#pragma unroll
        for (int r = 0; r < FR; ++r) { const int m = m0 + r * NGW, b = m >> 11; if (m >= MTOK) break;
            f32x4 v[4];
#pragma unroll
            for (int j = 0; j < 4; ++j) v[j] = (f32x4){bf_lo(xq[r][j].x), bf_hi(xq[r][j].x), bf_lo(xq[r][j].y), bf_hi(xq[r][j].y)};
#pragma unroll
            for (int k = 0; k < 4; ++k) if (ek[r][k] >= 0) { const float g = __uint_as_float((unsigned)__builtin_amdgcn_readlane((int)__float_as_uint(glv[r]), ek[r][k])) * (1.0f / YE8_SCALE);
#pragma unroll
                for (int j = 0; j < 4; ++j) { const int y = (int)yq[r][k][j]; const f32x2 lo = __builtin_amdgcn_cvt_pk_f32_fp8(y, false), hi2 = __builtin_amdgcn_cvt_pk_f32_fp8(y, true);
                    v[j][0] += g * lo[0]; v[j][1] += g * lo[1]; v[j][2] += g * hi2[0]; v[j][3] += g * hi2[1]; } }
            unsigned rs_ = rest[r];
            while (rs_) { const int e = (int)__builtin_ctz(rs_); rs_ &= rs_ - 1u;
                const int s2 = __builtin_amdgcn_readlane(sl[r], e); const float g = __uint_as_float((unsigned)__builtin_amdgcn_readlane((int)__float_as_uint(glv[r]), e)) * (1.0f / YE8_SCALE);
                const unsigned* yr = YEp + (size_t)((e * 32 + b) * 256 + s2) * 256 + lane;
#pragma unroll
                for (int j = 0; j < 4; ++j) { const int y = (int)yr[64 * j]; const f32x2 lo = __builtin_amdgcn_cvt_pk_f32_fp8(y, false), hi2 = __builtin_amdgcn_cvt_pk_f32_fp8(y, true);
                    v[j][0] += g * lo[0]; v[j][1] += g * lo[1]; v[j][2] += g * hi2[0]; v[j][3] += g * hi2[1]; } }
            float s = 0.f;
#pragma unroll
            for (int j = 0; j < 4; ++j) s += (v[j][0] * v[j][0] + v[j][1] * v[j][1]) + (v[j][2] * v[j][2] + v[j][3] * v[j][3]);
            const float rstd = 1.0f / sqrtf(wave_sum(s) * (1.0f / 1024.0f) + EPS);
            f32x4* orow = (f32x4*)(P.out + (size_t)m * 1024) + lane;
#pragma unroll
            for (int j = 0; j < 4; ++j) { f32x4 o; o[0] = v[j][0] * rstd * gg[j][0]; o[1] = v[j][1] * rstd * gg[j][1]; o[2] = v[j][2] * rstd * gg[j][2]; o[3] = v[j][3] * rstd * gg[j][3]; orow[64 * j] = o; } }
    }
}

constexpr int N_PHASES = 10;
struct Args { Ptrs P; int ph_lo, ph_hi; };
__global__ void __launch_bounds__(512, 2) fwd(Args args) {
    extern __shared__ __attribute__((aligned(16))) unsigned char lds_raw[];
    LAS unsigned char* lds = (LAS unsigned char*)lds_raw;
    const Ptrs& P = args.P;
    Frame F; F.lds = lds; F.tid = threadIdx.x; F.lane = F.tid & 63; F.wave = __builtin_amdgcn_readfirstlane(F.tid >> 6);
    F.G = gridDim.x; { const int bx = blockIdx.x; F.vcu = (F.G % 8 == 0) ? (bx % 8) * (F.G / 8) + bx / 8 : bx; }
    volatile LAS unsigned* MISC = (volatile LAS unsigned*)(lds + MISC_OFF);
    if (F.tid < 64) MISC[F.tid] = 0u;
    __syncthreads();
    XcdBarrier bar; bar.bar = WSP(unsigned, WS_CTL) + 1024; bar.x = 0; bar.st = nullptr;
    if (MK_N_LAUNCHES == 1) bar = xcd_barrier_post(WSP(unsigned, WS_CTL) + 1024, MISC + 8);
    const int lo = args.ph_lo, hi = args.ph_hi;
#ifndef PHMASK
#define PHMASK 0x3ff
#endif
#define IN(k) (((PHMASK >> (k)) & 1) && lo <= (k) && (k) < hi)
#define SEAM(k) do { if (IN(k) && IN((k) + 1)) xcd_barrier(bar); } while (0)

    if (IN(0)) { phase_prologue(F, P); } SEAM(0);
    if (IN(1)) { JobP1 J{P, F.G, (int)blockIdx.x, INPROJ_FP8 ? 512 : 1024, INPROJ_FP8 ? 512 : 1024, INPROJ_FP8 ? 512 : 1024, (LAS float*)(lds + EPI_OFF)}; pg::gemm_phase<JobP1, true, false, INPROJ_FP8 != 0>(lds, J);
        if (XA_FP8) { JobP1x Jx{P, F.G, (int)blockIdx.x, 512, 512, 512}; pg::gemm_phase<JobP1x, true, false, true>(lds, Jx); } } SEAM(1);
    if (IN(2)) {
        for (int i = 0; i < 4; ++i) { const int u_ = i * F.G + F.vcu; fa::wa_group(lds, P, u_ >> 5, (u_ >> 3) & 3, u_ & 7); }
        { JobXA J{P, F.G, (int)blockIdx.x, XS_FP8 ? 128 : 256, XS_FP8 ? 512 : 1024, XS_FP8 ? 512 : 1024, (LAS float*)(lds + EPI_OFF)}; pg::gemm_phase<JobXA, true, false, XS_FP8 != 0>(lds, J); }
        { JobMVW J{P, F.G, (int)blockIdx.x, XS_FP8 ? 128 : 256, XS_FP8 ? 512 : 1024, XS_FP8 ? 512 : 1024}; pg::gemm_phase<JobMVW, true, false, XS_FP8 != 0>(lds, J); }
        { float lam;
          { const float a = P.lq1[F.lane] * P.lk1[F.lane], b2 = P.lq2[F.lane] * P.lk2[F.lane];
            lam = __expf(wave_sum(a)) - __expf(wave_sum(b2)) + LAM_INIT; }
          const int g_ = F.vcu >> 4, qb0 = F.vcu & 15;
          for (int i = 0; i < 16; ++i) { const int ih = i & 7, ib = i >> 3; fa::flash_unit<0>(lds, P, 2 * g_ + ib, (ih + g_) & 7, (qb0 + 3 * ih + 8 * ib) & 15, lam); } }
    } SEAM(2);
    if (IN(3)) {
        { JobMergeG J{P, F.G, (int)blockIdx.x, GATES_FP8 ? 512 : 1024, GATES_FP8 ? 512 : 1024, GATES_FP8 ? 512 : 1024}; pg::gemm_phase<JobMergeG, true, false, GATES_FP8 != 0>(lds, J); }
        if (YC_FP8) { { JobMergeY J{P, F.G, (int)blockIdx.x, 1024, 1024, 1024, 1}; pg::gemm_phase<JobMergeY, true, false>(lds, J); }
                      { JobMergeY J{P, F.G, (int)blockIdx.x, 512, 512, 512, 2}; pg::gemm_phase<JobMergeY, true, false, true>(lds, J); } }
        else { JobMergeY J{P, F.G, (int)blockIdx.x, 1024, 1024, 1024, 0}; pg::gemm_phase<JobMergeY, true, false>(lds, J); }
    } SEAM(3);
    if (IN(4)) { JobOut J{P, F.G, (int)blockIdx.x, 1024, 1024, 1024}; pg::gemm_phase<JobOut, true, false>(lds, J); } SEAM(4);
    if (IN(5)) { phase_norm_router(F, P); } SEAM(5);
    if (IN(6)) { phase_topk_convert(F, P); } SEAM(6);
    if (IN(7)) { JobGU J{P, F.G, (int)blockIdx.x, 512, 512, 512}; pg::gemm_phase<JobGU, true, true, true>(lds, J); } SEAM(7);
    if (IN(8)) { JobDown J{P, F.G, (int)blockIdx.x, 1024, 1024, 1024}; pg::gemm_phase<JobDown, true, false, true>(lds, J); } SEAM(8);
    if (IN(9)) { phase_final(F, P); }
#undef IN
#undef SEAM
}

extern "C" void kernel_launch(void* const* d_in, const int* in_sizes, int n_in, void* d_out, int out_size, void* d_ws, size_t ws_size, hipStream_t stream) {
    static int grid = 0;
    if (grid == 0) {
        if (n_in != 22 || in_sizes[0] != MTOK * DM || out_size != MTOK * DM || ws_size < WS_END) {
            fprintf(stderr, "kernel_launch: unexpected shapes (n_in %d, in0 %d, out %d, ws %zu)\n", n_in, n_in > 0 ? in_sizes[0] : -1, out_size, ws_size); grid = -1; return; }
        int dev = 0, cus = 0;
        if (hipGetDevice(&dev) != hipSuccess || hipDeviceGetAttribute(&cus, hipDeviceAttributeMultiprocessorCount, dev) != hipSuccess) { grid = -1; return; }
        if (hipFuncSetAttribute((const void*)fwd, hipFuncAttributeMaxDynamicSharedMemorySize, LDS_BYTES) != hipSuccess) { fprintf(stderr, "kernel_launch: hipFuncSetAttribute failed\n"); grid = -1; return; }
        int per_cu = 0;
        if (hipOccupancyMaxActiveBlocksPerMultiprocessor(&per_cu, (const void*)fwd, 512, LDS_BYTES) != hipSuccess || per_cu < 1) fprintf(stderr, "kernel_launch: occupancy query says %d\n", per_cu);
        (void)hipGetLastError();
        grid = cus;
        if (grid != 256) fprintf(stderr, "kernel_launch: %d CUs (built for 256)\n", grid);
    }
    if (grid < 0) return;
    (void)hipMemsetAsync((char*)d_ws + WS_CTL, 0, CTL_ZERO_BYTES, stream);
    Args a{};
    Ptrs& P = a.P;
    P.x = (const float*)d_in[0]; P.mem = (const float*)d_in[1]; P.attn_g = (const float*)d_in[2]; P.mem_g = (const float*)d_in[3]; P.w_in = (const float*)d_in[4]; P.w_mkv = (const float*)d_in[5];
    P.lq1 = (const float*)d_in[6]; P.lk1 = (const float*)d_in[7]; P.lq2 = (const float*)d_in[8]; P.lk2 = (const float*)d_in[9]; P.subln_g = (const float*)d_in[10]; P.wa_sink = (const float*)d_in[11];
    P.w_da_o = (const float*)d_in[12]; P.w_wa_o = (const float*)d_in[13]; P.w_xa_o = (const float*)d_in[14]; P.w_out = (const float*)d_in[15]; P.ffn_g = (const float*)d_in[16]; P.w_router = (const float*)d_in[17];
    P.w_eg = (const float*)d_in[18]; P.w_eu = (const float*)d_in[19]; P.w_ed = (const float*)d_in[20]; P.final_g = (const float*)d_in[21];
    P.out = (float*)d_out; P.ws = (unsigned char*)d_ws;
    if (MK_N_LAUNCHES == 1) { a.ph_lo = 0; a.ph_hi = N_PHASES; hipLaunchKernelGGL(fwd, dim3(grid), dim3(512), LDS_BYTES, stream, a); }
    else { for (int p = 0; p < N_PHASES; ++p) { a.ph_lo = p; a.ph_hi = p + 1; hipLaunchKernelGGL(fwd, dim3(grid), dim3(512), LDS_BYTES, stream, a); } }
}
```

```cpp
#include <hip/hip_runtime.h>
#include <cstdio>
#include <cstdint>

#define GATES_FP8 1
#define INPROJ_FP8 0
#define XA_FP8 1
#define YC_FP8 1
#define WA_FP8 1
#define XS_FP8 1
constexpr float XQ8_SCALE = 16.0f;
constexpr float P8_SCALE = 256.0f, MVW8_SCALE = 8.0f;
#ifndef SG_U8
#define SG_U8 1
#endif
#ifndef FUSE_AB
#define FUSE_AB 1
#endif
#ifndef TAILQ
#define TAILQ 1
#endif
#ifndef GU_NSTAT
#define GU_NSTAT 26
#endif
#ifndef MK_N_LAUNCHES
#define MK_N_LAUNCHES 1
#endif

#define LAS __attribute__((address_space(3)))
#define GAS __attribute__((address_space(1)))
typedef unsigned short bf16_t;
typedef short bf16x8 __attribute__((ext_vector_type(8)));
typedef float f32x4 __attribute__((ext_vector_type(4)));
typedef float f32x2 __attribute__((ext_vector_type(2)));
typedef float f32x16 __attribute__((ext_vector_type(16)));
typedef unsigned u32x4 __attribute__((ext_vector_type(4)));
typedef unsigned u32x2 __attribute__((ext_vector_type(2)));

constexpr int DM = 1024, NB = 32, SEQ = 2048, MTOK = NB * SEQ;
constexpr int MEML = 256, MMEM = NB * MEML;
constexpr int NEXP = 16, CAP = 256, DEXP = 2048;
constexpr int INW = 8704;
constexpr float EPS = 1e-6f;
constexpr float LOG2E = 1.4426950408889634f;
constexpr float LAM_INIT = 0.2f;

constexpr size_t MiB = 1u << 20;
constexpr size_t WS_CTL = 0, CTL_ZERO_BYTES = 64 * 1024;
constexpr size_t WS_QCTR = 48 * 1024;
constexpr size_t WS_KMAX = 32 * 1024;
constexpr size_t WS_GL = 1 * MiB;
constexpr size_t WS_IDX = 1 * MiB + 512 * 1024;
constexpr size_t WS_INV = 2 * MiB;
constexpr size_t WS_WIN = 4 * MiB;
constexpr size_t WS_WMKV = 21 * MiB;
constexpr size_t WS_WDAO = 25 * MiB, WS_WWAO = 27 * MiB, WS_WXAO = 29 * MiB, WS_WOUT = 31 * MiB;
constexpr size_t WS_MN = 33 * MiB;
constexpr size_t WS_MK = 49 * MiB, WS_MV = 65 * MiB;
constexpr size_t WS_MVW = 81 * MiB;
constexpr size_t WS_AFF = 145 * MiB;
constexpr size_t WS_SG0 = 448 * MiB, WS_SG1 = 768 * MiB;
constexpr size_t WS_WXQ8 = 152 * MiB, WS_WMKV8 = 153 * MiB, WS_MN8 = 155 * MiB;
constexpr size_t WS_WWA8 = 163 * MiB;
constexpr size_t WS_WG8 = 149 * MiB;
constexpr size_t WS_ACT0 = 192 * MiB;
constexpr size_t WS_DAQ = 192 * MiB, WS_DAK = 320 * MiB, WS_DAVT = 448 * MiB, WS_WAQ = 576 * MiB, WS_WAK = 704 * MiB, WS_WAVT = 736 * MiB,
                 WS_XAQ = 768 * MiB, WS_H = 896 * MiB, WS_END = 1024 * MiB;
constexpr size_t WS_MERGED = WS_DAK;
constexpr size_t WS_X1 = 192 * MiB;
constexpr size_t WS_H2 = 320 * MiB;
constexpr size_t WS_WGU = 384 * MiB;
constexpr size_t WS_WD = 448 * MiB;
constexpr size_t WS_ACTB = 480 * MiB;
constexpr size_t WS_YE = 736 * MiB;

constexpr int R_DAQ = 0, R_DAK = 1024, R_WAQ = 2048, R_XAQ = 3072, R_WAK = 4096, R_DAV = 4352, R_WAV = 5376, R_GATE = 5632;

constexpr int RING_BYTES = 131072;
constexpr int EPI_OFF = RING_BYTES;
constexpr int MISC_OFF = RING_BYTES + 8192;
constexpr int LDS_BYTES = 147456;

#define LDS_WAIT() asm volatile("s_waitcnt lgkmcnt(0)" ::: "memory")
#define VM_WAIT() asm volatile("s_waitcnt vmcnt(0)" ::: "memory")
__device__ __forceinline__ unsigned cvt_pk_bf16(float lo, float hi) { unsigned r; asm volatile("v_cvt_pk_bf16_f32 %0, %1, %2" : "=v"(r) : "v"(lo), "v"(hi)); return r; }
typedef __bf16 bf16x2_t __attribute__((ext_vector_type(2)));
__device__ __forceinline__ unsigned cvt_pk_bf16_c(float lo, float hi) { f32x2 v; v.x = lo; v.y = hi; return __builtin_bit_cast(unsigned, __builtin_convertvector(v, bf16x2_t)); }
__device__ __forceinline__ float bf_lo(unsigned w) { return __uint_as_float(w << 16); }
__device__ __forceinline__ float bf_hi(unsigned w) { return __uint_as_float(w & 0xffff0000u); }
__device__ __forceinline__ float wave_sum(float v) {
#pragma unroll
    for (int o = 1; o < 64; o <<= 1) v += __shfl_xor(v, o);
    return v;
}
typedef int v8i __attribute__((ext_vector_type(8)));
typedef int v4i __attribute__((ext_vector_type(4)));
constexpr float W8_SCALE = 64.0f, ACT8_SCALE = 8.0f, YE8_SCALE = 8.0f;
__device__ __forceinline__ float clamp8(float v) { return fminf(fmaxf(v, -448.0f), 448.0f); }
__device__ __forceinline__ unsigned pk4_fp8(float a, float b, float c, float d) {
    int w = 0; w = __builtin_amdgcn_cvt_pk_fp8_f32(clamp8(a), clamp8(b), w, false); w = __builtin_amdgcn_cvt_pk_fp8_f32(clamp8(c), clamp8(d), w, true); return (unsigned)w; }
__device__ __forceinline__ float fast_sigmoid(float v) { return __builtin_amdgcn_rcpf(1.0f + __builtin_amdgcn_exp2f(-LOG2E * v)); }

#define XB_TMO      128
#define XB_XCNT(j)  (256  + 64 * (j))
#define XB_XSUB(j)  (1280 + 64 * (j))
#define XB_XGEN(j)  (2304 + 64 * (j))
#define XB_TOP      3328
#define XB_TOPGEN   3392
#define XCD_BAR_WORDS 3456
#define XB_SPIN_CAP (1u << 18)
__device__ __forceinline__ unsigned xb_ld(unsigned* p)              { return __hip_atomic_load(p, __ATOMIC_RELAXED, __HIP_MEMORY_SCOPE_AGENT); }
__device__ __forceinline__ unsigned xb_add(unsigned* p, unsigned v) { return __hip_atomic_fetch_add(p, v, __ATOMIC_RELAXED, __HIP_MEMORY_SCOPE_AGENT); }
__device__ __forceinline__ unsigned xb_xcc_id() { return (unsigned)__builtin_amdgcn_s_getreg((3 << 11) | 20) & 0xFu; }
#define XB_SPIN(cond, bar) do { unsigned _sp = 0; while (cond) { __builtin_amdgcn_s_sleep(1); \
    if ((++_sp & 255u) == 0u) { if (xb_ld(&(bar)[XB_TMO])) break; if (_sp > XB_SPIN_CAP) { atomicAdd(&(bar)[XB_TMO], 1u); break; } } } } while (0)
struct XcdBarrier { unsigned* bar; unsigned x; volatile LAS unsigned* st; };
__device__ __forceinline__ XcdBarrier xcd_barrier_post(unsigned* bar, volatile LAS unsigned* st) {
    XcdBarrier b; b.bar = bar; b.x = xb_xcc_id(); b.st = st;
    if (threadIdx.x == 0) (void)xb_add(&bar[XB_XCNT(b.x)], 1u);
    return b;
}
__device__ __forceinline__ void xcd_barrier_complete(unsigned* bar, unsigned x, unsigned& nloc, unsigned& nx) {
    const unsigned G = gridDim.x * gridDim.y * gridDim.z;
    unsigned sum, cnt, mine, sp = 0u;
    for (;;) {
        sum = 0u; cnt = 0u; mine = 0u;
#pragma unroll
        for (unsigned j = 0; j < 16; ++j) { const unsigned c = xb_ld(&bar[XB_XCNT(j)]); sum += c; cnt += (c > 0u) ? 1u : 0u; mine = (j == x) ? c : mine; }
        if (sum == G) break;
        __builtin_amdgcn_s_sleep(1);
        if ((++sp & 255u) == 0u) { if (xb_ld(&bar[XB_TMO])) break; if (sp > XB_SPIN_CAP) { atomicAdd(&bar[XB_TMO], 1u); break; } }
    }
    nloc = mine > 0u ? mine : 1u; nx = cnt > 0u ? cnt : 1u;
}
__device__ __forceinline__ void xcd_barrier(const XcdBarrier& b) {
    asm volatile("s_waitcnt vmcnt(0)" ::: "memory");
    __syncthreads();
    if (threadIdx.x == 0) {
        unsigned* bar = b.bar;
        __builtin_amdgcn_s_waitcnt(0);
        unsigned nloc = b.st[0], nx = b.st[1];
        if (nloc == 0u) { xcd_barrier_complete(bar, b.x, nloc, nx); b.st[0] = nloc; b.st[1] = nx; }
        const unsigned old = xb_add(&bar[XB_XSUB(b.x)], 1u);
        const unsigned gen = old / nloc;
        if (old + 1u == (gen + 1u) * nloc) {
            __builtin_amdgcn_fence(__ATOMIC_RELEASE, "agent");
            asm volatile("s_waitcnt vmcnt(0)" ::: "memory");
            const unsigned og = xb_add(&bar[XB_TOP], 1u);
            const unsigned tg = og / nx;
            if (og + 1u == (tg + 1u) * nx) xb_add(&bar[XB_TOPGEN], 1u);
            else XB_SPIN(xb_ld(&bar[XB_TOPGEN]) == tg, bar);
            __builtin_amdgcn_fence(__ATOMIC_ACQUIRE, "agent");
            xb_add(&bar[XB_XGEN(b.x)], 1u);
            asm volatile("s_waitcnt vmcnt(0)" ::: "memory");
        } else {
            XB_SPIN(xb_ld(&bar[XB_XGEN(b.x)]) == gen, bar);
            __builtin_amdgcn_fence(__ATOMIC_ACQUIRE, "agent");
            asm volatile("s_waitcnt vmcnt(0)" ::: "memory");
        }
    }
    __syncthreads();
}

namespace pg {
constexpr int BM = 256, BK = 64, HALF = 128, HTB = HALF * BK * 2, STAGE_BYTES = 8 * HTB, NXCD = 8, WGM = 8;
__host__ __device__ __forceinline__ int lds_byte(int r, int c) { const int st = (r >> 4) * 2 + (c >> 5), rr = r & 15, cc = c & 31, ob = rr * 64 + cc * 2; return st * 1024 + (ob ^ (((ob >> 9) & 1) << 5)); }
__host__ __device__ __forceinline__ void stage_rc(int b, int& R, int& C) { const int st = b / 1024, sb = b % 1024, swz = sb ^ (((sb >> 9) & 1) << 5); R = (st >> 1) * 16 + swz / 64; C = (st & 1) * 32 + (swz % 64) / 2; }
__host__ __device__ __forceinline__ int perm32(int rho) { const int n = rho >> 4, i = rho & 15; return 8 * (i >> 2) + 4 * n + (i & 3); }
__device__ __forceinline__ void xcd_map(int L, int nM, int nN, int& pm, int& pn) {
    const int nwg = nM * nN; int wgid = L;
    { const int q = nwg / NXCD, r = nwg % NXCD, xcd = wgid % NXCD, off = wgid / NXCD; wgid = (xcd < r ? xcd * (q + 1) : r * (q + 1) + (xcd - r) * q) + off; }
    const int nig = WGM * nN, gid = wgid / nig, fm = gid * WGM, gsz = (nM - fm) < WGM ? (nM - fm) : WGM;
    pm = fm + ((wgid % nig) % gsz); pn = (wgid % nig) / gsz;
}
struct GUnit { const char* A; const char* B; int pm, pn, job; };

#ifndef PG_SP2
#define PG_SP2 1
#endif
template <class Job> __device__ __forceinline__ bool pg_keep_acc(const Job&, const GUnit&) { return false; }
template <class Job, bool PERM, bool GATHER, bool FP8 = false, bool TAIL = false>
__device__ __forceinline__ void gemm_phase(LAS unsigned char* lds, const Job& J, int* qctr = nullptr, int nq = 0, int nstat = 0, int gG = 1, int gc = 0) {
    const int tid = threadIdx.x, wid = __builtin_amdgcn_readfirstlane(tid >> 6), lane = tid & 63, wr = wid >> 2, wc = wid & 3, fr = lane & 15, fq = lane >> 4;
    const int K = J.K, nt = K / BK, lda = J.lda, ldb = J.ldb;
    int R0, C0, R1, C1; stage_rc(tid * 16, R0, C0); stage_rc(tid * 16 + 8192, R1, C1);
    unsigned vA[2][2], vAn[2][2], vB[2];
    { const int Rb0 = PERM ? ((R0 & ~31) + perm32(R0 & 31)) : R0, Rb1 = PERM ? ((R1 & ~31) + perm32(R1 & 31)) : R1;
      vB[0] = (unsigned)(Rb0 * ldb + C0) * 2u; vB[1] = (unsigned)(Rb1 * ldb + C1) * 2u; }
    const size_t kstep = (size_t)(BK * 2);
    const size_t hstepB = (size_t)HALF * ldb * 2;
    const unsigned ldsw = (unsigned)wid * 1024u;
    const unsigned ldsb = (unsigned)__builtin_amdgcn_readfirstlane((int)((unsigned)(uintptr_t)lds + ldsw));
    const int aoff = lds_byte(wr * 64 + fr, fq * 8), boff = lds_byte(wc * 32 + fr, fq * 8);
#define PG_SA(b, h) (((b) * 2 + (h)) * HTB)
#define PG_SB(b, h) ((4 + (b) * 2 + (h)) * HTB)
#define PG_STAGE(bufoff, gbase, voff) do { _Pragma("unroll") for (int _i = 0; _i < 2; ++_i) { unsigned _keep; \
        asm volatile("s_mov_b32 %0, m0\n\ts_mov_b32 m0, %3\n\ts_nop 0\n\tglobal_load_lds_dwordx4 %1, %2\n\ts_mov_b32 m0, %0" \
            : "=&s"(_keep) : "v"((voff)[_i]), "s"((const char*)(gbase)), "s"(ldsb + (unsigned)((bufoff) + _i * 8192)) : "memory"); } } while (0)
#define PG_LDA(dst, b, h) do { _Pragma("unroll") for (int m = 0; m < 4; ++m) _Pragma("unroll") for (int k = 0; k < 2; ++k) dst[m][k] = *(const LAS bf16x8*)(lds + PG_SA(b, h) + aoff + m * 2048 + k * 1024); } while (0)
#define PG_LDB(dst, b, h) do { _Pragma("unroll") for (int n = 0; n < 2; ++n) _Pragma("unroll") for (int k = 0; k < 2; ++k) dst[n][k] = *(const LAS bf16x8*)(lds + PG_SB(b, h) + boff + n * 2048 + k * 1024); } while (0)
#define PG_CAT8(x) __builtin_shufflevector(__builtin_bit_cast(v4i, (x)[0]), __builtin_bit_cast(v4i, (x)[1]), 0, 1, 2, 3, 4, 5, 6, 7)
#define PG_MMA(ai, bj, At, Bt) do { __builtin_amdgcn_s_setprio(1); _Pragma("unroll") for (int m = 0; m < 4; ++m) _Pragma("unroll") for (int n = 0; n < 2; ++n) { \
        if constexpr (FP8) { asm volatile("v_mfma_scale_f32_16x16x128_f8f6f4 %0, %1, %2, %0, %3, %3 op_sel_hi:[0,0,0]" : "+v"(acc[ai][bj][m][n]) : "v"(PG_CAT8(Bt[n])), "v"(PG_CAT8(At[m])), "v"(sc8)); } \
        else { _Pragma("unroll") for (int k = 0; k < 2; ++k) acc[ai][bj][m][n] = __builtin_amdgcn_mfma_f32_16x16x32_bf16(Bt[n][k], At[m][k], acc[ai][bj][m][n], 0, 0, 0); } } \
        __builtin_amdgcn_s_setprio(0); } while (0)
#define PG_WAIT_V(n) asm volatile("s_waitcnt vmcnt(" #n ")" ::: "memory")
#define PG_WAIT_L(n) asm volatile("s_waitcnt lgkmcnt(" #n ")" ::: "memory")
#define PG_BAR __builtin_amdgcn_s_barrier()
#define PG_SCHED __builtin_amdgcn_sched_barrier(0)
#define PG_SETV(dst, u) do { if constexpr (GATHER) { const int* _rw = J.rows(u); \
        dst[0][0] = (unsigned)(_rw[R0] * lda + C0) * 2u; dst[0][1] = (unsigned)(_rw[R1] * lda + C1) * 2u; \
        dst[1][0] = (unsigned)(_rw[HALF + R0] * lda + C0) * 2u; dst[1][1] = (unsigned)(_rw[HALF + R1] * lda + C1) * 2u; } \
      else { dst[0][0] = (unsigned)(R0 * lda + C0) * 2u; dst[0][1] = (unsigned)(R1 * lda + C1) * 2u; \
        dst[1][0] = (unsigned)((HALF + R0) * lda + C0) * 2u; dst[1][1] = (unsigned)((HALF + R1) * lda + C1) * 2u; } } while (0)
    const int sc8 = 0x7f7f7f7f;
    GUnit cur, nxt; int ui = 0;
    int dq = (int)(blockIdx.x & 7), dtk = 0;
    volatile LAS int* dbx = (volatile LAS int*)(lds + MISC_OFF + 192);
#define PG_DRAW() __hip_atomic_fetch_add(qctr + dq * 16, 1, __ATOMIC_RELAXED, __HIP_MEMORY_SCOPE_AGENT)
#define PG_RESOLVE(tk, Lout) do { Lout = -1; if ((tk) < nq) Lout = nstat * gG + (tk) * 8 + dq; \
        else { for (int _try = 0; _try < 16 && Lout < 0; ++_try) { \
                   int _c[8]; _Pragma("unroll") for (int _k = 0; _k < 8; ++_k) _c[_k] = __hip_atomic_load(qctr + _k * 16, __ATOMIC_RELAXED, __HIP_MEMORY_SCOPE_AGENT); \
                   int _bq = -1, _bl = 0; _Pragma("unroll") for (int _k = 0; _k < 8; ++_k) { const int _left = nq - _c[_k]; if (_left > _bl) { _bl = _left; _bq = _k; } } \
                   if (_bq < 0) break; \
                   const int _t2 = __hip_atomic_fetch_add(qctr + _bq * 16, 1, __ATOMIC_RELAXED, __HIP_MEMORY_SCOPE_AGENT); \
                   if (_t2 < nq) { dq = _bq; Lout = nstat * gG + _t2 * 8 + _bq; } } } } while (0)
    if (!J.next(TAIL ? gc : 0, cur)) return;
    f32x4 acc[2][2][4][2];
#pragma unroll
    for (int a = 0; a < 2; ++a)
#pragma unroll
        for (int b = 0; b < 2; ++b)
#pragma unroll
            for (int m = 0; m < 4; ++m)
#pragma unroll
                for (int n = 0; n < 2; ++n) acc[a][b][m][n] = (f32x4){0.f, 0.f, 0.f, 0.f};
    bf16x8 At[4][2], B0[2][2], B1[2][2];
    const char* cA = cur.A; const char* cB = cur.B;
    PG_SETV(vA, cur);
    if (PG_SP2) {
    PG_STAGE(PG_SB(0, 0), cB, vB); PG_STAGE(PG_SB(0, 1), cB + hstepB, vB); PG_STAGE(PG_SA(0, 0), cA, vA[0]); PG_STAGE(PG_SA(0, 1), cA, vA[1]);
    if (wr == 1) PG_BAR;
    PG_WAIT_V(2); PG_BAR;
    PG_STAGE(PG_SB(1, 0), cB + kstep, vB); PG_STAGE(PG_SA(1, 0), cA + kstep, vA[0]); PG_STAGE(PG_SB(1, 1), cB + hstepB + kstep, vB);
    PG_WAIT_V(6); PG_BAR;
    } else {
    PG_STAGE(PG_SB(0, 0), cB, vB); PG_STAGE(PG_SA(0, 0), cA, vA[0]); PG_STAGE(PG_SB(0, 1), cB + hstepB, vB); PG_STAGE(PG_SA(0, 1), cA, vA[1]);
    if (wr == 1) PG_BAR;
    PG_WAIT_V(4); PG_BAR;
    PG_STAGE(PG_SB(1, 0), cB + kstep, vB); PG_STAGE(PG_SA(1, 0), cA + kstep, vA[0]); PG_STAGE(PG_SB(1, 1), cB + hstepB + kstep, vB);
    PG_WAIT_V(6); PG_BAR;
    }
    for (;;) {
        bool has_next;
        if constexpr (TAIL) {
            if (ui + 1 < nstat) has_next = J.next((ui + 1) * gG + gc, nxt);
            else {
                if (tid == 0) { int Ln; PG_RESOLVE(dtk, Ln); *dbx = Ln; }
                asm volatile("s_waitcnt lgkmcnt(0)" ::: "memory"); __builtin_amdgcn_s_barrier(); asm volatile("" ::: "memory");
                const int Ln = __builtin_amdgcn_readfirstlane(*dbx);
                has_next = Ln >= 0; if (has_next) J.next(Ln, nxt); }
        } else has_next = J.next(ui + 1, nxt);
        const char* nA = has_next ? nxt.A : cA; const char* nB = has_next ? nxt.B : cB;
        if constexpr (GATHER) { if (has_next) { PG_SETV(vAn, nxt); } else {
#pragma unroll
            for (int h = 0; h < 2; ++h) { vAn[h][0] = vA[h][0]; vAn[h][1] = vA[h][1]; } } }
        for (int t = 0; t < nt; t += 2) {
            const bool last = (t == nt - 2);
            const char* a1 = cA + (size_t)(t + 1) * kstep;
            const char* a2 = last ? nA : cA + (size_t)(t + 2) * kstep; const char* b2 = last ? nB : cB + (size_t)(t + 2) * kstep;
            const char* a3 = a2 + kstep; const char* b3 = b2 + kstep;
            unsigned vq[2][2];
#pragma unroll
            for (int h = 0; h < 2; ++h)
#pragma unroll
                for (int i = 0; i < 2; ++i) vq[h][i] = (GATHER && last) ? vAn[h][i] : vA[h][i];
            if (PG_SP2) {
            PG_LDB(B0, 0, 0); PG_LDB(B1, 0, 1); PG_SCHED; PG_LDA(At, 0, 0); PG_STAGE(PG_SA(1, 1), a1, vA[1]);
            PG_WAIT_V(8); PG_WAIT_L(0); PG_BAR; PG_MMA(0, 0, At, B0); PG_MMA(0, 1, At, B1); PG_BAR; PG_SCHED;
            PG_LDA(At, 0, 1); PG_STAGE(PG_SB(0, 0), b2, vB); PG_STAGE(PG_SB(0, 1), b2 + hstepB, vB); PG_STAGE(PG_SA(0, 0), a2, vq[0]);
            PG_WAIT_V(8); PG_WAIT_L(0); PG_BAR; PG_MMA(1, 0, At, B0); PG_MMA(1, 1, At, B1); PG_BAR; PG_SCHED;
            PG_LDB(B0, 1, 0); PG_LDB(B1, 1, 1); PG_SCHED; PG_LDA(At, 1, 0); PG_STAGE(PG_SA(0, 1), a2, vq[1]);
            PG_WAIT_V(8); PG_WAIT_L(0); PG_BAR; PG_MMA(0, 0, At, B0); PG_MMA(0, 1, At, B1); PG_BAR; PG_SCHED;
            PG_LDA(At, 1, 1); PG_STAGE(PG_SB(1, 0), b3, vB); PG_STAGE(PG_SB(1, 1), b3 + hstepB, vB); PG_STAGE(PG_SA(1, 0), a3, vq[0]);
            PG_WAIT_V(8); PG_WAIT_L(0); PG_BAR; PG_MMA(1, 0, At, B0); PG_MMA(1, 1, At, B1); PG_BAR; PG_SCHED;
            } else {
            PG_LDB(B0, 0, 0); PG_SCHED; PG_LDA(At, 0, 0); PG_STAGE(PG_SA(1, 1), a1, vA[1]);
            PG_WAIT_L(8); PG_BAR; PG_WAIT_L(0); PG_MMA(0, 0, At, B0); PG_BAR; PG_SCHED;
            PG_LDB(B1, 0, 1); PG_STAGE(PG_SB(0, 0), b2, vB);
            PG_BAR; PG_WAIT_L(0); PG_MMA(0, 1, At, B1); PG_BAR;
            PG_LDA(At, 0, 1); PG_STAGE(PG_SA(0, 0), a2, vq[0]);
            PG_BAR; PG_WAIT_L(0); PG_MMA(1, 0, At, B0); PG_BAR; PG_SCHED;
            PG_STAGE(PG_SB(0, 1), b2 + hstepB, vB);
            PG_WAIT_V(6); PG_BAR; PG_MMA(1, 1, At, B1); PG_BAR;
            PG_LDB(B0, 1, 0); PG_SCHED; PG_LDA(At, 1, 0); PG_STAGE(PG_SA(0, 1), a2, vq[1]);
            PG_WAIT_L(8); PG_BAR; PG_WAIT_L(0); PG_MMA(0, 0, At, B0); PG_BAR; PG_SCHED;
            PG_LDB(B1, 1, 1); PG_STAGE(PG_SB(1, 0), b3, vB);
            PG_BAR; PG_WAIT_L(0); PG_MMA(0, 1, At, B1); PG_BAR;
            PG_LDA(At, 1, 1); PG_STAGE(PG_SA(1, 0), a3, vq[0]);
            PG_BAR; PG_WAIT_L(0); PG_MMA(1, 0, At, B0); PG_BAR; PG_SCHED;
            PG_STAGE(PG_SB(1, 1), b3 + hstepB, vB);
            PG_WAIT_V(6); PG_BAR; PG_MMA(1, 1, At, B1); PG_BAR;
            }
        }
        if constexpr (FP8) asm volatile("s_nop 15\n\ts_nop 7" ::: "memory");
        if (wr == 0) PG_BAR;
        if constexpr (TAIL) { if (tid == 0 && has_next && ui + 2 >= nstat) dtk = PG_DRAW(); }
        J.epi(acc, cur, wr, wc, fr, fq);
        if (!has_next) break;
        if (!pg_keep_acc(J, cur)) {
#pragma unroll
        for (int a = 0; a < 2; ++a)
#pragma unroll
            for (int b = 0; b < 2; ++b)
#pragma unroll
                for (int m = 0; m < 4; ++m)
#pragma unroll
                    for (int n = 0; n < 2; ++n) acc[a][b][m][n] = (f32x4){0.f, 0.f, 0.f, 0.f};
        }
        cur = nxt; cA = nA; cB = nB; ++ui;
        if constexpr (GATHER) {
#pragma unroll
            for (int h = 0; h < 2; ++h) { vA[h][0] = vAn[h][0]; vA[h][1] = vAn[h][1]; } }
        if (wr == 1) PG_BAR;
    }
    PG_WAIT_V(0);
    PG_BAR;
#undef PG_SA
#undef PG_SB
#undef PG_STAGE
#undef PG_LDA
#undef PG_LDB
#undef PG_MMA
#undef PG_CAT8
#undef PG_WAIT_V
#undef PG_WAIT_L
#undef PG_BAR
#undef PG_SCHED
#undef PG_SETV
#undef PG_DRAW
#undef PG_RESOLVE
}

__device__ __forceinline__ void store_tile_bf16(const f32x4 (&acc)[2][2][4][2], bf16_t* O, int ldo, float sc, int wr, int wc, int fr, int fq) {
    const unsigned loff = (unsigned)((wr * 64 + fr) * ldo + wc * 32 + 8 * fq) * 2u;
#pragma unroll
    for (int ai = 0; ai < 2; ++ai)
#pragma unroll
        for (int m = 0; m < 4; ++m) { char* rowb = (char*)O + (size_t)(ai * HALF + m * 16) * ldo * 2;
#pragma unroll
            for (int bj = 0; bj < 2; ++bj) { const f32x4 v0 = acc[ai][bj][m][0] * sc, v1 = acc[ai][bj][m][1] * sc;
                u32x4 w; w.x = cvt_pk_bf16(v0[0], v0[1]); w.y = cvt_pk_bf16(v0[2], v0[3]); w.z = cvt_pk_bf16(v1[0], v1[1]); w.w = cvt_pk_bf16(v1[2], v1[3]);
                *(u32x4*)(rowb + bj * HALF * 2 + loff) = w; } }
}
}

struct Ptrs {
    const float* x; const float* mem; const float* attn_g; const float* mem_g; const float* w_in; const float* w_mkv;
    const float* lq1; const float* lk1; const float* lq2; const float* lk2; const float* subln_g; const float* wa_sink;
    const float* w_da_o; const float* w_wa_o; const float* w_xa_o; const float* w_out; const float* ffn_g; const float* w_router;
    const float* w_eg; const float* w_eu; const float* w_ed; const float* final_g;
    float* out; unsigned char* ws;
};
#define WSP(T, off) ((T*)(P.ws + (off)))

struct JobP1 {
    Ptrs P; int G, c; int K, lda, ldb; LAS float* scr;
    __device__ __forceinline__ bool next(int i, pg::GUnit& u) const {
        int L = i * G + c;
        constexpr size_t RB = INPROJ_FP8 ? 1024 : 2048;
        const char* h = INPROJ_FP8 ? (const char*)P.out + 128 * MiB : (const char*)(P.ws + WS_H); const char* w = (const char*)(P.ws + WS_WIN);
        if (XA_FP8 && WA_FP8) {
            if (L < 2048) { pg::xcd_map(L, 256, 8, u.pm, u.pn); u.job = 0; u.A = h + (size_t)u.pm * (256 * RB); u.B = w + (size_t)u.pn * (256 * RB); return true; }
            L -= 2048;
            if (L < 1024) { pg::xcd_map(L, 4, 256, u.pm, u.pn); u.job = 1; u.A = w + (size_t)(R_DAV + u.pm * 256) * RB; u.B = h + (size_t)u.pn * (256 * RB); return true; }
            return false;
        }
        if (XA_FP8) {
            if (L < 3328) { pg::xcd_map(L, 256, 13, u.pm, u.pn); if (u.pn == 12) u.pn = 16; u.job = 0; u.A = h + (size_t)u.pm * (256 * RB); u.B = w + (size_t)u.pn * (256 * RB); return true; }
            L -= 3328;
            if (L < 1280) { pg::xcd_map(L, 5, 256, u.pm, u.pn); u.job = 1; u.A = w + (size_t)(R_DAV + u.pm * 256) * RB; u.B = h + (size_t)u.pn * (256 * RB); return true; }
            return false;
        }
        if (L < 4352) { pg::xcd_map(L, 256, 17, u.pm, u.pn); u.job = 0; u.A = h + (size_t)u.pm * (256 * RB); u.B = w + (size_t)u.pn * (256 * RB); return true; }
        L -= 4352;
        if (L < 1280) { pg::xcd_map(L, 5, 256, u.pm, u.pn); u.job = 1; u.A = w + (size_t)(R_DAV + u.pm * 256) * RB; u.B = h + (size_t)u.pn * (256 * RB); return true; }
        L -= 1280;
        if (L < 256) { pg::xcd_map(L, 32, 8, u.pm, u.pn); u.job = 2; u.A = (const char*)(P.ws + WS_MN) + (size_t)u.pm * (256 * RB); u.B = (const char*)(P.ws + WS_WMKV) + (size_t)u.pn * (256 * RB); return true; }
        return false;
    }
    __device__ __forceinline__ const int* rows(const pg::GUnit&) const { return nullptr; }
    __device__ __forceinline__ void epi(const f32x4 (&acc)[2][2][4][2], const pg::GUnit& u, int wr, int wc, int fr, int fq) const {
        bf16_t* O; int ldo = 1024; float sc = INPROJ_FP8 ? (1.0f / W8_SCALE) : 1.f;
        if (u.job == 0) {
            const int s = u.pn >> 2, q = u.pn & 3;
            if (s == 0) { O = WSP(bf16_t, WS_DAQ) + (size_t)u.pm * 256 * 1024 + q * 256; sc *= 0.125f * LOG2E; }
            else if (s == 1) { O = WSP(bf16_t, WS_DAK) + (size_t)u.pm * 256 * 1024 + q * 256; }
            else if (s == 2) { O = WSP(bf16_t, WS_WAQ) + (size_t)u.pm * 256 * 1024 + q * 256; sc *= 0.125f * LOG2E; }
            else if (s == 3) { O = WSP(bf16_t, WS_XAQ) + (size_t)u.pm * 256 * 1024 + q * 256; sc *= 0.0625f * LOG2E; }
            else { O = WSP(bf16_t, WS_WAK) + (size_t)u.pm * 256 * 256; ldo = 256; }
        } else if (u.job == 1) {
            ldo = MTOK;
            if (u.pm < 4) O = WSP(bf16_t, WS_DAVT) + (size_t)u.pm * 256 * MTOK + (size_t)u.pn * 256;
            else O = WSP(bf16_t, WS_WAVT) + (size_t)u.pn * 256;
        } else {
            if (u.pn < 4) O = WSP(bf16_t, WS_MK) + (size_t)u.pm * 256 * 1024 + u.pn * 256;
            else O = WSP(bf16_t, WS_MV) + (size_t)u.pm * 256 * 1024 + (u.pn - 4) * 256;
        }
        pg::store_tile_bf16(acc, O, ldo, sc, wr, wc, fr, fq);
        if (u.job == 0 && (u.pn >> 2) == 1) {
            LAS float* X = scr;
#pragma unroll
            for (int ai = 0; ai < 2; ++ai)
#pragma unroll
                for (int m = 0; m < 4; ++m)
#pragma unroll
                    for (int bj = 0; bj < 2; ++bj) { const f32x4 a = acc[ai][bj][m][0] * sc, b2 = acc[ai][bj][m][1] * sc;
                        float q = (a[0] * a[0] + a[1] * a[1]) + (a[2] * a[2] + a[3] * a[3]) + (b2[0] * b2[0] + b2[1] * b2[1]) + (b2[2] * b2[2] + b2[3] * b2[3]);
                        q += __shfl_xor(q, 16); q += __shfl_xor(q, 32);
                        if (fq == 0) X[((ai * 128 + wr * 64 + m * 16 + fr) * 2 + bj) * 4 + wc] = q; }
            LDS_WAIT(); __builtin_amdgcn_s_barrier(); asm volatile("" ::: "memory");
            { const int t = threadIdx.x, row = t & 255, bj = t >> 8; const f32x4 q = *(const LAS f32x4*)(X + (row * 2 + bj) * 4);
              float v = fmaxf(q[0] + q[1], q[2] + q[3]) * 1.01f;
#pragma unroll
              for (int off = 1; off < 64; off <<= 1) v = fmaxf(v, __shfl_xor(v, off));
              if ((t & 63) == 0) __hip_atomic_fetch_max(WSP(unsigned, WS_KMAX) + (u.pm >> 3) * 8 + 2 * (u.pn - 4) + bj, __float_as_uint(v), __ATOMIC_RELAXED, __HIP_MEMORY_SCOPE_AGENT); }
            LDS_WAIT(); __builtin_amdgcn_s_barrier(); asm volatile("" ::: "memory");
        }
    }
};

struct JobP1x {
    Ptrs P; int G, c; int K, lda, ldb;
    __device__ __forceinline__ bool next(int i, pg::GUnit& u) const {
        int L = i * G + c;
        if (L < 1024) { pg::xcd_map(L, 256, 4, u.pm, u.pn); u.job = 0; u.A = (const char*)P.out + 128 * MiB + (size_t)u.pm * (256 * 1024); u.B = (const char*)(P.ws + WS_WXQ8) + (size_t)u.pn * (256 * 1024); return true; }
        L -= 1024;
        if (L < 256) { pg::xcd_map(L, 32, 8, u.pm, u.pn); u.job = 2; u.A = (const char*)(P.ws + WS_MN8) + (size_t)u.pm * (256 * 1024); u.B = (const char*)(P.ws + WS_WMKV8) + (size_t)u.pn * (256 * 1024); return true; }
        if (!WA_FP8) return false;
        L -= 256;
        const char* h8 = (const char*)P.out + 128 * MiB; const char* w8 = (const char*)(P.ws + WS_WWA8);
        if (L < 1280) { pg::xcd_map(L, 256, 5, u.pm, u.pn); u.job = 3; u.A = h8 + (size_t)u.pm * (256 * 1024); u.B = w8 + (size_t)u.pn * (256 * 1024); return true; }
        L -= 1280;
        if (L < 256) { u.pm = 0; u.pn = L; u.job = 4; u.A = w8 + (size_t)1280 * 1024; u.B = h8 + (size_t)u.pn * (256 * 1024); return true; }
        return false;
    }
    __device__ __forceinline__ const int* rows(const pg::GUnit&) const { return nullptr; }
    __device__ __forceinline__ void epi(const f32x4 (&acc)[2][2][4][2], const pg::GUnit& u, int wr, int wc, int fr, int fq) const {
        bf16_t* O; float sc = 1.0f / W8_SCALE;
        if (u.job >= 3) {
            int ldo = 1024;
            if (u.job == 4) { O = WSP(bf16_t, WS_WAVT) + (size_t)u.pn * 256; ldo = MTOK; }
            else if (u.pn < 4) { O = WSP(bf16_t, WS_WAQ) + (size_t)u.pm * 256 * 1024 + u.pn * 256; sc *= 0.125f * LOG2E; }
            else { O = WSP(bf16_t, WS_WAK) + (size_t)u.pm * 256 * 256; ldo = 256; }
            pg::store_tile_bf16(acc, O, ldo, sc, wr, wc, fr, fq);
            return; }
        if (u.job == 0) { O = WSP(bf16_t, WS_XAQ) + (size_t)u.pm * 256 * 1024 + u.pn * 256; sc *= 0.0625f * LOG2E; }
        else if (u.pn < 4) O = WSP(bf16_t, WS_MK) + (size_t)u.pm * 256 * 1024 + u.pn * 256;
        else O = WSP(bf16_t, WS_MV) + (size_t)u.pm * 256 * 1024 + (u.pn - 4) * 256;
        if (XS_FP8) {
            if (u.job == 0) sc *= XQ8_SCALE;
            char* O8 = (char*)(P.ws + (u.job == 0 ? WS_XAQ : (u.pn < 4 ? WS_MK : WS_MV))) + (size_t)u.pm * 256 * 1024 + (u.pn & 3) * 256;
            const unsigned loff = (unsigned)((wr * 64 + fr) * 1024 + wc * 32 + 8 * fq);
#pragma unroll
            for (int ai = 0; ai < 2; ++ai)
#pragma unroll
                for (int m = 0; m < 4; ++m)
#pragma unroll
                    for (int bj = 0; bj < 2; ++bj) { const f32x4 a = acc[ai][bj][m][0] * sc, b2 = acc[ai][bj][m][1] * sc;
                        u32x2 w; w.x = pk4_fp8(a[0], a[1], a[2], a[3]); w.y = pk4_fp8(b2[0], b2[1], b2[2], b2[3]);
                        *(u32x2*)(O8 + (size_t)(ai * 128 + m * 16) * 1024 + bj * 128 + loff) = w; }
            return; }
        pg::store_tile_bf16(acc, O, 1024, sc, wr, wc, fr, fq);
    }
};

struct JobXA {
    Ptrs P; int G, c; int K, lda, ldb; LAS float* scr;
    __device__ __forceinline__ bool next(int i, pg::GUnit& u) const {
        const int L = i * G + c; if (L >= 1024) return false;
        u.job = 0; u.pm = L >> 2; u.pn = L & 3;
        if (XS_FP8) { u.A = (const char*)(P.ws + WS_XAQ) + (size_t)u.pm * (256 * 1024) + u.pn * 256;
                      u.B = (const char*)(P.ws + WS_MK) + (size_t)(u.pm >> 3) * (256 * 1024) + u.pn * 256; return true; }
        u.A = (const char*)(P.ws + WS_XAQ) + (size_t)u.pm * (256 * 1024 * 2) + u.pn * 512;
        u.B = (const char*)(P.ws + WS_MK) + (size_t)(u.pm >> 3) * (256 * 1024 * 2) + u.pn * 512; return true;
    }
    __device__ __forceinline__ const int* rows(const pg::GUnit&) const { return nullptr; }
    __device__ __forceinline__ void epi(f32x4 (&acc)[2][2][4][2], const pg::GUnit& u, int wr, int wc, int fr, int fq) const {
        LAS f32x2* X = (LAS f32x2*)scr;
        if (XS_FP8) {
#pragma unroll
            for (int ai = 0; ai < 2; ++ai)
#pragma unroll
                for (int bj = 0; bj < 2; ++bj)
#pragma unroll
                    for (int m = 0; m < 4; ++m)
#pragma unroll
                        for (int n = 0; n < 2; ++n) acc[ai][bj][m][n] = acc[ai][bj][m][n] * (1.0f / XQ8_SCALE); }
        float lm[2][4];
#pragma unroll
        for (int ai = 0; ai < 2; ++ai)
#pragma unroll
            for (int m = 0; m < 4; ++m) { float v = -3.0e38f;
#pragma unroll
                for (int bj = 0; bj < 2; ++bj)
#pragma unroll
                    for (int n = 0; n < 2; ++n) { const f32x4 a = acc[ai][bj][m][n]; v = fmaxf(v, fmaxf(fmaxf(a[0], a[1]), fmaxf(a[2], a[3]))); }
                v = fmaxf(v, __shfl_xor(v, 16)); v = fmaxf(v, __shfl_xor(v, 32));
                float sm = 0.f;
#pragma unroll
                for (int bj = 0; bj < 2; ++bj)
#pragma unroll
                    for (int n = 0; n < 2; ++n) { f32x4 a = acc[ai][bj][m][n];
#pragma unroll
                        for (int j = 0; j < 4; ++j) { a[j] = __builtin_amdgcn_exp2f(a[j] - v); sm += a[j]; }
                        acc[ai][bj][m][n] = a; }
                sm += __shfl_xor(sm, 16); sm += __shfl_xor(sm, 32);
                lm[ai][m] = v; if (fq == 0) X[(ai * 128 + wr * 64 + m * 16 + fr) * 4 + wc] = (f32x2){v, sm}; }
        LDS_WAIT(); __builtin_amdgcn_s_barrier(); asm volatile("" ::: "memory");
#pragma unroll
        for (int ai = 0; ai < 2; ++ai)
#pragma unroll
            for (int m = 0; m < 4; ++m) { const LAS f32x2* xp = X + (ai * 128 + wr * 64 + m * 16 + fr) * 4;
                const f32x2 p0 = xp[0], p1 = xp[1], p2 = xp[2], p3 = xp[3];
                const float M = fmaxf(fmaxf(p0[0], p1[0]), fmaxf(p2[0], p3[0]));
                const float tot = (p0[1] * __builtin_amdgcn_exp2f(p0[0] - M) + p1[1] * __builtin_amdgcn_exp2f(p1[0] - M)) + (p2[1] * __builtin_amdgcn_exp2f(p2[0] - M) + p3[1] * __builtin_amdgcn_exp2f(p3[0] - M));
                const float f = __builtin_amdgcn_exp2f(lm[ai][m] - M) / tot;
#pragma unroll
                for (int bj = 0; bj < 2; ++bj)
#pragma unroll
                    for (int n = 0; n < 2; ++n) acc[ai][bj][m][n] = acc[ai][bj][m][n] * f; }
        if (YC_FP8) { char* O8 = (char*)P.out + (size_t)u.pm * 256 * 1024 + u.pn * 256; const unsigned loff = (unsigned)((wr * 64 + fr) * 1024 + wc * 32 + 8 * fq);
#pragma unroll
            for (int ai = 0; ai < 2; ++ai)
#pragma unroll
                for (int m = 0; m < 4; ++m)
#pragma unroll
                    for (int bj = 0; bj < 2; ++bj) { const f32x4 a = acc[ai][bj][m][0] * P8_SCALE, b2 = acc[ai][bj][m][1] * P8_SCALE;
                        u32x2 w; w.x = pk4_fp8(a[0], a[1], a[2], a[3]); w.y = pk4_fp8(b2[0], b2[1], b2[2], b2[3]);
                        *(u32x2*)(O8 + (size_t)(ai * 128 + m * 16) * 1024 + bj * 128 + loff) = w; } }
        else { bf16_t* O = (bf16_t*)P.out + (size_t)u.pm * 256 * 1024 + u.pn * 256;
            pg::store_tile_bf16(acc, O, 1024, 1.f, wr, wc, fr, fq); }
        LDS_WAIT(); __builtin_amdgcn_s_barrier(); asm volatile("" ::: "memory");
    }
};
struct JobMVW {
    Ptrs P; int G, c; int K, lda, ldb;
    __device__ __forceinline__ bool next(int i, pg::GUnit& u) const {
        const int L = i * G + c; if (L >= 512) return false;
        u.job = 0; u.pm = L & 3; u.pn = L >> 2;
        if (XS_FP8) { u.A = (const char*)(P.ws + WS_WXAO) + (size_t)u.pm * (256 * 1024) + (u.pn & 3) * 256;
                      u.B = (const char*)(P.ws + WS_MV) + (size_t)(u.pn >> 2) * (256 * 1024) + (u.pn & 3) * 256; return true; }
        u.A = (const char*)(P.ws + WS_WXAO) + (size_t)u.pm * (256 * 1024 * 2) + (u.pn & 3) * 512;
        u.B = (const char*)(P.ws + WS_MV) + (size_t)(u.pn >> 2) * (256 * 1024 * 2) + (u.pn & 3) * 512; return true;
    }
    __device__ __forceinline__ const int* rows(const pg::GUnit&) const { return nullptr; }
    __device__ __forceinline__ void epi(const f32x4 (&acc)[2][2][4][2], const pg::GUnit& u, int wr, int wc, int fr, int fq) const {
        if (YC_FP8) { char* O8 = (char*)(P.ws + WS_MVW) + (size_t)(u.pn >> 2) * (1024 * 1024) + (size_t)u.pm * 256 * 1024 + (u.pn & 3) * 256;
            const unsigned loff = (unsigned)((wr * 64 + fr) * 1024 + wc * 32 + 8 * fq);
#pragma unroll
            for (int ai = 0; ai < 2; ++ai)
#pragma unroll
                for (int m = 0; m < 4; ++m)
#pragma unroll
                    for (int bj = 0; bj < 2; ++bj) { const float ms = XS_FP8 ? MVW8_SCALE / W8_SCALE : MVW8_SCALE; const f32x4 a = acc[ai][bj][m][0] * ms, b2 = acc[ai][bj][m][1] * ms;
                        u32x2 w; w.x = pk4_fp8(a[0], a[1], a[2], a[3]); w.y = pk4_fp8(b2[0], b2[1], b2[2], b2[3]);
                        *(u32x2*)(O8 + (size_t)(ai * 128 + m * 16) * 1024 + bj * 128 + loff) = w; } }
        else { bf16_t* O = WSP(bf16_t, WS_MVW) + (size_t)(u.pn >> 2) * (1024 * 1024) + (size_t)u.pm * 256 * 1024 + (u.pn & 3) * 256;
            pg::store_tile_bf16(acc, O, 1024, 1.f, wr, wc, fr, fq); }
    }
};

__device__ __forceinline__ char* sg_base(const Ptrs& P, int br) {
    return br == 0 ? (char*)(P.ws + WS_SG0) : br == 1 ? (char*)(P.ws + WS_SG1) : (GATES_FP8 ? (char*)(P.ws + WS_H) : (char*)P.out + 128 * MiB);
}
struct JobMergeG {
    Ptrs P; int G, c; int K, lda, ldb;
    __device__ __forceinline__ bool next(int i, pg::GUnit& u) const {
        if (i >= 12) return false;
        const int ti = i / 3, br = i - ti * 3;
        pg::xcd_map(ti * G + c, 256, 4, u.pm, u.pn); u.job = br;
        if (GATES_FP8) { u.A = (const char*)P.out + 128 * MiB + (size_t)u.pm * (256 * 1024); u.B = (const char*)(P.ws + (INPROJ_FP8 ? WS_WIN + (size_t)R_GATE * 1024 : WS_WG8)) + (size_t)(br * 1024 + u.pn * 256) * 1024; }
        else { u.A = (const char*)(P.ws + WS_H) + (size_t)u.pm * (256 * 1024 * 2); u.B = (const char*)(P.ws + WS_WIN) + (size_t)(R_GATE + br * 1024 + u.pn * 256) * 2048; }
        return true;
    }
    __device__ __forceinline__ const int* rows(const pg::GUnit&) const { return nullptr; }
    __device__ __forceinline__ void epi(const f32x4 (&acc)[2][2][4][2], const pg::GUnit& u, int wr, int wc, int fr, int fq) const {
        constexpr int GB = SG_U8 ? 1 : 2;
        char* OB = sg_base(P, u.job) + ((size_t)u.pm * 256 * 1024 + u.pn * 256) * GB;
        const unsigned loff = (unsigned)((wr * 64 + fr) * 1024 + wc * 32 + 8 * fq) * (unsigned)GB;
        constexpr float sc = GATES_FP8 ? (1.0f / W8_SCALE) : 1.0f;
#pragma unroll
        for (int ai = 0; ai < 2; ++ai)
#pragma unroll
            for (int m = 0; m < 4; ++m)
#pragma unroll
                for (int bj = 0; bj < 2; ++bj) { const unsigned uo = (unsigned)((ai * 128 + m * 16) * 1024 + bj * 128) * (unsigned)GB;
                    const f32x4 a = acc[ai][bj][m][0] * (-LOG2E * sc), b = acc[ai][bj][m][1] * (-LOG2E * sc);
#define MG_SIG(v) __builtin_amdgcn_rcpf(1.0f + __builtin_amdgcn_exp2f(v))
                    if constexpr (SG_U8 != 0) {
#define MG_Q(v) __float_as_uint(__builtin_fmaf(MG_SIG(v), 255.0f, 8388608.0f))
                        u32x2 w8; w8.x = (MG_Q(a[0]) & 255u) | ((MG_Q(a[1]) & 255u) << 8) | ((MG_Q(a[2]) & 255u) << 16) | (MG_Q(a[3]) << 24);
                        w8.y = (MG_Q(b[0]) & 255u) | ((MG_Q(b[1]) & 255u) << 8) | ((MG_Q(b[2]) & 255u) << 16) | (MG_Q(b[3]) << 24);
#undef MG_Q
                        *(u32x2*)(OB + uo + loff) = w8; continue; }
                    u32x4 w; w.x = cvt_pk_bf16_c(MG_SIG(a[0]), MG_SIG(a[1])); w.y = cvt_pk_bf16_c(MG_SIG(a[2]), MG_SIG(a[3]));
                    w.z = cvt_pk_bf16_c(MG_SIG(b[0]), MG_SIG(b[1])); w.w = cvt_pk_bf16_c(MG_SIG(b[2]), MG_SIG(b[3]));
#undef MG_SIG
                    *(u32x4*)(OB + uo + loff) = w; }
    }
};
struct JobMergeY {
    Ptrs P; int G, c; int K, lda, ldb; int mode;
    __device__ __forceinline__ bool next(int i, pg::GUnit& u) const {
        int ti, br;
        if (mode == 0) { if (i >= 12) return false; ti = i / 3; br = i - ti * 3; }
        else if (mode == 1) { if (i >= 8) return false; ti = i >> 1; br = i & 1; }
        else { if (i >= 4) return false; ti = i; br = 2; }
        pg::xcd_map(ti * G + c, 256, 4, u.pm, u.pn); u.job = br;
        if (mode == 2) { u.A = (const char*)P.out + (size_t)u.pm * (256 * 1024); u.B = (const char*)(P.ws + WS_MVW) + (size_t)(u.pm >> 3) * (1024 * 1024) + (size_t)u.pn * (256 * 1024); return true; }
        if (br == 0) { u.A = (const char*)(P.ws + WS_DAQ) + (size_t)u.pm * (256 * 1024 * 2); u.B = (const char*)(P.ws + WS_WDAO) + (size_t)u.pn * (256 * 1024 * 2); }
        else if (br == 1) { u.A = (const char*)(P.ws + WS_WAQ) + (size_t)u.pm * (256 * 1024 * 2); u.B = (const char*)(P.ws + WS_WWAO) + (size_t)u.pn * (256 * 1024 * 2); }
        else { u.A = (const char*)P.out + (size_t)u.pm * (256 * 1024 * 2); u.B = (const char*)(P.ws + WS_MVW) + (size_t)(u.pm >> 3) * (1024 * 1024 * 2) + (size_t)u.pn * (256 * 1024 * 2); }
        return true;
    }
    __device__ __forceinline__ const int* rows(const pg::GUnit&) const { return nullptr; }
    __device__ __forceinline__ void epi(f32x4 (&acc)[2][2][4][2], const pg::GUnit& u, int wr, int wc, int fr, int fq) const {
        const size_t tileoff = ((size_t)u.pm * 256 * 1024 + u.pn * 256) * 2;
        if constexpr (SG_U8 != 0 && FUSE_AB != 0) {
            if (mode == 1) {
                const char* GA = sg_base(P, 0) + tileoff / 2; const char* GBp = sg_base(P, 1) + tileoff / 2; char* MG = (char*)(P.ws + WS_MERGED) + tileoff;
                const unsigned lo8 = (unsigned)((wr * 64 + fr) * 1024 + wc * 32 + 8 * fq);
#define MY_G(wd, k) ((float)(((wd) >> (8 * (k))) & 255u))
#pragma unroll
                for (int ai = 0; ai < 2; ++ai) {
                    u32x2 ga[4][2], gb[4][2];
#pragma unroll
                    for (int m = 0; m < 4; ++m)
#pragma unroll
                        for (int bj = 0; bj < 2; ++bj) { const unsigned uo8 = (unsigned)((ai * 128 + m * 16) * 1024 + bj * 128);
                            gb[m][bj] = __builtin_nontemporal_load((const u32x2*)(GBp + uo8 + lo8));
                            if (u.job == 0) ga[m][bj] = __builtin_nontemporal_load((const u32x2*)(GA + uo8 + lo8)); else ga[m][bj] = gb[m][bj]; }
#pragma unroll
                    for (int m = 0; m < 4; ++m)
#pragma unroll
                        for (int bj = 0; bj < 2; ++bj) { const unsigned uo8 = (unsigned)((ai * 128 + m * 16) * 1024 + bj * 128);
                            float nb[8], na[8];
#pragma unroll
                            for (int k = 0; k < 4; ++k) { nb[k] = fmaxf(MY_G(gb[m][bj].x, k), 1.0f); nb[4 + k] = fmaxf(MY_G(gb[m][bj].y, k), 1.0f); na[k] = MY_G(ga[m][bj].x, k); na[4 + k] = MY_G(ga[m][bj].y, k); }
                            if (u.job == 0) {
#pragma unroll
                                for (int k = 0; k < 4; ++k) { acc[ai][bj][m][0][k] *= na[k] * __builtin_amdgcn_rcpf(nb[k]); acc[ai][bj][m][1][k] *= na[4 + k] * __builtin_amdgcn_rcpf(nb[4 + k]); } }
                            else { const f32x4 a = acc[ai][bj][m][0] * (1.0f / 255.0f), b = acc[ai][bj][m][1] * (1.0f / 255.0f);
                                u32x4 w; w.x = cvt_pk_bf16(a[0] * nb[0], a[1] * nb[1]); w.y = cvt_pk_bf16(a[2] * nb[2], a[3] * nb[3]); w.z = cvt_pk_bf16(b[0] * nb[4], b[1] * nb[5]); w.w = cvt_pk_bf16(b[2] * nb[6], b[3] * nb[7]);
                                *(u32x4*)(MG + (size_t)(uo8 + lo8) * 2) = w; } }
                    asm volatile("" ::: "memory"); }
#undef MY_G
                return; }
        }
        const char* SGb = sg_base(P, u.job) + (SG_U8 ? tileoff / 2 : tileoff); char* MGb = (char*)(P.ws + WS_MERGED) + tileoff;
        const unsigned loff = (unsigned)((wr * 64 + fr) * 1024 + wc * 32 + 8 * fq) * 2u;
        const bool hasPrev = u.job != 0;
        const float ysc = ((mode == 2) ? 1.0f / (P8_SCALE * MVW8_SCALE) : 1.0f) * (SG_U8 ? 1.0f / 255.0f : 1.0f);
#pragma unroll
        for (int ai = 0; ai < 2; ++ai) {
            u32x4 g[4][2], pv[4][2];
#pragma unroll
            for (int m = 0; m < 4; ++m)
#pragma unroll
                for (int bj = 0; bj < 2; ++bj) { const unsigned uo = (unsigned)((ai * 128 + m * 16) * 1024 + bj * 128) * 2u;
                    if constexpr (SG_U8 != 0) { const u32x2 g8 = __builtin_nontemporal_load((const u32x2*)(SGb + (uo + loff) / 2)); g[m][bj] = (u32x4){g8.x, g8.y, 0u, 0u}; }
                    else g[m][bj] = __builtin_nontemporal_load((const u32x4*)(SGb + uo + loff));
                    pv[m][bj] = (u32x4){0u, 0u, 0u, 0u};
                    if (hasPrev) pv[m][bj] = __builtin_nontemporal_load((const u32x4*)(MGb + uo + loff)); }
#pragma unroll
            for (int m = 0; m < 4; ++m)
#pragma unroll
                for (int bj = 0; bj < 2; ++bj) { const unsigned uo = (unsigned)((ai * 128 + m * 16) * 1024 + bj * 128) * 2u;
                    const f32x4 a = acc[ai][bj][m][0] * ysc, b = acc[ai][bj][m][1] * ysc;
                    const u32x4 gq = g[m][bj], pq = pv[m][bj];
                    u32x4 w;
                    if constexpr (SG_U8 != 0) {
#define MY_G(wd, k) ((float)(((wd) >> (8 * (k))) & 255u))
                        w.x = cvt_pk_bf16(bf_lo(pq.x) + MY_G(gq.x, 0) * a[0], bf_hi(pq.x) + MY_G(gq.x, 1) * a[1]);
                        w.y = cvt_pk_bf16(bf_lo(pq.y) + MY_G(gq.x, 2) * a[2], bf_hi(pq.y) + MY_G(gq.x, 3) * a[3]);
                        w.z = cvt_pk_bf16(bf_lo(pq.z) + MY_G(gq.y, 0) * b[0], bf_hi(pq.z) + MY_G(gq.y, 1) * b[1]);
                        w.w = cvt_pk_bf16(bf_lo(pq.w) + MY_G(gq.y, 2) * b[2], bf_hi(pq.w) + MY_G(gq.y, 3) * b[3]);
#undef MY_G
                        *(u32x4*)(MGb + uo + loff) = w; continue; }
                    w.x = cvt_pk_bf16(bf_lo(pq.x) + bf_lo(gq.x) * a[0], bf_hi(pq.x) + bf_hi(gq.x) * a[1]);
                    w.y = cvt_pk_bf16(bf_lo(pq.y) + bf_lo(gq.y) * a[2], bf_hi(pq.y) + bf_hi(gq.y) * a[3]);
                    w.z = cvt_pk_bf16(bf_lo(pq.z) + bf_lo(gq.z) * b[0], bf_hi(pq.z) + bf_hi(gq.z) * b[1]);
                    w.w = cvt_pk_bf16(bf_lo(pq.w) + bf_lo(gq.w) * b[2], bf_hi(pq.w) + bf_hi(gq.w) * b[3]);
                    *(u32x4*)(MGb + uo + loff) = w; }
            asm volatile("" ::: "memory"); }
    }
};
__device__ __forceinline__ bool pg_keep_acc(const JobMergeY& J, const pg::GUnit& u) { return SG_U8 != 0 && FUSE_AB != 0 && J.mode == 1 && u.job == 0; }

struct JobOut {
    Ptrs P; int G, c; int K, lda, ldb;
    __device__ __forceinline__ bool next(int i, pg::GUnit& u) const {
        const int L = i * G + c; if (L >= 1024) return false;
        pg::xcd_map(L, 256, 4, u.pm, u.pn); u.job = 0;
        u.A = (const char*)(P.ws + WS_MERGED) + (size_t)u.pm * (256 * 1024 * 2); u.B = (const char*)(P.ws + WS_WOUT) + (size_t)u.pn * (256 * 1024 * 2); return true;
    }
    __device__ __forceinline__ const int* rows(const pg::GUnit&) const { return nullptr; }
    __device__ __forceinline__ void epi(const f32x4 (&acc)[2][2][4][2], const pg::GUnit& u, int wr, int wc, int fr, int fq) const {
        const int row0 = u.pm * 256 + wr * 64 + fr, col0 = u.pn * 256 + wc * 32 + 8 * fq;
#pragma unroll
        for (int ai = 0; ai < 2; ++ai)
#pragma unroll
            for (int m = 0; m < 4; ++m) { const size_t off = (size_t)(row0 + ai * 128 + m * 16) * 1024 + col0;
#pragma unroll
                for (int bj = 0; bj < 2; ++bj) { const f32x4 x0 = *(const f32x4*)(P.x + off + bj * 128), x1 = *(const f32x4*)(P.x + off + bj * 128 + 4);
                    const f32x4 v0 = x0 + acc[ai][bj][m][0], v1 = x1 + acc[ai][bj][m][1];
                    u32x4 w; w.x = cvt_pk_bf16(v0[0], v0[1]); w.y = cvt_pk_bf16(v0[2], v0[3]); w.z = cvt_pk_bf16(v1[0], v1[1]); w.w = cvt_pk_bf16(v1[2], v1[3]);
                    *(u32x4*)(WSP(bf16_t, WS_X1) + off + bj * 128) = w; } }
    }
};
struct JobGU {
    Ptrs P; int G, c; int K, lda, ldb;
    __device__ __forceinline__ bool next(int i, pg::GUnit& u) const {
        const int L = i * G + c; if (L >= 8192) return false;
        pg::xcd_map(L, 512, 16, u.pm, u.pn); u.job = 0;
        u.A = (const char*)(P.ws + WS_H2);
        u.B = (const char*)(P.ws + WS_WGU) + (size_t)(u.pm >> 5) * (4096 * 1024) + (size_t)u.pn * (256 * 1024); return true;
    }
    __device__ __forceinline__ const int* rows(const pg::GUnit& u) const { const int e = u.pm >> 5, b = u.pm & 31; return WSP(const int, WS_IDX) + (b * 16 + e) * 256; }
    __device__ __forceinline__ void epi(const f32x4 (&acc)[2][2][4][2], const pg::GUnit& u, int wr, int wc, int fr, int fq) const {
        char* O = (char*)(P.ws + WS_ACTB) + (size_t)u.pm * 256 * 2048 + u.pn * 128;
        const unsigned loff = (unsigned)((wr * 64 + fr) * 2048 + wc * 32 + 8 * fq);
        constexpr float IS = 1.0f / W8_SCALE, KX = -LOG2E * IS, IC = 1.0f / (IS * IS * ACT8_SCALE);
#pragma unroll
        for (int ai = 0; ai < 2; ++ai)
#pragma unroll
            for (int m = 0; m < 4; ++m) {
                f32x2 o[2][2];
#pragma unroll
                for (int n = 0; n < 2; ++n)
#pragma unroll
                    for (int p = 0; p < 2; ++p) {
                        const f32x2 g = p ? __builtin_shufflevector(acc[ai][0][m][n], acc[ai][0][m][n], 2, 3) : __builtin_shufflevector(acc[ai][0][m][n], acc[ai][0][m][n], 0, 1);
                        const f32x2 up = p ? __builtin_shufflevector(acc[ai][1][m][n], acc[ai][1][m][n], 2, 3) : __builtin_shufflevector(acc[ai][1][m][n], acc[ai][1][m][n], 0, 1);
                        const f32x2 t = g * up, x = g * KX;
                        f32x2 e; e.x = __builtin_amdgcn_exp2f(x.x); e.y = __builtin_amdgcn_exp2f(x.y);
                        const f32x2 d = e * IC + IC;
                        f32x2 r; r.x = __builtin_amdgcn_rcpf(d.x); r.y = __builtin_amdgcn_rcpf(d.y);
                        o[n][p] = t * r; }
                u32x2 w; w.x = pk4_fp8(o[0][0].x, o[0][0].y, o[0][1].x, o[0][1].y); w.y = pk4_fp8(o[1][0].x, o[1][0].y, o[1][1].x, o[1][1].y);
                *(u32x2*)(O + (size_t)(ai * 128 + m * 16) * 2048 + loff) = w; }
    }
};
struct JobDown {
    Ptrs P; int G, c; int K, lda, ldb;
    __device__ __forceinline__ bool next(int i, pg::GUnit& u) const {
        const int L = i * G + c; if (L >= 2048) return false;
        pg::xcd_map(L, 512, 4, u.pm, u.pn); u.job = 0;
        u.A = (const char*)(P.ws + WS_ACTB) + (size_t)u.pm * (256 * 2048);
        u.B = (const char*)(P.ws + WS_WD) + (size_t)(u.pm >> 5) * (1024 * 2048) + (size_t)u.pn * (256 * 2048); return true;
    }
    __device__ __forceinline__ const int* rows(const pg::GUnit&) const { return nullptr; }
    __device__ __forceinline__ void epi(const f32x4 (&acc)[2][2][4][2], const pg::GUnit& u, int wr, int wc, int fr, int fq) const {
        char* O = (char*)(P.ws + WS_YE) + (size_t)u.pm * 256 * 1024 + u.pn * 256;
        const unsigned loff = (unsigned)((wr * 64 + fr) * 1024 + wc * 32 + 8 * fq);
        constexpr float sc = YE8_SCALE / (W8_SCALE * ACT8_SCALE);
#pragma unroll
        for (int ai = 0; ai < 2; ++ai)
#pragma unroll
            for (int m = 0; m < 4; ++m)
#pragma unroll
                for (int bj = 0; bj < 2; ++bj) { const f32x4 a = acc[ai][bj][m][0] * sc, b2 = acc[ai][bj][m][1] * sc;
                    u32x2 w; w.x = pk4_fp8(a[0], a[1], a[2], a[3]); w.y = pk4_fp8(b2[0], b2[1], b2[2], b2[3]);
                    *(u32x2*)(O + (size_t)(ai * 128 + m * 16) * 1024 + bj * 128 + loff) = w; }
    }
};

namespace fa {
__device__ __forceinline__ void glds16(const void* g, LAS unsigned char* l) { __builtin_amdgcn_global_load_lds((const unsigned*)g, (LAS unsigned*)l, 16, 0, 0); }
__device__ __forceinline__ void glds16_s(const char* sbase, unsigned voff, unsigned ldsaddr) { unsigned keep;
    asm volatile("s_mov_b32 %0, m0\n\ts_mov_b32 m0, %3\n\ts_nop 0\n\tglobal_load_lds_dwordx4 %1, %2\n\ts_mov_b32 m0, %0" : "=&s"(keep) : "v"(voff), "s"(sbase), "s"(ldsaddr) : "memory"); }
__device__ __forceinline__ float max3f(float a, float b, float c) { float r; asm volatile("v_max3_f32 %0, %1, %2, %3" : "=v"(r) : "v"(a), "v"(b), "v"(c)); return r; }
#define FA_ROWMAX(_m, Y0, Y1) do { \
        float _g0 = __builtin_amdgcn_fmed3f(Y0[0], Y0[1], Y0[2]); asm volatile("" : "+v"(_g0)); \
        float _g1 = __builtin_amdgcn_fmed3f(Y1[0], Y1[1], Y1[2]); asm volatile("" : "+v"(_g1)); \
        _m = max3f(Y0[0], Y0[1], Y0[2]); float _m2 = max3f(Y1[0], Y1[1], Y1[2]); \
        _Pragma("unroll") for (int _r = 3; _r < 15; _r += 2) { _m = max3f(_m, Y0[_r], Y0[_r + 1]); _m2 = max3f(_m2, Y1[_r], Y1[_r + 1]); } \
        _m = max3f(_m, Y0[15], Y1[15]); _m = max3f(_m, _m2, _m2); { float _o = __shfl_xor(_m, 32); _m = max3f(_m, _o, _o); } } while (0)
constexpr float THR = 16.0f;
#define FA_SB() __builtin_amdgcn_sched_barrier(0)

template <int MODE>
__device__ __forceinline__ void flash_unit(LAS unsigned char* lds, const Ptrs& P, int b, int hd, int qblk, float lam) {
    constexpr bool DA = (MODE == 0);
    constexpr int NDB = DA ? 4 : 2;
    constexpr int NPV = 4 * NDB;
    constexpr int STG = DA ? 32768 : 16384, VOFF = DA ? 16384 : 8192;
    const int tid = threadIdx.x, lane = tid & 63, r32 = lane & 31, hi = lane >> 5, w = __builtin_amdgcn_readfirstlane(tid >> 6);
    int q0, qw, NT, tlo, ts, thi; bool notrack = false;
    const bf16_t *Qp, *Kp, *Vp; bf16_t* Op; int kld; float slope2;
    if constexpr (DA) {
        q0 = qblk * 128; const int map = w >> 2; qw = q0 + (w & 3) * 32;
        Qp = WSP(const bf16_t, WS_DAQ) + (size_t)(b * SEQ) * 1024 + hd * 128 + map * 64;
        Kp = WSP(const bf16_t, WS_DAK) + (size_t)(b * SEQ) * 1024 + hd * 128;
        Vp = WSP(const bf16_t, WS_DAVT) + (size_t)(hd * 128) * MTOK + (size_t)b * SEQ;
        Op = WSP(bf16_t, WS_DAQ) + (size_t)(b * SEQ) * 1024 + hd * 128;
        kld = 1024; NT = 32; tlo = 0; thi = 31; ts = q0 >> 6;
        slope2 = LOG2E * __builtin_amdgcn_exp2f(-(float)(hd + 1));
    } else {
        q0 = qblk * 256; qw = q0 + w * 32; const int kvh = hd >> 2;
        Qp = WSP(const bf16_t, WS_WAQ) + (size_t)(b * SEQ) * 1024 + hd * 64;
        Kp = WSP(const bf16_t, WS_WAK) + (size_t)(b * SEQ) * 256 + kvh * 64;
        Vp = WSP(const bf16_t, WS_WAVT) + (size_t)(kvh * 64) * MTOK + (size_t)b * SEQ;
        Op = WSP(bf16_t, WS_WAQ) + (size_t)(b * SEQ) * 1024 + hd * 64;
        kld = 256; tlo = 4 * qblk - 2; if (tlo < 0) tlo = 0; thi = 4 * qblk + 5; if (thi > 31) thi = 31; ts = 4 * qblk; NT = thi - tlo + 1;
        slope2 = LOG2E * __builtin_amdgcn_exp2f(-0.5f * (float)(hd + 1));
    }
    const int Rk = w * 8 + (lane >> 3), slot = lane & 7;
    const bf16_t* srcK0 = Kp + (size_t)Rk * kld + ((slot ^ ((Rk >> 1) & 7)) * 8);
    const bf16_t* srcV0 = Vp + (size_t)Rk * MTOK + ((slot ^ ((Rk >> 1) & 7)) * 8);
    const bf16_t* srcV1 = Vp + (size_t)(Rk + 64) * MTOK + ((slot ^ (((Rk + 64) >> 1) & 7)) * 8);
    const unsigned koffb = (unsigned)(Rk * kld + ((slot ^ ((Rk >> 1) & 7)) * 8)) * 2u;
    const unsigned voffb0 = (unsigned)(Rk * MTOK + ((slot ^ ((Rk >> 1) & 7)) * 8)) * 2u, voffb1 = (unsigned)((Rk + 64) * MTOK + ((slot ^ (((Rk + 64) >> 1) & 7)) * 8)) * 2u;
    const unsigned ldsw0 = (unsigned)__builtin_amdgcn_readfirstlane((int)((unsigned)(uintptr_t)lds + (unsigned)w * 1024u));
#define FA_DMAK(t, stg) do { LAS unsigned char* _s = lds + (stg) * STG; \
        if constexpr (DA) { const char* _kb = (const char*)Kp + (size_t)(t) * (64 * 1024 * 2); const unsigned _la = ldsw0 + (unsigned)((stg) * STG); \
            glds16_s(_kb, koffb, _la); glds16_s(_kb, koffb + 128u, _la + 8192u); } \
        else { glds16(srcK0 + (size_t)(t) * 64 * 256, _s + w * 1024); } } while (0)
#define FA_DMAV(t, stg) do { LAS unsigned char* _s = lds + (stg) * STG; \
        if constexpr (DA) { const char* _vb = (const char*)Vp + (size_t)(t) * 128; const unsigned _la = ldsw0 + (unsigned)((stg) * STG + VOFF); \
            glds16_s(_vb, voffb0, _la); glds16_s(_vb, voffb1, _la + 8192u); } \
        else { glds16(srcV0 + (t) * 64, _s + VOFF + w * 1024); } } while (0)
#define FA_TILE(i) ((ts + (i) <= thi) ? ts + (i) : tlo + ((i) - (thi - ts + 1)))
    FA_DMAK(FA_TILE(0), 0);
    bf16x8 qf[4];
    { const bf16_t* qp = Qp + (size_t)(qw + r32) * 1024 + hi * 8;
#pragma unroll
      for (int d = 0; d < 4; ++d) qf[d] = *(const bf16x8*)(qp + d * 16); }
    if constexpr (DA) {
        float qs = 0.f;
#pragma unroll
        for (int d = 0; d < 4; ++d)
#pragma unroll
            for (int jj = 0; jj < 8; ++jj) { const float x = __uint_as_float(((unsigned)(unsigned short)qf[d][jj]) << 16); qs += x * x; }
        qs += __shfl_xor(qs, 32);
#pragma unroll
        for (int off = 1; off < 32; off <<= 1) qs = fmaxf(qs, __shfl_xor(qs, off));
        volatile LAS float* qsc = (volatile LAS float*)(lds + MISC_OFF + 64);
        if (lane == 0) qsc[w] = qs;
        LDS_WAIT(); __builtin_amdgcn_s_barrier(); asm volatile("" ::: "memory");
        float qn2 = qsc[0];
#pragma unroll
        for (int i = 1; i < 8; ++i) qn2 = fmaxf(qn2, qsc[i]);
        const float kn2 = __uint_as_float(WSP(const unsigned, WS_KMAX)[b * 8 + hd]);
        const float qk = sqrtf(qn2 * kn2);
        notrack = __builtin_amdgcn_readfirstlane((int)(qk < 100.0f)) != 0;
        float wf = (46.0f + 2.0f * qk) / slope2; wf = fminf(wf, 4096.0f);
        const int W = __builtin_amdgcn_readfirstlane((int)wf + 1);
        tlo = (q0 - W) < 0 ? 0 : ((q0 - W) >> 6); thi = (q0 + 127 + W) >> 6; if (thi > 31) thi = 31;
        if (((thi - tlo) & 1) == 0) { if (thi < 31) ++thi; else --tlo; }
        NT = thi - tlo + 1;
    }
    const int krow = (r32 & 0x13) | ((r32 & 4) << 1) | ((r32 & 8) >> 1), ksw = (krow >> 1) & 7, vsw = (r32 >> 1) & 7;
    const LAS unsigned char* kp[4]; const LAS unsigned char* vp[4];
#pragma unroll
    for (int d = 0; d < 4; ++d) kp[d] = lds + (DA ? (w >> 2) * 8192 : 0) + krow * 128 + (((2 * d + hi) ^ ksw) * 16);
#pragma unroll
    for (int ks = 0; ks < 4; ++ks) vp[ks] = lds + r32 * 128 + (((4 * (ks >> 1) + 2 * (ks & 1) + hi) ^ vsw) * 16);
    f32x16 o[NDB];
#pragma unroll
    for (int d = 0; d < NDB; ++d) o[d] = (f32x16){0.f, 0.f, 0.f, 0.f, 0.f, 0.f, 0.f, 0.f, 0.f, 0.f, 0.f, 0.f, 0.f, 0.f, 0.f, 0.f};
    f32x16 A0, A1, B0, B1;
    B0 = o[0]; B1 = o[0];
    float mref = 0.f, negm = 0.f, l = 0.f, fsave = 1.f; bool resc = false;
    const int qpos = qw + r32; const float nslope = -slope2;
    u32x4 pk[4]; bf16x8 kf[4], vf[8];
#define FA_EL(X0, X1, e) (((e) < 16) ? X0[(e) & 15] : X1[(e) & 15])
#define FA_SETEL(X0, X1, e, v) do { if ((e) < 16) X0[(e) & 15] = (v); else X1[(e) & 15] = (v); } while (0)
#define FA_NOFF(e) (32 * ((e) >> 4) + 16 * (((e) & 15) >> 3) + ((e) & 7))
#define FA_BIAS1(X0, X1, e) do { const float _x = t0n - (float)FA_NOFF(e); float _c = __builtin_fmaf(nslope, __builtin_fabsf(_x), negm); \
        if constexpr (!DA) _c = (__builtin_fabsf(_x) > 128.0f) ? -1.0e30f : _c; asm volatile("" : "+v"(_c)); FA_SETEL(X0, X1, e, _c); } while (0)
#define FA_BIASC(X0, X1, e) do { float _c = __builtin_fmaf(bd1, (float)FA_NOFF(e), bbase); asm volatile("" : "+v"(_c)); FA_SETEL(X0, X1, e, _c); } while (0)
#define FA_T0(dst, t) do { float _t = (float)(qpos - 64 * (t) - 8 * hi); asm volatile("" : "+v"(_t)); dst = _t; } while (0)
#define FA_STEP(Y0, Y1, X0, X1, KS, VB, T, TN, HASN, TRK, PV, CH) do { \
        if (HASN) FA_DMAK(TN, (KS) ^ 1); \
        FA_DMAV(T, KS); \
        _Pragma("unroll") for (int _j = 0; _j < 4; ++_j) kf[_j] = *(const LAS bf16x8*)(kp[_j >> 1] + (KS) * STG + (_j & 1) * 4096); \
        if (PV) { _Pragma("unroll") for (int _f = 0; _f < 8; ++_f) vf[_f] = *(const LAS bf16x8*)(vp[DA ? (_f >> 2) : (_f >> 1)] + (VB) + (DA ? (_f & 3) : (_f & 1)) * 4096); } \
        float t0n; FA_T0(t0n, TN); \
        float sacc = 0.f; FA_SB(); \
        _Pragma("unroll") for (int _j = 0; _j < 8; ++_j) { \
            if (_j & 1) Y1 = __builtin_amdgcn_mfma_f32_32x32x16_bf16(kf[_j & 3], qf[_j >> 1], Y1, 0, 0, 0); \
            else        Y0 = __builtin_amdgcn_mfma_f32_32x32x16_bf16(kf[_j & 3], qf[_j >> 1], Y0, 0, 0, 0); \
            if (_j < 4) kf[_j] = *(const LAS bf16x8*)(kp[(_j + 4) >> 1] + (KS) * STG + (_j & 1) * 4096); \
            { const float _a = FA_EL(X0, X1, 4 * _j), _b = FA_EL(X0, X1, 4 * _j + 1), _c = FA_EL(X0, X1, 4 * _j + 2), _d = FA_EL(X0, X1, 4 * _j + 3); \
              sacc += (_a + _b) + (_c + _d); asm volatile("" : "+v"(sacc)); pk[_j >> 1][2 * (_j & 1)] = cvt_pk_bf16(_a, _b); pk[_j >> 1][2 * (_j & 1) + 1] = cvt_pk_bf16(_c, _d); } \
            FA_SB(); } \
        l += sacc; \
        if (TRK) { float _m; FA_ROWMAX(_m, Y0, Y1); resc = false; \
          if (__builtin_expect(__any(_m > THR), 0)) { const float _dl = fmaxf(_m, 0.f); mref += _dl; negm = -mref; fsave = __builtin_amdgcn_exp2f(-_dl); l *= fsave; resc = true; \
              _Pragma("unroll") for (int _r = 0; _r < 16; ++_r) { Y0[_r] -= _dl; Y1[_r] -= _dl; } } } \
        float bbase = 0.f, bd1 = 0.f; if (CH) { const float _sn = ((TN) > ts) ? -nslope : nslope; bbase = __builtin_fmaf(_sn, t0n, negm); bd1 = -_sn; } \
        FA_SB(); \
        _Pragma("unroll") for (int _i = 0; _i < NPV; ++_i) { \
            if (PV) { o[DA ? (_i & 3) : (_i & 1)] = __builtin_amdgcn_mfma_f32_32x32x16_bf16(vf[_i & 7], __builtin_bit_cast(bf16x8, pk[DA ? (_i >> 2) : (_i >> 1)]), o[DA ? (_i & 3) : (_i & 1)], 0, 0, 0); \
              if (DA && _i < 8) vf[_i] = *(const LAS bf16x8*)(vp[(_i + 8) >> 2] + (VB) + ((_i + 8) & 3) * 4096); } \
            _Pragma("unroll") for (int _e = 0; _e < 32 / NPV; ++_e) { const int _q = (32 / NPV) * _i + _e; \
                { float _ev = __builtin_amdgcn_exp2f(FA_EL(Y0, Y1, _q)); asm volatile("" : "+v"(_ev)); FA_SETEL(Y0, Y1, _q, _ev); } if (CH) FA_BIASC(X0, X1, _q); else FA_BIAS1(X0, X1, _q); } \
            FA_SB(); } \
        asm volatile("s_waitcnt vmcnt(0) lgkmcnt(0)" ::: "memory"); __builtin_amdgcn_s_barrier(); asm volatile("" ::: "memory"); \
        if (TRK && __builtin_expect(resc, 0)) { _Pragma("unroll") for (int _d = 0; _d < NDB; ++_d) _Pragma("unroll") for (int _r = 0; _r < 16; ++_r) o[_d][_r] *= fsave; } \
    } while (0)
    { float t0n; FA_T0(t0n, FA_TILE(0));
#pragma unroll
      for (int e = 0; e < 32; ++e) FA_BIAS1(A0, A1, e); }
    asm volatile("s_waitcnt vmcnt(0)" ::: "memory"); __builtin_amdgcn_s_barrier(); asm volatile("" ::: "memory");
    const bool trk = !(DA && notrack);
    { const int t0_ = FA_TILE(0), t1_ = FA_TILE(1), t2_ = FA_TILE(2);
      FA_STEP(A0, A1, B0, B1, 0, 0, t0_, t1_, true, trk, false, false);
      FA_STEP(B0, B1, A0, A1, 1, VOFF, t1_, t2_, true, trk, true, DA); }
    for (int i = 2; i < NT; i += 2) {
        const int ta = FA_TILE(i), tb = FA_TILE(i + 1), tc = (i + 2 < NT) ? FA_TILE(i + 2) : FA_TILE(i + 1);
        FA_STEP(A0, A1, B0, B1, 0, STG + VOFF, ta, tb, true, trk, true, DA);
        FA_STEP(B0, B1, A0, A1, 1, VOFF, tb, tc, (i + 2 < NT), trk, true, DA); }
    { float sacc = 0.f;
#pragma unroll
      for (int j = 0; j < 8; ++j) { const float a_ = FA_EL(B0, B1, 4 * j), b_ = FA_EL(B0, B1, 4 * j + 1), c_ = FA_EL(B0, B1, 4 * j + 2), d_ = FA_EL(B0, B1, 4 * j + 3);
          sacc += (a_ + b_) + (c_ + d_); pk[j >> 1][2 * (j & 1)] = cvt_pk_bf16(a_, b_); pk[j >> 1][2 * (j & 1) + 1] = cvt_pk_bf16(c_, d_); }
      l += sacc;
#pragma unroll
      for (int i = 0; i < NPV; ++i) { const int ks = DA ? (i >> 2) : (i >> 1), d = DA ? (i & 3) : (i & 1);
          const bf16x8 v = *(const LAS bf16x8*)(vp[ks] + STG + VOFF + d * 4096);
          o[d] = __builtin_amdgcn_mfma_f32_32x32x16_bf16(v, __builtin_bit_cast(bf16x8, pk[ks]), o[d], 0, 0, 0); } }
    LDS_WAIT(); __builtin_amdgcn_s_barrier(); asm volatile("" ::: "memory");
    l += __shfl_xor(l, 32);
    if constexpr (DA) {
        const float il = 1.0f / l;
        LAS float* ex = (LAS float*)lds + (w & 3) * 4096;
        if (w >= 4) {
#pragma unroll
            for (int d = 0; d < 4; ++d)
#pragma unroll
                for (int r = 0; r < 16; ++r) ex[(d * 16 + r) * 64 + lane] = o[d][r] * il;
        }
        LDS_WAIT(); __builtin_amdgcn_s_barrier(); asm volatile("" ::: "memory");
        if (w < 4) {
            float ss = 0.f;
#pragma unroll
            for (int d = 0; d < 4; ++d)
#pragma unroll
                for (int r = 0; r < 16; ++r) { const float v = o[d][r] * il - lam * ex[(d * 16 + r) * 64 + lane]; o[d][r] = v; ss += v * v; }
            ss += __shfl_xor(ss, 32);
            const float rs = (1.0f - LAM_INIT) * __builtin_amdgcn_rsqf(ss * (1.0f / 128.0f) + EPS);
            bf16_t* op = Op + (size_t)(qw + r32) * 1024;
#pragma unroll
            for (int d = 0; d < 4; ++d)
#pragma unroll
                for (int gp = 0; gp < 2; ++gp) { u32x2 pw[2];
#pragma unroll
                    for (int gg = 0; gg < 2; ++gg) { const int g = 2 * gp + gg, dd = d * 32 + 8 * g + 4 * hi; const f32x4 sg = *(const f32x4*)(P.subln_g + dd);
                        pw[gg].x = cvt_pk_bf16(o[d][4 * g] * rs * sg[0], o[d][4 * g + 1] * rs * sg[1]); pw[gg].y = cvt_pk_bf16(o[d][4 * g + 2] * rs * sg[2], o[d][4 * g + 3] * rs * sg[3]); }
                    const unsigned sx = hi ? pw[0].x : pw[1].x, sy = hi ? pw[0].y : pw[1].y;
                    const unsigned rx = (unsigned)__shfl_xor((int)sx, 32), ry = (unsigned)__shfl_xor((int)sy, 32);
                    u32x4 wv; if (hi) { wv.x = rx; wv.y = ry; wv.z = pw[1].x; wv.w = pw[1].y; } else { wv.x = pw[0].x; wv.y = pw[0].y; wv.z = rx; wv.w = ry; }
                    *(u32x4*)(op + d * 32 + 16 * gp + 8 * hi) = wv; }
        }
    } else {
        const float sink2 = P.wa_sink[hd] * LOG2E;
        const float lt = l + __builtin_amdgcn_exp2f(sink2 - mref);
        const float il = 1.0f / lt;
        bf16_t* op = Op + (size_t)(qw + r32) * 1024;
#pragma unroll
        for (int d = 0; d < 2; ++d)
#pragma unroll
            for (int g = 0; g < 4; ++g) { const int dd = d * 32 + 8 * g + 4 * hi;
                u32x2 wv; wv.x = cvt_pk_bf16(o[d][4 * g] * il, o[d][4 * g + 1] * il); wv.y = cvt_pk_bf16(o[d][4 * g + 2] * il, o[d][4 * g + 3] * il);
                *(u32x2*)(op + dd) = wv; }
    }
    asm volatile("s_waitcnt vmcnt(0) lgkmcnt(0)" ::: "memory"); __builtin_amdgcn_s_barrier(); asm volatile("" ::: "memory");
#undef FA_DMAK
#undef FA_DMAV
#undef FA_TILE
#undef FA_EL
#undef FA_SETEL
#undef FA_NOFF
#undef FA_BIAS1
#undef FA_BIASC
#undef FA_T0
#undef FA_STEP
}
#undef FA_SB
__device__ __forceinline__ void wa_group(LAS unsigned char* lds, const Ptrs& P, int b, int kvh, int qblk) {
    constexpr int NDB = 2, NPV = 8, TSZ = 16384, VOFF = 8192;
    const int tid = threadIdx.x, lane = tid & 63, r32 = lane & 31, hi = lane >> 5, w = __builtin_amdgcn_readfirstlane(tid >> 6);
    const int q0 = qblk * 256, qw = q0 + w * 32;
    int tlo = 4 * qblk - 2; if (tlo < 0) tlo = 0; int thi = 4 * qblk + 5; if (thi > 31) thi = 31; const int NTW = thi - tlo + 1;
    { const bf16_t* Kp = WSP(const bf16_t, WS_WAK) + (size_t)(b * SEQ) * 256 + kvh * 64;
      const bf16_t* Vp = WSP(const bf16_t, WS_WAVT) + (size_t)(kvh * 64) * MTOK + (size_t)b * SEQ;
      const int Rk = w * 8 + (lane >> 3), slot = lane & 7;
      const bf16_t* srcK0 = Kp + (size_t)Rk * 256 + ((slot ^ ((Rk >> 1) & 7)) * 8);
      const bf16_t* srcV0 = Vp + (size_t)Rk * MTOK + ((slot ^ ((Rk >> 1) & 7)) * 8);
      for (int j = 0; j < NTW; ++j) { const int t = tlo + j; glds16(srcK0 + (size_t)t * 64 * 256, lds + j * TSZ + w * 1024); glds16(srcV0 + t * 64, lds + j * TSZ + VOFF + w * 1024); } }
    int tw0 = (qw - 128) >> 6; const int tw0r = tw0; if (tw0 > thi - 4) tw0 = thi - 4; if (tw0 < tlo) tw0 = tlo;
    const bool regular = __builtin_amdgcn_readfirstlane((int)(tw0 == tw0r)) != 0;
    const int krow = (r32 & 0x13) | ((r32 & 4) << 1) | ((r32 & 8) >> 1), ksw = (krow >> 1) & 7, vsw = (r32 >> 1) & 7;
    const LAS unsigned char* kp[4]; const LAS unsigned char* vp[4];
#pragma unroll
    for (int d = 0; d < 4; ++d) kp[d] = lds + krow * 128 + (((2 * d + hi) ^ ksw) * 16);
#pragma unroll
    for (int ks = 0; ks < 4; ++ks) vp[ks] = lds + r32 * 128 + (((4 * (ks >> 1) + 2 * (ks & 1) + hi) ^ vsw) * 16);
    const int qpos = qw + r32;
    asm volatile("s_waitcnt vmcnt(0)" ::: "memory"); __builtin_amdgcn_s_barrier(); asm volatile("" ::: "memory");
    float kmx;
    { float kn2 = 0.f;
      if (w < NTW) { const LAS unsigned char* kr = lds + w * TSZ + lane * 128;
#pragma unroll
          for (int c = 0; c < 8; ++c) { const bf16x8 v = *(const LAS bf16x8*)(kr + c * 16);
#pragma unroll
              for (int jj = 0; jj < 8; ++jj) { const float x = __uint_as_float(((unsigned)(unsigned short)v[jj]) << 16); kn2 += x * x; } } }
#pragma unroll
      for (int off = 1; off < 64; off <<= 1) kn2 = fmaxf(kn2, __shfl_xor(kn2, off));
      volatile LAS float* ksc = (volatile LAS float*)(lds + MISC_OFF + 64);
      if (lane == 0) ksc[w] = kn2;
      LDS_WAIT(); __builtin_amdgcn_s_barrier(); asm volatile("" ::: "memory");
      kmx = ksc[0];
#pragma unroll
      for (int i = 1; i < 8; ++i) kmx = fmaxf(kmx, ksc[i]); }
#define FA_SB() __builtin_amdgcn_sched_barrier(0)
#define FA_EL(X0, X1, e) (((e) < 16) ? X0[(e) & 15] : X1[(e) & 15])
#define FA_SETEL(X0, X1, e, v) do { if ((e) < 16) X0[(e) & 15] = (v); else X1[(e) & 15] = (v); } while (0)
#define FA_NOFF(e) (32 * ((e) >> 4) + 16 * (((e) & 15) >> 3) + ((e) & 7))
#define FA_BIAS1(X0, X1, e) do { const float _x = t0n - (float)FA_NOFF(e); float _c = __builtin_fmaf(nslope, __builtin_fabsf(_x), negm); \
        _c = (__builtin_fabsf(_x) > 128.0f) ? -1.0e30f : _c; asm volatile("" : "+v"(_c)); FA_SETEL(X0, X1, e, _c); } while (0)
#define FW_BIAS(BM, SG, X0, X1, e) do { if ((BM) != 4) { float _c; \
        if ((BM) == 0 || (BM) == 2) { const float _x = t0n - (float)FA_NOFF(e); _c = __builtin_fmaf(nslope, __builtin_fabsf(_x), negm); \
            if ((BM) == 0) _c = (__builtin_fabsf(_x) > 128.0f) ? -1.0e30f : _c; } \
        else { _c = __builtin_fmaf(bd1, (float)FA_NOFF(e), bbase); \
            if ((BM) == 3) _c = (((SG) > 0) ? ((float)FA_NOFF(e) < blim) : ((float)FA_NOFF(e) > blim)) ? -1.0e30f : _c; } \
        asm volatile("" : "+v"(_c)); FA_SETEL(X0, X1, e, _c); } } while (0)
#define FA_T0(dst, t) do { float _t = (float)(qpos - 64 * (t) - 8 * hi); asm volatile("" : "+v"(_t)); dst = _t; } while (0)
#define FW_STEP(Y0, Y1, X0, X1, KOFF, VBOFF, TN, PV, BM, SG) do { \
        const LAS unsigned char* kq[4]; const LAS unsigned char* vq[4]; \
        _Pragma("unroll") for (int _d = 0; _d < 4; ++_d) { kq[_d] = kp[_d] + (KOFF); vq[_d] = vp[_d] + (VBOFF); } \
        _Pragma("unroll") for (int _j = 0; _j < 4; ++_j) kf[_j] = *(const LAS bf16x8*)(kq[_j >> 1] + (_j & 1) * 4096); \
        if (PV) { _Pragma("unroll") for (int _f = 0; _f < 8; ++_f) vf[_f] = *(const LAS bf16x8*)(vq[_f >> 1] + (_f & 1) * 4096); } \
        float t0n; FA_T0(t0n, TN); \
        float sacc = 0.f; FA_SB(); \
        _Pragma("unroll") for (int _j = 0; _j < 8; ++_j) { \
            if (_j & 1) Y1 = __builtin_amdgcn_mfma_f32_32x32x16_bf16(kf[_j & 3], qf[_j >> 1], Y1, 0, 0, 0); \
            else        Y0 = __builtin_amdgcn_mfma_f32_32x32x16_bf16(kf[_j & 3], qf[_j >> 1], Y0, 0, 0, 0); \
            if (_j < 4) kf[_j] = *(const LAS bf16x8*)(kq[(_j + 4) >> 1] + (_j & 1) * 4096); \
            { const float _a = FA_EL(X0, X1, 4 * _j), _b = FA_EL(X0, X1, 4 * _j + 1), _c = FA_EL(X0, X1, 4 * _j + 2), _d = FA_EL(X0, X1, 4 * _j + 3); \
              sacc += (_a + _b) + (_c + _d); asm volatile("" : "+v"(sacc)); pk[_j >> 1][2 * (_j & 1)] = cvt_pk_bf16(_a, _b); pk[_j >> 1][2 * (_j & 1) + 1] = cvt_pk_bf16(_c, _d); } \
            FA_SB(); } \
        l += sacc; \
        if (trk) { float _m; FA_ROWMAX(_m, Y0, Y1); resc = false; \
          if (__builtin_expect(__any(_m > THR), 0)) { const float _dl = fmaxf(_m, 0.f); mref += _dl; negm = -mref; fsave = __builtin_amdgcn_exp2f(-_dl); l *= fsave; resc = true; \
              _Pragma("unroll") for (int _r = 0; _r < 16; ++_r) { Y0[_r] -= _dl; Y1[_r] -= _dl; } } } \
        float bbase = 0.f, bd1 = 0.f, blim = 0.f; if ((BM) == 1 || (BM) == 3) { const float _sn = ((SG) > 0) ? nslope : -nslope; bbase = __builtin_fmaf(_sn, t0n, negm); bd1 = -_sn; blim = ((SG) > 0) ? t0n - 128.0f : t0n + 128.0f; } \
        FA_SB(); \
        _Pragma("unroll") for (int _i = 0; _i < NPV; ++_i) { \
            if (PV) o[_i & 1] = __builtin_amdgcn_mfma_f32_32x32x16_bf16(vf[_i], __builtin_bit_cast(bf16x8, pk[_i >> 1]), o[_i & 1], 0, 0, 0); \
            _Pragma("unroll") for (int _e = 0; _e < 4; ++_e) { const int _q = 4 * _i + _e; \
                { float _ev = __builtin_amdgcn_exp2f(FA_EL(Y0, Y1, _q)); asm volatile("" : "+v"(_ev)); FA_SETEL(Y0, Y1, _q, _ev); } FW_BIAS(BM, SG, X0, X1, _q); } \
            FA_SB(); } \
        if (trk && __builtin_expect(resc, 0)) { _Pragma("unroll") for (int _d = 0; _d < NDB; ++_d) _Pragma("unroll") for (int _r = 0; _r < 16; ++_r) o[_d][_r] *= fsave; } \
    } while (0)
    for (int hq = 0; hq < 4; ++hq) {
        const int hd = kvh * 4 + hq;
        const float slope2 = LOG2E * __builtin_amdgcn_exp2f(-0.5f * (float)(hd + 1)), nslope = -slope2;
        bf16x8 qf[4];
        { const bf16_t* qp = WSP(const bf16_t, WS_WAQ) + (size_t)(b * SEQ + qw + r32) * 1024 + hd * 64 + hi * 8;
#pragma unroll
          for (int d = 0; d < 4; ++d) qf[d] = *(const bf16x8*)(qp + d * 16); }
        bool trk;
        { float qs = 0.f;
#pragma unroll
          for (int d = 0; d < 4; ++d)
#pragma unroll
              for (int jj = 0; jj < 8; ++jj) { const float x = __uint_as_float(((unsigned)(unsigned short)qf[d][jj]) << 16); qs += x * x; }
          qs += __shfl_xor(qs, 32);
#pragma unroll
          for (int off = 1; off < 32; off <<= 1) qs = fmaxf(qs, __shfl_xor(qs, off));
          trk = __builtin_amdgcn_readfirstlane((int)(sqrtf(qs * kmx) < 100.0f)) == 0; }
        f32x16 o[NDB];
#pragma unroll
        for (int d = 0; d < NDB; ++d) o[d] = (f32x16){0.f, 0.f, 0.f, 0.f, 0.f, 0.f, 0.f, 0.f, 0.f, 0.f, 0.f, 0.f, 0.f, 0.f, 0.f, 0.f};
        f32x16 A0, A1, B0, B1; B0 = o[0]; B1 = o[0];
        float mref = 0.f, negm = 0.f, l = 0.f, fsave = 1.f; bool resc = false;
        u32x4 pk[4]; bf16x8 kf[4], vf[8];
        const int kb0 = (tw0 - tlo) * TSZ;
        if (regular) {
            { float t0n; FA_T0(t0n, tw0); const float bbase = __builtin_fmaf(nslope, t0n, negm), bd1 = -nslope, blim = t0n - 128.0f;
#pragma unroll
              for (int e = 0; e < 32; ++e) FW_BIAS(3, 1, A0, A1, e); }
            FW_STEP(A0, A1, B0, B1, kb0, kb0, tw0 + 1, false, 1, 1);
            FW_STEP(B0, B1, A0, A1, kb0 + TSZ, kb0 + VOFF, tw0 + 2, true, 2, 0);
            FW_STEP(A0, A1, B0, B1, kb0 + 2 * TSZ, kb0 + TSZ + VOFF, tw0 + 3, true, 1, -1);
            FW_STEP(B0, B1, A0, A1, kb0 + 3 * TSZ, kb0 + 2 * TSZ + VOFF, tw0 + 4, true, 3, -1);
            FW_STEP(A0, A1, B0, B1, kb0 + 4 * TSZ, kb0 + 3 * TSZ + VOFF, tw0 + 4, true, 4, 0);
        } else {
            { float t0n; FA_T0(t0n, tw0); const float bbase = 0.f, bd1 = 0.f, blim = 0.f;
#pragma unroll
              for (int e = 0; e < 32; ++e) FW_BIAS(0, 0, A0, A1, e); }
            FW_STEP(A0, A1, B0, B1, kb0, kb0, tw0 + 1, false, 0, 0);
            FW_STEP(B0, B1, A0, A1, kb0 + TSZ, kb0 + VOFF, tw0 + 2, true, 0, 0);
            FW_STEP(A0, A1, B0, B1, kb0 + 2 * TSZ, kb0 + TSZ + VOFF, tw0 + 3, true, 0, 0);
            FW_STEP(B0, B1, A0, A1, kb0 + 3 * TSZ, kb0 + 2 * TSZ + VOFF, tw0 + 4, true, 0, 0);
            FW_STEP(A0, A1, B0, B1, kb0 + 4 * TSZ, kb0 + 3 * TSZ + VOFF, tw0 + 4, true, 4, 0);
        }
        { float sacc = 0.f;
#pragma unroll
          for (int j = 0; j < 8; ++j) { const float a_ = FA_EL(A0, A1, 4 * j), b_ = FA_EL(A0, A1, 4 * j + 1), c_ = FA_EL(A0, A1, 4 * j + 2), d_ = FA_EL(A0, A1, 4 * j + 3);
              sacc += (a_ + b_) + (c_ + d_); pk[j >> 1][2 * (j & 1)] = cvt_pk_bf16(a_, b_); pk[j >> 1][2 * (j & 1) + 1] = cvt_pk_bf16(c_, d_); }
          l += sacc;
#pragma unroll
          for (int i = 0; i < NPV; ++i) { const int ks = i >> 1, d = i & 1;
              const bf16x8 v = *(const LAS bf16x8*)(vp[ks] + kb0 + 4 * TSZ + VOFF + d * 4096);
              o[d] = __builtin_amdgcn_mfma_f32_32x32x16_bf16(v, __builtin_bit_cast(bf16x8, pk[ks]), o[d], 0, 0, 0); } }
        l += __shfl_xor(l, 32);
        { const float sink2 = P.wa_sink[hd] * LOG2E;
          const float il = 1.0f / (l + __builtin_amdgcn_exp2f(sink2 - mref));
          bf16_t* op = WSP(bf16_t, WS_WAQ) + (size_t)(b * SEQ + qw + r32) * 1024 + hd * 64;
#pragma unroll
          for (int d = 0; d < 2; ++d)
#pragma unroll
              for (int gp = 0; gp < 2; ++gp) { u32x2 pw[2];
#pragma unroll
                  for (int gg = 0; gg < 2; ++gg) { const int g = 2 * gp + gg; pw[gg].x = cvt_pk_bf16(o[d][4 * g] * il, o[d][4 * g + 1] * il); pw[gg].y = cvt_pk_bf16(o[d][4 * g + 2] * il, o[d][4 * g + 3] * il); }
                  const unsigned sx = hi ? pw[0].x : pw[1].x, sy = hi ? pw[0].y : pw[1].y;
                  const unsigned rx = (unsigned)__shfl_xor((int)sx, 32), ry = (unsigned)__shfl_xor((int)sy, 32);
                  u32x4 wv; if (hi) { wv.x = rx; wv.y = ry; wv.z = pw[1].x; wv.w = pw[1].y; } else { wv.x = pw[0].x; wv.y = pw[0].y; wv.z = rx; wv.w = ry; }
                  *(u32x4*)(op + d * 32 + 16 * gp + 8 * hi) = wv; } }
    }
    asm volatile("s_waitcnt vmcnt(0) lgkmcnt(0)" ::: "memory"); __builtin_amdgcn_s_barrier(); asm volatile("" ::: "memory");
#undef FW_STEP
#undef FW_BIAS
#undef FA_EL
#undef FA_SETEL
#undef FA_NOFF
#undef FA_BIAS1
#undef FA_T0
#undef FA_SB
}
}

struct Frame { LAS unsigned char* lds; int tid, lane, wave, vcu, G; };

__device__ __forceinline__ void transpose_item(const float* W, int K, int N, bf16_t* WT, int k0, int n0, int drow0, LAS float* scr, int lane) {
    { float tv[32]; const float* wp = W + (size_t)(k0 + (lane >> 5)) * N + n0 + (lane & 31);
#pragma unroll
      for (int i = 0; i < 32; ++i) tv[i] = wp[(size_t)(2 * i) * N];
#pragma unroll
      for (int i = 0; i < 32; ++i) { const int kk = 2 * i + (lane >> 5); scr[kk * 33 + (lane & 31)] = tv[i]; } }
    LDS_WAIT(); asm volatile("" ::: "memory");
    const int c = lane & 7;
#pragma unroll
    for (int j = 0; j < 4; ++j) { const int n = (lane >> 3) + 8 * j; const LAS float* s = scr + (8 * c) * 33 + n;
        u32x4 o; o.x = cvt_pk_bf16(s[0 * 33], s[1 * 33]); o.y = cvt_pk_bf16(s[2 * 33], s[3 * 33]); o.z = cvt_pk_bf16(s[4 * 33], s[5 * 33]); o.w = cvt_pk_bf16(s[6 * 33], s[7 * 33]);
        *(u32x4*)(WT + (size_t)(drow0 + n) * K + k0 + 8 * c) = o; }
    LDS_WAIT(); asm volatile("" ::: "memory");
}
__device__ __forceinline__ void transpose_item_fp8(const float* W, int K, int N, unsigned char* WT, int k0, int n0, int drow0, float sc, LAS float* scr, int lane) {
    { float tv[32]; const float* wp = W + (size_t)(k0 + (lane >> 5)) * N + n0 + (lane & 31);
#pragma unroll
      for (int i = 0; i < 32; ++i) tv[i] = wp[(size_t)(2 * i) * N];
#pragma unroll
      for (int i = 0; i < 32; ++i) { const int kk = 2 * i + (lane >> 5); scr[kk * 33 + (lane & 31)] = tv[i]; } }
    LDS_WAIT(); asm volatile("" ::: "memory");
    const int c = lane & 7;
#pragma unroll
    for (int j = 0; j < 4; ++j) { const int n = (lane >> 3) + 8 * j; const LAS float* q = scr + (8 * c) * 33 + n;
        u32x2 o; o.x = pk4_fp8(q[0 * 33] * sc, q[1 * 33] * sc, q[2 * 33] * sc, q[3 * 33] * sc); o.y = pk4_fp8(q[4 * 33] * sc, q[5 * 33] * sc, q[6 * 33] * sc, q[7 * 33] * sc);
        *(u32x2*)(WT + (size_t)(drow0 + n) * K + k0 + 8 * c) = o; }
    LDS_WAIT(); asm volatile("" ::: "memory");
}
__device__ __forceinline__ int win_dst_row(int n) {
    if (n < 1024) return R_DAQ + n; if (n < 2048) return R_DAK + (n - 1024); if (n < 3072) return R_DAV + (n - 2048); if (n < 4096) return R_WAQ + (n - 3072);
    if (n < 4352) return R_WAK + (n - 4096); if (n < 4608) return R_WAV + (n - 4352); if (n < 5632) return R_XAQ + (n - 4608); return R_GATE + (n - 5632);
}
__device__ __forceinline__ void rms_row_to_bf16(const float* xrow, const float* g, bf16_t* orow, int lane, unsigned* orow8 = nullptr) {
    const f32x4* xr = (const f32x4*)xrow + lane; const f32x4* gr = (const f32x4*)g + lane;
    f32x4 v[4]; float s = 0.f;
#pragma unroll
    for (int j = 0; j < 4; ++j) { v[j] = xr[64 * j]; s += (v[j][0] * v[j][0] + v[j][1] * v[j][1]) + (v[j][2] * v[j][2] + v[j][3] * v[j][3]); }
    const float rstd = 1.0f / sqrtf(wave_sum(s) * (1.0f / 1024.0f) + EPS);
    u32x2* o8 = (u32x2*)orow + lane;
#pragma unroll
    for (int j = 0; j < 4; ++j) { const f32x4 gg = gr[64 * j]; u32x2 wv; wv.x = cvt_pk_bf16(v[j][0] * rstd * gg[0], v[j][1] * rstd * gg[1]); wv.y = cvt_pk_bf16(v[j][2] * rstd * gg[2], v[j][3] * rstd * gg[3]); if (orow) o8[64 * j] = wv;
        if (orow8) orow8[lane + 64 * j] = pk4_fp8(v[j][0] * rstd * gg[0], v[j][1] * rstd * gg[1], v[j][2] * rstd * gg[2], v[j][3] * rstd * gg[3]); }
}
template <int NR>
__device__ __forceinline__ void rms_rows(const float* x0, const float* g, bf16_t* o0, unsigned* o80, int lane) {
    const f32x4* gr = (const f32x4*)g + lane;
    f32x4 v[NR][4]; float rstd[NR];
#pragma unroll
    for (int r = 0; r < NR; ++r) { const f32x4* xr = (const f32x4*)(x0 + (size_t)r * 1024) + lane;
#pragma unroll
        for (int j = 0; j < 4; ++j) v[r][j] = xr[64 * j]; }
#pragma unroll
    for (int r = 0; r < NR; ++r) { float s = 0.f;
#pragma unroll
        for (int j = 0; j < 4; ++j) s += (v[r][j][0] * v[r][j][0] + v[r][j][1] * v[r][j][1]) + (v[r][j][2] * v[r][j][2] + v[r][j][3] * v[r][j][3]);
        rstd[r] = 1.0f / sqrtf(wave_sum(s) * (1.0f / 1024.0f) + EPS); }
#pragma unroll
    for (int j = 0; j < 4; ++j) { const f32x4 gg = gr[64 * j];
#pragma unroll
        for (int r = 0; r < NR; ++r) { const float a = v[r][j][0] * rstd[r] * gg[0], b = v[r][j][1] * rstd[r] * gg[1], c = v[r][j][2] * rstd[r] * gg[2], d = v[r][j][3] * rstd[r] * gg[3];
            if (o0) { u32x2 wv; wv.x = cvt_pk_bf16(a, b); wv.y = cvt_pk_bf16(c, d); ((u32x2*)(o0 + (size_t)r * 1024))[lane + 64 * j] = wv; }
            if (o80) o80[(size_t)r * 256 + lane + 64 * j] = pk4_fp8(a, b, c, d); } }
}
__device__ __forceinline__ void phase_prologue(Frame& F, const Ptrs& P) {
    LAS float* scr = (LAS float*)(F.lds + F.wave * 16384);
    const int gw = F.vcu * 8 + F.wave, NGW = F.G * 8;
    constexpr int I_IN = 16 * 272, I_KV = 16 * 64, I_SQ = 16 * 32;
    constexpr int NIT = I_IN + I_KV + 4 * I_SQ;
    for (int it = gw; it < NIT; it += NGW) {
        int r = it;
        if (r < I_IN) { const int kb = r / 272, nb = r % 272;
            if (WA_FP8 && 32 * nb >= 3072 && 32 * nb < 4608) transpose_item_fp8(P.w_in, 1024, INW, WSP(unsigned char, WS_WWA8), 64 * kb, 32 * nb, 32 * nb - 3072, W8_SCALE, scr, F.lane);
            else if (XA_FP8 && 32 * nb >= 4608 && 32 * nb < 5632) transpose_item_fp8(P.w_in, 1024, INW, WSP(unsigned char, WS_WXQ8), 64 * kb, 32 * nb, 32 * nb - 4608, W8_SCALE, scr, F.lane);
            else if (INPROJ_FP8) transpose_item_fp8(P.w_in, 1024, INW, WSP(unsigned char, WS_WIN), 64 * kb, 32 * nb, win_dst_row(32 * nb), W8_SCALE, scr, F.lane);
            else if (GATES_FP8 && 32 * nb >= 5632) transpose_item_fp8(P.w_in, 1024, INW, WSP(unsigned char, WS_WG8), 64 * kb, 32 * nb, 32 * nb - 5632, W8_SCALE, scr, F.lane);
            else transpose_item(P.w_in, 1024, INW, WSP(bf16_t, WS_WIN), 64 * kb, 32 * nb, win_dst_row(32 * nb), scr, F.lane);
            continue; } r -= I_IN;
        if (r < I_KV) { const int kb = r / 64, nb = r % 64;
            if (XA_FP8) transpose_item_fp8(P.w_mkv, 1024, 2048, WSP(unsigned char, WS_WMKV8), 64 * kb, 32 * nb, 32 * nb, W8_SCALE, scr, F.lane);
            else if (INPROJ_FP8) transpose_item_fp8(P.w_mkv, 1024, 2048, WSP(unsigned char, WS_WMKV), 64 * kb, 32 * nb, 32 * nb, W8_SCALE, scr, F.lane);
            else transpose_item(P.w_mkv, 1024, 2048, WSP(bf16_t, WS_WMKV), 64 * kb, 32 * nb, 32 * nb, scr, F.lane);
            continue; } r -= I_KV;
        const int which = r / I_SQ; r -= which * I_SQ; const int kb = r / 32, nb = r % 32;
        const float* src = which == 0 ? P.w_da_o : which == 1 ? P.w_wa_o : which == 2 ? P.w_xa_o : P.w_out;
        bf16_t* dst = which == 0 ? WSP(bf16_t, WS_WDAO) : which == 1 ? WSP(bf16_t, WS_WWAO) : which == 2 ? WSP(bf16_t, WS_WXAO) : WSP(bf16_t, WS_WOUT);
        if (XS_FP8 && which == 2) transpose_item_fp8(src, 1024, 1024, (unsigned char*)dst, 64 * kb, 32 * nb, 32 * nb, W8_SCALE, scr, F.lane);
        else transpose_item(src, 1024, 1024, dst, 64 * kb, 32 * nb, 32 * nb, scr, F.lane);
    }
    for (int m = 4 * gw; m < MTOK; m += 4 * NGW) rms_rows<4>(P.x + (size_t)m * 1024, P.attn_g, INPROJ_FP8 ? nullptr : WSP(bf16_t, WS_H) + (size_t)m * 1024, GATES_FP8 ? (unsigned*)((char*)P.out + 128 * MiB) + (size_t)m * 256 : nullptr, F.lane);
    for (int m = 4 * gw; m < MMEM; m += 4 * NGW) rms_rows<4>(P.mem + (size_t)m * 1024, P.mem_g, (INPROJ_FP8 || XA_FP8) ? nullptr : WSP(bf16_t, WS_MN) + (size_t)m * 1024, XA_FP8 ? WSP(unsigned, WS_MN8) + (size_t)m * 256 : INPROJ_FP8 ? WSP(unsigned, WS_MN) + (size_t)m * 256 : nullptr, F.lane);
    { u32x4* inv = WSP(u32x4, WS_INV); const int n16 = MTOK * 16 * 2 / 16;
      for (int i = F.vcu * 512 + F.tid; i < n16; i += F.G * 512) inv[i] = (u32x4){0xffffffffu, 0xffffffffu, 0xffffffffu, 0xffffffffu}; }
}

__device__ __forceinline__ void convert_expert_weights(Frame& F, const Ptrs& P, LAS float* scr);
__device__ __forceinline__ void phase_norm_router(Frame& F, const Ptrs& P) {
    LAS float* wl = (LAS float*)F.lds;
    LAS float* gl = wl + 64 * 260;
    for (int i = F.tid; i < 1024 * 16; i += 512) { const int k = i >> 4, e = i & 15; wl[(((k >> 4) & 3) * 16 + e) * 260 + (k >> 6) * 16 + (k & 15)] = P.w_router[i] * P.ffn_g[k]; }
    for (int i = F.tid; i < 1024; i += 512) gl[i] = P.ffn_g[i];
    __syncthreads();
    const int lane = F.lane, t = lane & 15, kq = lane >> 4;
    const LAS float* wrow = wl + (kq * 16 + t) * 260;
    const LAS float* grow = gl + kq * 16;
    LAS float* cscr = (LAS float*)(F.lds + 70656 + F.wave * 8448);
    static_assert(70656 + 8 * 8448 <= MISC_OFF, "conversion tiles overlap the barrier words");
    if (F.wave & 1) convert_expert_weights(F, P, cscr);
    for (int g = F.vcu * 8 + F.wave; g < MTOK / 16; g += F.G * 8) {
        const int m0 = 16 * g;
        const u32x4* xr = (const u32x4*)(WSP(const unsigned char, WS_X1) + (size_t)(m0 + t) * 2048 + kq * 32);
        u32x4 xp[32];
#pragma unroll
        for (int J = 0; J < 16; ++J) { xp[2 * J] = xr[8 * J]; xp[2 * J + 1] = xr[8 * J + 1]; }
        f32x4 a0 = (f32x4){0.f, 0.f, 0.f, 0.f}, a1 = a0; float ss = 0.f;
        f32x4 w0 = *(const LAS f32x4*)(wrow), w1 = *(const LAS f32x4*)(wrow + 4);
#pragma unroll
        for (int j = 0; j < 32; ++j) {
            asm volatile("" ::: "memory");
            const f32x4 w0n = *(const LAS f32x4*)(wrow + 8 * ((j + 1) & 31)), w1n = *(const LAS f32x4*)(wrow + 8 * ((j + 1) & 31) + 4);
            asm volatile("" : "+v"(xp[j]));
            const u32x4 d = xp[j];
            const float x0 = bf_lo(d.x), x1 = bf_hi(d.x), x2 = bf_lo(d.y), x3 = bf_hi(d.y), x4 = bf_lo(d.z), x5 = bf_hi(d.z), x6 = bf_lo(d.w), x7 = bf_hi(d.w);
            a0 = __builtin_amdgcn_mfma_f32_16x16x4f32(w0[0], x0, a0, 0, 0, 0); a1 = __builtin_amdgcn_mfma_f32_16x16x4f32(w0[1], x1, a1, 0, 0, 0);
            a0 = __builtin_amdgcn_mfma_f32_16x16x4f32(w0[2], x2, a0, 0, 0, 0); a1 = __builtin_amdgcn_mfma_f32_16x16x4f32(w0[3], x3, a1, 0, 0, 0);
            a0 = __builtin_amdgcn_mfma_f32_16x16x4f32(w1[0], x4, a0, 0, 0, 0); a1 = __builtin_amdgcn_mfma_f32_16x16x4f32(w1[1], x5, a1, 0, 0, 0);
            a0 = __builtin_amdgcn_mfma_f32_16x16x4f32(w1[2], x6, a0, 0, 0, 0); a1 = __builtin_amdgcn_mfma_f32_16x16x4f32(w1[3], x7, a1, 0, 0, 0);
            ss += ((x0 * x0 + x1 * x1) + (x2 * x2 + x3 * x3)) + ((x4 * x4 + x5 * x5) + (x6 * x6 + x7 * x7));
            w0 = w0n; w1 = w1n; __builtin_amdgcn_sched_barrier(0); }
        ss += __shfl_xor(ss, 16); ss += __shfl_xor(ss, 32);
        const float rstd = 1.0f / sqrtf(ss * (1.0f / 1024.0f) + EPS);
        const f32x4 lg = (a0 + a1) * rstd;
        float mx = fmaxf(fmaxf(lg[0], lg[1]), fmaxf(lg[2], lg[3])); mx = fmaxf(mx, __shfl_xor(mx, 16)); mx = fmaxf(mx, __shfl_xor(mx, 32));
        f32x4 ex; ex[0] = __expf(lg[0] - mx); ex[1] = __expf(lg[1] - mx); ex[2] = __expf(lg[2] - mx); ex[3] = __expf(lg[3] - mx);
        float den = (ex[0] + ex[1]) + (ex[2] + ex[3]); den += __shfl_xor(den, 16); den += __shfl_xor(den, 32);
        *(f32x4*)(WSP(float, WS_AFF) + (size_t)(m0 + t) * 16 + 4 * kq) = ex / den;
        unsigned char* hrow = WSP(unsigned char, WS_H2) + (size_t)(m0 + t) * 1024 + kq * 16;
#pragma unroll
        for (int J = 0; J < 16; ++J) { u32x4 o;
#pragma unroll
            for (int h = 0; h < 2; ++h) { asm volatile("" : "+v"(xp[2 * J + h]) :: "memory"); const u32x4 d = xp[2 * J + h];
                const f32x4 g0 = *(const LAS f32x4*)(grow + 64 * J + 8 * h), g1 = *(const LAS f32x4*)(grow + 64 * J + 8 * h + 4);
                const unsigned lo = pk4_fp8(bf_lo(d.x) * rstd * g0[0], bf_hi(d.x) * rstd * g0[1], bf_lo(d.y) * rstd * g0[2], bf_hi(d.y) * rstd * g0[3]);
                const unsigned hi = pk4_fp8(bf_lo(d.z) * rstd * g1[0], bf_hi(d.z) * rstd * g1[1], bf_lo(d.w) * rstd * g1[2], bf_hi(d.w) * rstd * g1[3]);
                if (h == 0) { o.x = lo; o.y = hi; } else { o.z = lo; o.w = hi; } }
            *(u32x4*)(hrow + 64 * J) = o; __builtin_amdgcn_sched_barrier(0); }
    }
    if (!(F.wave & 1)) convert_expert_weights(F, P, cscr);
}

__device__ __forceinline__ void convert_expert_weights(Frame& F, const Ptrs& P, LAS float* scr) {
    {
        const int gw = F.vcu * 8 + F.wave, NGW = F.G * 8;
        for (int it = gw; it < 3 * 16 * 1024; it += NGW) {
            const int mat = it >> 14, r = it & 16383, e = r >> 10, q = r & 1023;
            if (mat < 2) { const int kb = q >> 6, nb = q & 63, n0 = 32 * nb;
                transpose_item_fp8((mat == 0 ? P.w_eg : P.w_eu) + (size_t)e * 1024 * 2048, 1024, 2048, WSP(unsigned char, WS_WGU) + (size_t)e * 4096 * 1024, 64 * kb, n0, (n0 >> 7) * 256 + mat * 128 + (n0 & 127), W8_SCALE, scr, F.lane); }
            else { const int kb = q >> 5, nb = q & 31;
                transpose_item_fp8(P.w_ed + (size_t)e * 2048 * 1024, 2048, 1024, WSP(unsigned char, WS_WD) + (size_t)e * 1024 * 2048, 64 * kb, 32 * nb, 32 * nb, W8_SCALE, scr, F.lane); }
        }
    }
}
__device__ __forceinline__ void phase_topk_convert(Frame& F, const Ptrs& P) {
    LAS float* vals = (LAS float*)F.lds;
    LAS unsigned* hist = (LAS unsigned*)(F.lds + 16384);
    LAS unsigned* ctl = hist + 512;
    for (int task0 = F.vcu; task0 < NB * NEXP; task0 += 2 * F.G) {
        const int nt2 = (task0 + F.G < NB * NEXP) ? 2 : 1;
        __syncthreads();
        float v[2][4]; unsigned u[2][4];
#pragma unroll
        for (int k = 0; k < 2; ++k) { const int task = task0 + k * F.G, b = task >> 4, e = task & 15;
#pragma unroll
            for (int j = 0; j < 4; ++j) { const int t = F.tid + 512 * j; v[k][j] = (k < nt2) ? WSP(const float, WS_AFF)[(size_t)(b * SEQ + t) * 16 + e] : 0.f; vals[k * 2048 + t] = v[k][j]; u[k][j] = __float_as_uint(v[k][j]); } }
        unsigned prefix[2] = {0u, 0u}, need[2] = {(unsigned)CAP, (unsigned)CAP};
        for (int pass = 0; pass < 4; ++pass) {
            const int shift = 24 - 8 * pass;
            hist[F.tid] = 0u;
            if (F.tid < 2) { ctl[F.tid * 8 + 2] = 0u; ctl[F.tid * 8 + 4] = 0u; }
            __syncthreads();
#pragma unroll
            for (int k = 0; k < 2; ++k)
#pragma unroll
                for (int j = 0; j < 4; ++j) if (pass == 0 || (u[k][j] >> (shift + 8)) == prefix[k]) __hip_atomic_fetch_add(&hist[k * 256 + ((u[k][j] >> shift) & 255u)], 1u, __ATOMIC_RELAXED, __HIP_MEMORY_SCOPE_WORKGROUP);
            __syncthreads();
            if (F.wave < 2) { const int k = F.wave;
                const u32x4 h4 = *(const LAS u32x4*)(hist + k * 256 + 4 * F.lane);
                const unsigned sl = (h4.x + h4.y) + (h4.z + h4.w);
                unsigned S = sl;
#pragma unroll
                for (int off = 1; off < 64; off <<= 1) { const unsigned t = __shfl_down(S, off); S += (F.lane + off < 64) ? t : 0u; }
                const unsigned nd = (k == 0) ? need[0] : need[1], pf = (k == 0) ? prefix[0] : prefix[1];
                const unsigned long long mk = __ballot(S >= nd);
                const int L = 63 - __builtin_clzll(mk);
                if (F.lane == L) { unsigned c = S - sl; int d = 4 * L; unsigned bc = 0u;
                    if (c + h4.w >= nd) { d = 4 * L + 3; bc = h4.w; } else { c += h4.w;
                    if (c + h4.z >= nd) { d = 4 * L + 2; bc = h4.z; } else { c += h4.z;
                    if (c + h4.y >= nd) { d = 4 * L + 1; bc = h4.y; } else { c += h4.y; d = 4 * L; bc = h4.x; } } }
                    ctl[k * 8 + 0] = (pf << 8) | (unsigned)d; ctl[k * 8 + 1] = nd - c; ctl[k * 8 + 3] = bc; }
            }
            __syncthreads();
            prefix[0] = ctl[0]; need[0] = ctl[1]; prefix[1] = ctl[8]; need[1] = ctl[9];
        }
#pragma unroll
        for (int k = 0; k < 2; ++k) { if (k >= nt2) break;
            const int task = task0 + k * F.G, b = task >> 4, e = task & 15;
            const unsigned T = prefix[k], cnt_eq = ctl[k * 8 + 3], ngt = (unsigned)CAP - need[k];
#pragma unroll
            for (int j = 0; j < 4; ++j) { const int t = F.tid + 512 * j; int slot = -1;
                if (u[k][j] > T) slot = (int)__hip_atomic_fetch_add(&ctl[k * 8 + 2], 1u, __ATOMIC_RELAXED, __HIP_MEMORY_SCOPE_WORKGROUP);
                else if (u[k][j] == T) {
                    if (cnt_eq == need[k]) slot = (int)(ngt + __hip_atomic_fetch_add(&ctl[k * 8 + 4], 1u, __ATOMIC_RELAXED, __HIP_MEMORY_SCOPE_WORKGROUP));
                    else { unsigned eq = 0u; for (int i = 0; i < t; ++i) eq += (vals[k * 2048 + i] == v[k][j]) ? 1u : 0u; if (eq < need[k]) slot = (int)(ngt + eq); } }
                if (slot >= 0) {
                    WSP(int, WS_IDX)[(b * 16 + e) * 256 + slot] = b * SEQ + t;
                    WSP(float, WS_GL)[(b * 16 + e) * 256 + slot] = v[k][j];
                    WSP(short, WS_INV)[(size_t)(b * SEQ + t) * 16 + e] = (short)slot; } } }
    }
}

__device__ __forceinline__ void phase_final(Frame& F, const Ptrs& P) {
    constexpr int FR = 4;
    const int gw = F.vcu * 8 + F.wave, NGW = F.G * 8, lane = F.lane;
    const short* INV = WSP(const short, WS_INV); const float* GLp = WSP(const float, WS_GL); const unsigned* YEp = WSP(const unsigned, WS_YE);
    f32x4 gg[4];
#pragma unroll
    for (int j = 0; j < 4; ++j) gg[j] = ((const f32x4*)P.final_g)[lane + 64 * j];
    int sln[FR];
#pragma unroll
    for (int r = 0; r < FR; ++r) { const int m = gw + r * NGW; sln[r] = (m < MTOK && lane < 16) ? (int)INV[(size_t)m * 16 + lane] : -1; }
    for (int m0 = gw; m0 < MTOK; m0 += FR * NGW) {
        int sl[FR]; u32x2 xq[FR][4]; unsigned yq[FR][4][4]; float glv[FR]; int ek[FR][4]; unsigned rest[FR];
#pragma unroll
        for (int r = 0; r < FR; ++r) sl[r] = sln[r];
#pragma unroll
        for (int r = 0; r < FR; ++r) { const int m = m0 + FR * NGW + r * NGW; sln[r] = (m < MTOK && lane < 16) ? (int)INV[(size_t)m * 16 + lane] : -1; }
#pragma unroll
        for (int r = 0; r < FR; ++r) { const int m = m0 + r * NGW; if (m < MTOK) { const u32x2* xr = WSP(const u32x2, WS_X1) + (size_t)m * 256 + lane;
#pragma unroll
            for (int j = 0; j < 4; ++j) xq[r][j] = xr[64 * j]; } }
#pragma unroll
        for (int r = 0; r < FR; ++r) { const int m = m0 + r * NGW, b = m >> 11;
            unsigned mk = (unsigned)__ballot(sl[r] >= 0) & 0xffffu;
            glv[r] = (sl[r] >= 0) ? GLp[(b * 16 + lane) * 256 + sl[r]] : 0.f;
#pragma unroll
            for (int k = 0; k < 4; ++k) { ek[r][k] = mk ? (int)__builtin_ctz(mk) : -1; mk &= mk - 1u;
                if (ek[r][k] >= 0) { const int s_ = __builtin_amdgcn_readlane(sl[r], ek[r][k]); const unsigned* yr = YEp + (size_t)((ek[r][k] * 32 + b) * 256 + s_) * 256 + lane;
#pragma unroll
                    for (int j = 0; j < 4; ++j) yq[r][k][j] = yr[64 * j]; } }
            rest[r] = mk; }
#pragma unroll
        for (int r = 0; r < FR; ++r) { const int m = m0 + r * NGW, b = m >> 11; if (m >= MTOK) break;
            f32x4 v[4];
#pragma unroll
            for (int j = 0; j < 4; ++j) v[j] = (f32x4){bf_lo(xq[r][j].x), bf_hi(xq[r][j].x), bf_lo(xq[r][j].y), bf_hi(xq[r][j].y)};
#pragma unroll
            for (int k = 0; k < 4; ++k) if (ek[r][k] >= 0) { const float g = __uint_as_float((unsigned)__builtin_amdgcn_readlane((int)__float_as_uint(glv[r]), ek[r][k])) * (1.0f / YE8_SCALE);
#pragma unroll
                for (int j = 0; j < 4; ++j) { const int y = (int)yq[r][k][j]; const f32x2 lo = __builtin_amdgcn_cvt_pk_f32_fp8(y, false), hi2 = __builtin_amdgcn_cvt_pk_f32_fp8(y, true);
                    v[j][0] += g * lo[0]; v[j][1] += g * lo[1]; v[j][2] += g * hi2[0]; v[j][3] += g * hi2[1]; } }
            unsigned rs_ = rest[r];
            while (rs_) { const int e = (int)__builtin_ctz(rs_); rs_ &= rs_ - 1u;
                const int s2 = __builtin_amdgcn_readlane(sl[r], e); const float g = __uint_as_float((unsigned)__builtin_amdgcn_readlane((int)__float_as_uint(glv[r]), e)) * (1.0f / YE8_SCALE);
                const unsigned* yr = YEp + (size_t)((e * 32 + b) * 256 + s2) * 256 + lane;
#pragma unroll
                for (int j = 0; j < 4; ++j) { const int y = (int)yr[64 * j]; const f32x2 lo = __builtin_amdgcn_cvt_pk_f32_fp8(y, false), hi2 = __builtin_amdgcn_cvt_pk_f32_fp8(y, true);
                    v[j][0] += g * lo[0]; v[j][1] += g * lo[1]; v[j][2] += g * hi2[0]; v[j][3] += g * hi2[1]; } }
            float s = 0.f;
#pragma unroll
            for (int j = 0; j < 4; ++j) s += (v[j][0] * v[j][0] + v[j][1] * v[j][1]) + (v[j][2] * v[j][2] + v[j][3] * v[j][3]);
            const float rstd = 1.0f / sqrtf(wave_sum(s) * (1.0f / 1024.0f) + EPS);
            f32x4* orow = (f32x4*)(P.out + (size_t)m * 1024) + lane;
#pragma unroll
            for (int j = 0; j < 4; ++j) { f32x4 o; o[0] = v[j][0] * rstd * gg[j][0]; o[1] = v[j][1] * rstd * gg[j][1]; o[2] = v[j][2] * rstd * gg[j][2]; o[3] = v[j][3] * rstd * gg[j][3]; orow[64 * j] = o; } }
    }
}

constexpr int N_PHASES = 10;
struct Args { Ptrs P; int ph_lo, ph_hi; };
__global__ void __launch_bounds__(512, 2) fwd(Args args) {
    extern __shared__ __attribute__((aligned(16))) unsigned char lds_raw[];
    LAS unsigned char* lds = (LAS unsigned char*)lds_raw;
    const Ptrs& P = args.P;
    Frame F; F.lds = lds; F.tid = threadIdx.x; F.lane = F.tid & 63; F.wave = __builtin_amdgcn_readfirstlane(F.tid >> 6);
    F.G = gridDim.x; { const int bx = blockIdx.x; F.vcu = (F.G % 8 == 0) ? (bx % 8) * (F.G / 8) + bx / 8 : bx; }
    volatile LAS unsigned* MISC = (volatile LAS unsigned*)(lds + MISC_OFF);
    if (F.tid < 64) MISC[F.tid] = 0u;
    __syncthreads();
    XcdBarrier bar; bar.bar = WSP(unsigned, WS_CTL) + 1024; bar.x = 0; bar.st = nullptr;
    if (MK_N_LAUNCHES == 1) bar = xcd_barrier_post(WSP(unsigned, WS_CTL) + 1024, MISC + 8);
    const int lo = args.ph_lo, hi = args.ph_hi;
#ifndef PHMASK
#define PHMASK 0x3ff
#endif
#define IN(k) (((PHMASK >> (k)) & 1) && lo <= (k) && (k) < hi)
#define SEAM(k) do { if (IN(k) && IN((k) + 1)) xcd_barrier(bar); } while (0)

    if (IN(0)) { phase_prologue(F, P); } SEAM(0);
    if (IN(1)) { JobP1 J{P, F.G, (int)blockIdx.x, INPROJ_FP8 ? 512 : 1024, INPROJ_FP8 ? 512 : 1024, INPROJ_FP8 ? 512 : 1024, (LAS float*)(lds + EPI_OFF)}; pg::gemm_phase<JobP1, true, false, INPROJ_FP8 != 0>(lds, J);
        if (XA_FP8) { JobP1x Jx{P, F.G, (int)blockIdx.x, 512, 512, 512}; pg::gemm_phase<JobP1x, true, false, true>(lds, Jx); } } SEAM(1);
    if (IN(2)) {
        for (int i = 0; i < 4; ++i) { const int u_ = i * F.G + F.vcu; fa::wa_group(lds, P, u_ >> 5, (u_ >> 3) & 3, u_ & 7); }
        { JobXA J{P, F.G, (int)blockIdx.x, XS_FP8 ? 128 : 256, XS_FP8 ? 512 : 1024, XS_FP8 ? 512 : 1024, (LAS float*)(lds + EPI_OFF)}; pg::gemm_phase<JobXA, true, false, XS_FP8 != 0>(lds, J); }
        { JobMVW J{P, F.G, (int)blockIdx.x, XS_FP8 ? 128 : 256, XS_FP8 ? 512 : 1024, XS_FP8 ? 512 : 1024}; pg::gemm_phase<JobMVW, true, false, XS_FP8 != 0>(lds, J); }
        { float lam;
          { const float a = P.lq1[F.lane] * P.lk1[F.lane], b2 = P.lq2[F.lane] * P.lk2[F.lane];
            lam = __expf(wave_sum(a)) - __expf(wave_sum(b2)) + LAM_INIT; }
          const int g_ = F.vcu >> 4, qb0 = F.vcu & 15;
          for (int i = 0; i < 16; ++i) { const int ih = i & 7, ib = i >> 3; fa::flash_unit<0>(lds, P, 2 * g_ + ib, (ih + g_) & 7, (qb0 + 3 * ih + 8 * ib) & 15, lam); } }
    } SEAM(2);
    if (IN(3)) {
        { JobMergeG J{P, F.G, (int)blockIdx.x, GATES_FP8 ? 512 : 1024, GATES_FP8 ? 512 : 1024, GATES_FP8 ? 512 : 1024}; pg::gemm_phase<JobMergeG, true, false, GATES_FP8 != 0>(lds, J); }
        if (YC_FP8) { { JobMergeY J{P, F.G, (int)blockIdx.x, 1024, 1024, 1024, 1}; pg::gemm_phase<JobMergeY, true, false>(lds, J); }
                      { JobMergeY J{P, F.G, (int)blockIdx.x, 512, 512, 512, 2}; pg::gemm_phase<JobMergeY, true, false, true>(lds, J); } }
        else { JobMergeY J{P, F.G, (int)blockIdx.x, 1024, 1024, 1024, 0}; pg::gemm_phase<JobMergeY, true, false>(lds, J); }
    } SEAM(3);
    if (IN(4)) { JobOut J{P, F.G, (int)blockIdx.x, 1024, 1024, 1024}; pg::gemm_phase<JobOut, true, false>(lds, J); } SEAM(4);
    if (IN(5)) { phase_norm_router(F, P); } SEAM(5);
    if (IN(6)) { phase_topk_convert(F, P); } SEAM(6);
    if (IN(7)) { JobGU J{P, TAILQ ? 1 : F.G, TAILQ ? 0 : (int)blockIdx.x, 512, 512, 512}; pg::gemm_phase<JobGU, true, true, true, TAILQ != 0>(lds, J, WSP(int, WS_QCTR), (8192 - GU_NSTAT * 256) / 8, GU_NSTAT, F.G, (int)blockIdx.x); } SEAM(7);
    if (IN(8)) { JobDown J{P, F.G, (int)blockIdx.x, 1024, 1024, 1024}; pg::gemm_phase<JobDown, true, false, true>(lds, J); } SEAM(8);
    if (IN(9)) { phase_final(F, P); }
#undef IN
#undef SEAM
}

extern "C" void kernel_launch(void* const* d_in, const int* in_sizes, int n_in, void* d_out, int out_size, void* d_ws, size_t ws_size, hipStream_t stream) {
    static int grid = 0;
    if (grid == 0) {
        if (n_in != 22 || in_sizes[0] != MTOK * DM || out_size != MTOK * DM || ws_size < WS_END) {
            fprintf(stderr, "kernel_launch: unexpected shapes (n_in %d, in0 %d, out %d, ws %zu)\n", n_in, n_in > 0 ? in_sizes[0] : -1, out_size, ws_size); grid = -1; return; }
        int dev = 0, cus = 0;
        if (hipGetDevice(&dev) != hipSuccess || hipDeviceGetAttribute(&cus, hipDeviceAttributeMultiprocessorCount, dev) != hipSuccess) { grid = -1; return; }
        if (hipFuncSetAttribute((const void*)fwd, hipFuncAttributeMaxDynamicSharedMemorySize, LDS_BYTES) != hipSuccess) { fprintf(stderr, "kernel_launch: hipFuncSetAttribute failed\n"); grid = -1; return; }
        int per_cu = 0;
        if (hipOccupancyMaxActiveBlocksPerMultiprocessor(&per_cu, (const void*)fwd, 512, LDS_BYTES) != hipSuccess || per_cu < 1) fprintf(stderr, "kernel_launch: occupancy query says %d\n", per_cu);
        (void)hipGetLastError();
        grid = cus;
        if (grid != 256) fprintf(stderr, "kernel_launch: %d CUs (built for 256)\n", grid);
    }
    if (grid < 0) return;
    (void)hipMemsetAsync((char*)d_ws + WS_CTL, 0, CTL_ZERO_BYTES, stream);
    Args a{};
    Ptrs& P = a.P;
    P.x = (const float*)d_in[0]; P.mem = (const float*)d_in[1]; P.attn_g = (const float*)d_in[2]; P.mem_g = (const float*)d_in[3]; P.w_in = (const float*)d_in[4]; P.w_mkv = (const float*)d_in[5];
    P.lq1 = (const float*)d_in[6]; P.lk1 = (const float*)d_in[7]; P.lq2 = (const float*)d_in[8]; P.lk2 = (const float*)d_in[9]; P.subln_g = (const float*)d_in[10]; P.wa_sink = (const float*)d_in[11];
    P.w_da_o = (const float*)d_in[12]; P.w_wa_o = (const float*)d_in[13]; P.w_xa_o = (const float*)d_in[14]; P.w_out = (const float*)d_in[15]; P.ffn_g = (const float*)d_in[16]; P.w_router = (const float*)d_in[17];
    P.w_eg = (const float*)d_in[18]; P.w_eu = (const float*)d_in[19]; P.w_ed = (const float*)d_in[20]; P.final_g = (const float*)d_in[21];
    P.out = (float*)d_out; P.ws = (unsigned char*)d_ws;
    if (MK_N_LAUNCHES == 1) { a.ph_lo = 0; a.ph_hi = N_PHASES; hipLaunchKernelGGL(fwd, dim3(grid), dim3(512), LDS_BYTES, stream, a); }
    else { for (int p = 0; p < N_PHASES; ++p) { a.ph_lo = p; a.ph_hi = p + 1; hipLaunchKernelGGL(fwd, dim3(grid), dim3(512), LDS_BYTES, stream, a); } }
}
```
